# Optimizing an MI355X kernel written in HIP

```python
import math
import jax, jax.numpy as jnp
from jax import lax
import numpy as np

D_MODEL = 1024
BATCH = 8
SEQ = 2048
DEPTH = 1
DEC_BATCH = 8
DEC_SEQ = 8192
PAST_LEN = 128

D_SSM = D_MODEL // 2
SSM_GROUP = 16
N_GROUPS = D_SSM // SSM_GROUP
STATE = 64
D_ATTN = D_MODEL // 2
N_HEADS = 4
HEAD_DIM = D_ATTN // (2 * N_HEADS)
Q_BLOCK = 128
ROPE_THETA = 10000.0
NORM_EPS = 1e-6
SUBLN_EPS = 1e-5
DT_MIN = 1e-3
DT_MAX = 1e-1
N_IN = 2 * D_SSM + 4 * D_ATTN + 2 * D_MODEL

kernel_name = "hybrid_s5_diffattn_gated_encoder"


def _rmsnorm(x, g, eps=NORM_EPS):
    xf = x.astype(jnp.float32)
    return xf * lax.rsqrt(jnp.mean(xf * xf, axis=-1, keepdims=True) + eps) * g.astype(jnp.float32)


def _rotary(x):
    L = x.shape[1]
    half = HEAD_DIM // 2
    inv_freq = 1.0 / (ROPE_THETA ** (jnp.arange(0, half, dtype=jnp.float32) * 2.0 / HEAD_DIM))
    ang = jnp.arange(L, dtype=jnp.float32)[:, None] * inv_freq[None, :]
    cos = jnp.cos(ang)[None, :, None, None, :]
    sin = jnp.sin(ang)[None, :, None, None, :]
    x1, x2 = x[..., :half], x[..., half:]
    return jnp.concatenate([x1 * cos - x2 * sin, x2 * cos + x1 * sin], axis=-1)


def _scan_combine(e1, e2):
    a1, b1 = e1
    a2, b2 = e2
    return (a2 * a1, a2 * b1 + b2)


def _s5_bidirectional(u, a_re, a_im, log_dt, b_re, b_im, c_re, c_im, d_skip):
    f32 = jnp.float32
    Bsz, L, _ = u.shape
    A = lax.complex(a_re.astype(f32), a_im.astype(f32))
    dt = jnp.exp(log_dt.astype(f32))[..., None]
    A_bar = jnp.exp(A * dt)
    B_c = lax.complex(b_re.astype(f32), b_im.astype(f32))
    B_bar = ((A_bar - 1.0) / A)[..., None] * B_c
    C_c = lax.complex(c_re.astype(f32), c_im.astype(f32))
    ug = u.reshape(Bsz, L, N_GROUPS, SSM_GROUP)

    def per_sequence(us):
        bu = jnp.einsum('ngpc,lgc->nlgp', B_bar, us.astype(jnp.complex64))
        a = jnp.broadcast_to(A_bar[:, None], bu.shape)
        _, h_f = lax.associative_scan(_scan_combine, (a[0], bu[0]), axis=0)
        _, h_b = lax.associative_scan(_scan_combine, (a[1], bu[1]), axis=0, reverse=True)
        y = jnp.einsum('gcp,lgp->lgc', C_c[0], h_f) + jnp.einsum('gcp,lgp->lgc', C_c[1], h_b)
        return jnp.real(y)

    y = lax.map(per_sequence, ug).reshape(Bsz, L, D_SSM)
    return y + d_skip.astype(f32) * u


def _diff_attention(q, k, v, lam):
    Bsz, L = q.shape[0], q.shape[1]
    nb = L // Q_BLOCK
    scale = 1.0 / math.sqrt(HEAD_DIM)
    qb = q.reshape(Bsz, nb, Q_BLOCK, N_HEADS, 2, HEAD_DIM).transpose(1, 0, 2, 3, 4, 5)

    def block(qi):
        s = jnp.einsum('bqhtd,bkhtd->bthqk', qi, k).astype(jnp.float32) * scale
        p = jax.nn.softmax(s, axis=-1)
        w = p[:, 0] - lam * p[:, 1]
        return jnp.einsum('bhqk,bkhe->bqhe', w, v)

    o = lax.map(block, qb)
    return o.transpose(1, 0, 2, 3, 4).reshape(Bsz, L, N_HEADS, 2 * HEAD_DIM)


def _layer(x, li, norm_g, w_in, ssm_a_re, ssm_a_im, ssm_log_dt, ssm_b_re, ssm_b_im,
           ssm_c_re, ssm_c_im, ssm_d, w_glu, b_glu, lambda_q1, lambda_k1, lambda_q2,
           lambda_k2, subln_g, w_branch, w_out):
    f32 = jnp.float32
    Bsz, L, _ = x.shape
    h = _rmsnorm(x, norm_g)
    proj = jnp.einsum('bld,dn->bln', h, w_in.astype(f32))
    o = 0
    xs = proj[..., o:o + D_SSM]; o += D_SSM
    zs = proj[..., o:o + D_SSM]; o += D_SSM
    q = proj[..., o:o + D_ATTN]; o += D_ATTN
    k = proj[..., o:o + D_ATTN]; o += D_ATTN
    v = proj[..., o:o + D_ATTN]; o += D_ATTN
    za = proj[..., o:o + D_ATTN]; o += D_ATTN
    gs = proj[..., o:o + D_MODEL]; o += D_MODEL
    ga = proj[..., o:o + D_MODEL]

    ys = _s5_bidirectional(xs, ssm_a_re, ssm_a_im, ssm_log_dt, ssm_b_re, ssm_b_im,
                           ssm_c_re, ssm_c_im, ssm_d)
    ys = jax.nn.gelu(ys)
    ys = ys * jax.nn.sigmoid(jnp.einsum('bld,de->ble', ys, w_glu.astype(f32)) + b_glu.astype(f32))
    ys = ys * jax.nn.silu(zs)

    q = _rotary(q.reshape(Bsz, L, N_HEADS, 2, HEAD_DIM))
    k = _rotary(k.reshape(Bsz, L, N_HEADS, 2, HEAD_DIM))
    v = v.reshape(Bsz, L, N_HEADS, 2 * HEAD_DIM)
    lam_init = 0.8 - 0.6 * math.exp(-0.3 * li)
    lam = (jnp.exp(jnp.sum(lambda_q1.astype(f32) * lambda_k1.astype(f32)))
           - jnp.exp(jnp.sum(lambda_q2.astype(f32) * lambda_k2.astype(f32))) + lam_init)
    ya = _diff_attention(q, k, v, lam)
    ya = _rmsnorm(ya, subln_g, eps=SUBLN_EPS) * (1.0 - lam_init)
    ya = ya.reshape(Bsz, L, D_ATTN) * jax.nn.silu(za)

    wb = w_branch.astype(f32)
    ps = jnp.einsum('bld,de->ble', ys, wb[0])
    pa = jnp.einsum('bld,de->ble', ya, wb[1])
    merged = jax.nn.sigmoid(gs) * ps + jax.nn.sigmoid(ga) * pa
    return x.astype(f32) + jnp.einsum('bld,de->ble', merged, w_out.astype(f32))


def _trunk(x, norm_g, w_in, ssm_a_re, ssm_a_im, ssm_log_dt, ssm_b_re, ssm_b_im,
           ssm_c_re, ssm_c_im, ssm_d, w_glu, b_glu, lambda_q1, lambda_k1, lambda_q2,
           lambda_k2, subln_g, w_branch, w_out, final_g):
    dtype = x.dtype
    h = x.astype(jnp.float32)
    for li in range(DEPTH):
        h = _layer(h, li, norm_g[li], w_in[li], ssm_a_re[li], ssm_a_im[li], ssm_log_dt[li],
                   ssm_b_re[li], ssm_b_im[li], ssm_c_re[li], ssm_c_im[li], ssm_d[li],
                   w_glu[li], b_glu[li], lambda_q1[li], lambda_k1[li], lambda_q2[li],
                   lambda_k2[li], subln_g[li], w_branch[li], w_out[li])
    return _rmsnorm(h, final_g).astype(dtype)


def setup_inputs(seed: int = 0) -> dict:
    key = jax.random.key(seed)
    ks = jax.random.split(key, 24)
    f32 = jnp.float32
    nrm = lambda k, s: jax.random.normal(k, s, f32)
    n_idx = jnp.arange(STATE, dtype=f32)
    a_re = -0.5 + 0.01 * nrm(ks[4], (DEPTH, 2, N_GROUPS, STATE))
    a_im = jnp.pi * n_idx + 0.01 * nrm(ks[5], (DEPTH, 2, N_GROUPS, STATE))
    log_dt = jax.random.uniform(ks[6], (DEPTH, 2, N_GROUPS), f32,
                                math.log(DT_MIN), math.log(DT_MAX))
    b_scale = (2.0 * SSM_GROUP) ** -0.5
    c_scale = (2.0 * STATE) ** -0.5
    return {
        "x_prompt": nrm(ks[0], (BATCH, SEQ, D_MODEL)),
        "x_sample": nrm(ks[1], (DEC_BATCH, DEC_SEQ, D_MODEL)),
        "norm_g": 1.0 + 0.01 * nrm(ks[2], (DEPTH, D_MODEL)),
        "w_in": nrm(ks[3], (DEPTH, D_MODEL, N_IN)) * D_MODEL ** -0.5,
        "ssm_a_re": a_re,
        "ssm_a_im": a_im,
        "ssm_log_dt": log_dt,
        "ssm_b_re": nrm(ks[7], (DEPTH, 2, N_GROUPS, STATE, SSM_GROUP)) * b_scale,
        "ssm_b_im": nrm(ks[8], (DEPTH, 2, N_GROUPS, STATE, SSM_GROUP)) * b_scale,
        "ssm_c_re": nrm(ks[9], (DEPTH, 2, N_GROUPS, SSM_GROUP, STATE)) * c_scale,
        "ssm_c_im": nrm(ks[10], (DEPTH, 2, N_GROUPS, SSM_GROUP, STATE)) * c_scale,
        "ssm_d": nrm(ks[11], (DEPTH, D_SSM)),
        "w_glu": nrm(ks[12], (DEPTH, D_SSM, D_SSM)) * D_SSM ** -0.5,
        "b_glu": 0.01 * nrm(ks[13], (DEPTH, D_SSM)),
        "lambda_q1": 0.1 * nrm(ks[14], (DEPTH, HEAD_DIM)),
        "lambda_k1": 0.1 * nrm(ks[15], (DEPTH, HEAD_DIM)),
        "lambda_q2": 0.1 * nrm(ks[16], (DEPTH, HEAD_DIM)),
        "lambda_k2": 0.1 * nrm(ks[17], (DEPTH, HEAD_DIM)),
        "subln_g": 1.0 + 0.01 * nrm(ks[18], (DEPTH, 2 * HEAD_DIM)),
        "w_branch": nrm(ks[19], (DEPTH, 2, D_SSM, D_MODEL)) * D_SSM ** -0.5,
        "w_out": nrm(ks[20], (DEPTH, D_MODEL, D_MODEL)) * D_MODEL ** -0.5,
        "final_g": 1.0 + 0.01 * nrm(ks[21], (D_MODEL,)),
    }


def reference(x_prompt, x_sample, norm_g, w_in, ssm_a_re, ssm_a_im, ssm_log_dt, ssm_b_re,
              ssm_b_im, ssm_c_re, ssm_c_im, ssm_d, w_glu, b_glu, lambda_q1, lambda_k1,
              lambda_q2, lambda_k2, subln_g, w_branch, w_out, final_g):
    y_prompt = _trunk(x_prompt, norm_g, w_in, ssm_a_re, ssm_a_im, ssm_log_dt, ssm_b_re,
                      ssm_b_im, ssm_c_re, ssm_c_im, ssm_d, w_glu, b_glu, lambda_q1,
                      lambda_k1, lambda_q2, lambda_k2, subln_g, w_branch, w_out, final_g)
    y_sample = _trunk(x_sample, norm_g, w_in, ssm_a_re, ssm_a_im, ssm_log_dt, ssm_b_re,
                      ssm_b_im, ssm_c_re, ssm_c_im, ssm_d, w_glu, b_glu, lambda_q1,
                      lambda_k1, lambda_q2, lambda_k2, subln_g, w_branch, w_out, final_g)
    return (y_prompt, y_sample)
```

```cpp
#include <hip/hip_runtime.h>
#include <hip/hip_cooperative_groups.h>
#include <cstdio>
#include <cstdint>
namespace cg = cooperative_groups;

#define LAS __attribute__((address_space(3)))
typedef unsigned short bf16_t;
typedef short bf16x8 __attribute__((ext_vector_type(8)));
typedef short s16x4 __attribute__((ext_vector_type(4)));
typedef float f32x4 __attribute__((ext_vector_type(4)));
typedef float f32x16 __attribute__((ext_vector_type(16)));
typedef unsigned u32x4 __attribute__((ext_vector_type(4)));
typedef unsigned u32x2 __attribute__((ext_vector_type(2)));

constexpr int DM = 1024, NIN = 5120, MP = 8 * 2048, MS = 8 * 8192, MT = MP + MS;
constexpr size_t UB = (size_t)MT * 512 * 2;
constexpr size_t OFF_XB = 0;
constexpr size_t OFF_XS = 2 * UB, OFF_ZS = 3 * UB, OFF_QB = 4 * UB, OFF_KB = 5 * UB, OFF_VB = 6 * UB, OFF_ZA = 7 * UB;
constexpr size_t OFF_YF = 8 * UB, OFF_YB = 9 * UB;
constexpr size_t OFF_YSG = OFF_QB, OFF_YAN = OFF_KB, OFF_YS2 = OFF_VB, OFF_AO = OFF_XB, OFF_PS = OFF_XB, OFF_MG = OFF_YF;
constexpr size_t OFF_WIN = 10 * UB;
constexpr size_t OFF_WGLU = OFF_WIN + (size_t)NIN * DM * 2;
constexpr size_t OFF_WBR = OFF_WGLU + 512 * 512 * 2;
constexpr size_t OFF_WOUT = OFF_WBR + 2 * 1024 * 512 * 2;
constexpr size_t OFF_RSTD = OFF_WOUT + 1024 * 1024 * 2;
constexpr size_t OFF_SSQ = OFF_RSTD + (size_t)MT * 4;
constexpr size_t OFF_ROT = OFF_SSQ + (size_t)MT * 4;
constexpr size_t OFF_LAM = OFF_ROT + 8192 * 64 * 4;
constexpr size_t OFF_BB = OFF_LAM + 2 * 32 * 64 * 2 * 4;
constexpr size_t OFF_CB = OFF_BB + 2 * 32 * 128 * 16 * 2;
constexpr size_t OFF_CTL = OFF_CB + 2 * 32 * 128 * 16 * 2;
constexpr size_t WS_END = OFF_CTL + 256;
constexpr int LDS_BYTES = 131072;

struct Params {
  const float* x_p; const float* x_s; const float* norm_g; const float* w_in;
  const float* a_re; const float* a_im; const float* log_dt; const float* b_re; const float* b_im;
  const float* c_re; const float* c_im; const float* ssm_d; const float* w_glu; const float* b_glu;
  const float* lq1; const float* lk1; const float* lq2; const float* lk2; const float* subln_g;
  const float* w_branch; const float* w_out; const float* final_g;
  float* out; unsigned char* ws; int ph_lo, ph_hi;
};

typedef __bf16 bf16x2_t __attribute__((ext_vector_type(2)));
typedef float f32x2_t __attribute__((ext_vector_type(2)));
__device__ __forceinline__ unsigned cvtpk(float lo, float hi) { f32x2_t v = {lo, hi}; bf16x2_t b = __builtin_convertvector(v, bf16x2_t); return *reinterpret_cast<unsigned*>(&b); }
__device__ __forceinline__ float bflo(unsigned w) { return __uint_as_float(w << 16); }
__device__ __forceinline__ float bfhi(unsigned w) { return __uint_as_float(w & 0xffff0000u); }
__device__ __forceinline__ float sigmoidf_(float x) { return __builtin_amdgcn_rcpf(1.f + __builtin_amdgcn_exp2f(-1.4426950408889634f * x)); }
__device__ __forceinline__ float siluf_(float x) { return x * sigmoidf_(x); }
__device__ __forceinline__ float gelu_tanh(float x) { const float u = x + 0.044715f * x * x * x; return x * sigmoidf_(1.5957691216057308f * u); }
__device__ __forceinline__ u32x4 pack8(f32x4 a, f32x4 b) { u32x4 w; w.x = cvtpk(a[0], a[1]); w.y = cvtpk(a[2], a[3]); w.z = cvtpk(b[0], b[1]); w.w = cvtpk(b[2], b[3]); return w; }
__device__ __forceinline__ void unpack8(u32x4 w, f32x4& a, f32x4& b) { a = (f32x4){bflo(w.x), bfhi(w.x), bflo(w.y), bfhi(w.y)}; b = (f32x4){bflo(w.z), bfhi(w.z), bflo(w.w), bfhi(w.w)}; }
__device__ __forceinline__ int row_pos(int r) { return r < MP ? (r & 2047) : (r & 8191); }

namespace pg8 {
constexpr int BM = 256, BK = 64, HALF = 128, HTB = HALF * BK * 2, STAGE_BYTES = 8 * HTB, NXCD = 8, WGM = 8;
__host__ __device__ __forceinline__ int lds_byte(int r, int c) { const int st = (r >> 4) * 2 + (c >> 5), rr = r & 15, cc = c & 31, ob = rr * 64 + cc * 2; return st * 1024 + (ob ^ (((ob >> 9) & 1) << 5)); }
__host__ __device__ __forceinline__ void stage_rc(int b, int& R, int& C) { const int st = b / 1024, sb = b % 1024, swz = sb ^ (((sb >> 9) & 1) << 5); R = (st >> 1) * 16 + swz / 64; C = (st & 1) * 32 + (swz % 64) / 2; }
__host__ __device__ __forceinline__ int perm32(int rho) { const int n = rho >> 4, i = rho & 15; return 8 * (i >> 2) + 4 * n + (i & 3); }
struct Unit { int pm, pn; };
struct Gemm { const bf16_t* A; const bf16_t* Bt; int M, N, K; };
struct StaticOrder {
  int nM, nN, nwg, G, c;
  __device__ void init(int M, int N, int G_, int c_) { nM = M / BM; nN = N / BM; nwg = nM * nN; G = G_; c = c_; }
  __device__ bool next(int i, Unit& u) const {
    const long L = (long)i * G + c; if (L >= nwg) return false;
    int wgid = (int)L; { const int q = nwg / NXCD, r = nwg % NXCD, xcd = wgid % NXCD, off = wgid / NXCD; wgid = (xcd < r ? xcd * (q + 1) : r * (q + 1) + (xcd - r) * q) + off; }
    const int nig = WGM * nN, gid = wgid / nig, fm = gid * WGM, gsz = (nM - fm) < WGM ? (nM - fm) : WGM;
    u.pm = fm + ((wgid % nig) % gsz); u.pn = (wgid % nig) / gsz; return true;
  }
};
template <class Epi>
__device__ __forceinline__ void gemm_phase(LAS unsigned char* lds, const Gemm g, const StaticOrder& S, const Epi& E) {
  const int tid = threadIdx.x, wid = __builtin_amdgcn_readfirstlane(tid >> 6), lane = tid & 63, wr = wid >> 2, wc = wid & 3, fr = lane & 15, fq = lane >> 4;
  const int K = g.K, nt = K / BK;
  unsigned voffA[2], voffB[2];
#pragma unroll
  for (int i = 0; i < 2; ++i) { int R, C; stage_rc(tid * 16 + i * 8192, R, C); const int Rb = Epi::PERM ? ((R & ~31) + perm32(R & 31)) : R;
    voffA[i] = (unsigned)(R * K + C) * 2u; voffB[i] = (unsigned)(Rb * K + C) * 2u; }
  const size_t kstep = (size_t)(BK * 2), hstep = (size_t)HALF * K * 2, tstep = 2 * hstep;
  const unsigned ldsw = (unsigned)wid * 1024u;
  const int aoff = lds_byte(wr * 64 + fr, fq * 8), boff = lds_byte(wc * 32 + fr, fq * 8);
#define PG8_SA(b, h) (((b) * 2 + (h)) * HTB)
#define PG8_SB(b, h) ((4 + (b) * 2 + (h)) * HTB)
#define PG8_STAGE(bufoff, gbase, voff) do { _Pragma("unroll") for (int _i = 0; _i < 2; ++_i) \
    __builtin_amdgcn_global_load_lds((const unsigned*)((const char*)(gbase) + (voff)[_i]), (LAS unsigned*)(lds + (bufoff) + ldsw + _i * 8192), 16, 0, 0); } while (0)
#define PG8_LDA(dst, b, h) do { _Pragma("unroll") for (int m = 0; m < 4; ++m) _Pragma("unroll") for (int k = 0; k < 2; ++k) dst[m][k] = *(const LAS bf16x8*)(lds + PG8_SA(b, h) + aoff + m * 2048 + k * 1024); } while (0)
#define PG8_LDB(dst, b, h) do { _Pragma("unroll") for (int n = 0; n < 2; ++n) _Pragma("unroll") for (int k = 0; k < 2; ++k) dst[n][k] = *(const LAS bf16x8*)(lds + PG8_SB(b, h) + boff + n * 2048 + k * 1024); } while (0)
#define PG8_MMA(ai, bj, At, Bt) do { __builtin_amdgcn_s_setprio(1); _Pragma("unroll") for (int m = 0; m < 4; ++m) _Pragma("unroll") for (int n = 0; n < 2; ++n) _Pragma("unroll") for (int k = 0; k < 2; ++k) \
    acc[ai][bj][m][n] = __builtin_amdgcn_mfma_f32_16x16x32_bf16(Bt[n][k], At[m][k], acc[ai][bj][m][n], 0, 0, 0); __builtin_amdgcn_s_setprio(0); } while (0)
#define PG8_WAIT_V(n) asm volatile("s_waitcnt vmcnt(" #n ")" ::: "memory")
#define PG8_WAIT_L(n) asm volatile("s_waitcnt lgkmcnt(" #n ")" ::: "memory")
#define PG8_BAR __builtin_amdgcn_s_barrier()
#define PG8_SCHED __builtin_amdgcn_sched_barrier(0)
  Unit cur, nxt; int ui = 0;
  if (!S.next(0, cur)) return;
  f32x4 acc[2][2][4][2];
#pragma unroll
  for (int a = 0; a < 2; ++a)
#pragma unroll
    for (int b = 0; b < 2; ++b)
#pragma unroll
      for (int m = 0; m < 4; ++m)
#pragma unroll
        for (int n = 0; n < 2; ++n) acc[a][b][m][n] = (f32x4){0.f, 0.f, 0.f, 0.f};
  bf16x8 At[4][2], B0[2][2], B1[2][2];
  const char* cA = (const char*)g.A + (size_t)cur.pm * tstep; const char* cB = (const char*)g.Bt + (size_t)cur.pn * tstep;
  PG8_STAGE(PG8_SB(0, 0), cB, voffB); PG8_STAGE(PG8_SA(0, 0), cA, voffA); PG8_STAGE(PG8_SB(0, 1), cB + hstep, voffB); PG8_STAGE(PG8_SA(0, 1), cA + hstep, voffA);
  if (wr == 1) PG8_BAR;
  PG8_WAIT_V(4); PG8_BAR;
  PG8_STAGE(PG8_SB(1, 0), cB + kstep, voffB); PG8_STAGE(PG8_SA(1, 0), cA + kstep, voffA); PG8_STAGE(PG8_SB(1, 1), cB + hstep + kstep, voffB);
  PG8_WAIT_V(6); PG8_BAR;
  for (;;) {
    const bool has_next = S.next(ui + 1, nxt);
    const char* nA = has_next ? (const char*)g.A + (size_t)nxt.pm * tstep : cA; const char* nB = has_next ? (const char*)g.Bt + (size_t)nxt.pn * tstep : cB;
    for (int t = 0; t < nt; t += 2) {
      const bool last = (t == nt - 2);
      const char* a1 = cA + (size_t)(t + 1) * kstep;
      const char* a2 = last ? nA : cA + (size_t)(t + 2) * kstep; const char* b2 = last ? nB : cB + (size_t)(t + 2) * kstep;
      const char* a3 = a2 + kstep; const char* b3 = b2 + kstep;
      PG8_LDB(B0, 0, 0); PG8_SCHED; PG8_LDA(At, 0, 0); PG8_STAGE(PG8_SA(1, 1), a1 + hstep, voffA);
      PG8_WAIT_L(8); PG8_BAR; PG8_WAIT_L(0); PG8_MMA(0, 0, At, B0); PG8_BAR; PG8_SCHED;
      PG8_LDB(B1, 0, 1); PG8_STAGE(PG8_SB(0, 0), b2, voffB);
      PG8_BAR; PG8_WAIT_L(0); PG8_MMA(0, 1, At, B1); PG8_BAR;
      PG8_LDA(At, 0, 1); PG8_STAGE(PG8_SA(0, 0), a2, voffA);
      PG8_BAR; PG8_WAIT_L(0); PG8_MMA(1, 0, At, B0); PG8_BAR; PG8_SCHED;
      PG8_STAGE(PG8_SB(0, 1), b2 + hstep, voffB);
      PG8_WAIT_V(6); PG8_BAR; PG8_MMA(1, 1, At, B1); PG8_BAR;
      PG8_LDB(B0, 1, 0); PG8_SCHED; PG8_LDA(At, 1, 0); PG8_STAGE(PG8_SA(0, 1), a2 + hstep, voffA);
      PG8_WAIT_L(8); PG8_BAR; PG8_WAIT_L(0); PG8_MMA(0, 0, At, B0); PG8_BAR; PG8_SCHED;
      PG8_LDB(B1, 1, 1); PG8_STAGE(PG8_SB(1, 0), b3, voffB);
      PG8_BAR; PG8_WAIT_L(0); PG8_MMA(0, 1, At, B1); PG8_BAR;
      PG8_LDA(At, 1, 1); PG8_STAGE(PG8_SA(1, 0), a3, voffA);
      PG8_BAR; PG8_WAIT_L(0); PG8_MMA(1, 0, At, B0); PG8_BAR; PG8_SCHED;
      PG8_STAGE(PG8_SB(1, 1), b3 + hstep, voffB);
      PG8_WAIT_V(6); PG8_BAR; PG8_MMA(1, 1, At, B1); PG8_BAR;
    }
    E(acc, cur, wr, wc, fr, fq);
    if (!has_next) break;
#pragma unroll
    for (int a = 0; a < 2; ++a)
#pragma unroll
      for (int b = 0; b < 2; ++b)
#pragma unroll
        for (int m = 0; m < 4; ++m)
#pragma unroll
          for (int n = 0; n < 2; ++n) acc[a][b][m][n] = (f32x4){0.f, 0.f, 0.f, 0.f};
    cur = nxt; cA = nA; cB = nB; ++ui;
  }
  PG8_WAIT_V(0);
  if (wr == 0) PG8_BAR;
  PG8_BAR;
#undef PG8_SA
#undef PG8_SB
#undef PG8_STAGE
#undef PG8_LDA
#undef PG8_LDB
#undef PG8_MMA
#undef PG8_WAIT_V
#undef PG8_WAIT_L
#undef PG8_BAR
#undef PG8_SCHED
}
}

struct EpiIn {
  static constexpr bool PERM = true;
  unsigned char* ws; bf16_t* gsga; const float* rstd; const float* rot;
  __device__ __forceinline__ void operator()(const f32x4 (&acc)[2][2][4][2], const pg8::Unit& u, int wr, int wc, int fr, int fq) const {
    const int pn = u.pn, row0 = u.pm * 256 + wr * 64 + fr, col0 = wc * 32 + 8 * fq;
    if (pn >= 4 && pn < 8) {
      bf16_t* base = (bf16_t*)(ws + (pn < 6 ? OFF_QB : OFF_KB));
      const int lc = ((pn & 1) * 4 + wc) * 64 + 8 * fq;
#pragma unroll
      for (int ai = 0; ai < 2; ++ai)
#pragma unroll
        for (int m = 0; m < 4; ++m) {
          const int r = row0 + ai * 128 + m * 16; const float rs = rstd[r];
          const float* rp = rot + (size_t)row_pos(r) * 64 + 8 * fq;
          const f32x4 c0 = *(const f32x4*)(rp), c1 = *(const f32x4*)(rp + 4), s0 = *(const f32x4*)(rp + 32), s1 = *(const f32x4*)(rp + 36);
          const f32x4 a0 = acc[ai][0][m][0] * rs, a1 = acc[ai][0][m][1] * rs, b0 = acc[ai][1][m][0] * rs, b1 = acc[ai][1][m][1] * rs;
          const f32x4 o10 = a0 * c0 - b0 * s0, o11 = a1 * c1 - b1 * s1, o20 = b0 * c0 + a0 * s0, o21 = b1 * c1 + a1 * s1;
          bf16_t* rowp = base + (size_t)r * 512 + lc;
          *(u32x4*)(rowp) = pack8(o10, o11); *(u32x4*)(rowp + 32) = pack8(o20, o21);
        }
    } else {
      bf16_t* base; int ldc, colt, act;
      if (pn < 2) { base = (bf16_t*)(ws + OFF_XS); ldc = 512; colt = pn * 256; act = 0; }
      else if (pn < 4) { base = (bf16_t*)(ws + OFF_ZS); ldc = 512; colt = (pn - 2) * 256; act = 1; }
      else if (pn < 10) { base = (bf16_t*)(ws + OFF_VB); ldc = 512; colt = (pn - 8) * 256; act = 0; }
      else if (pn < 12) { base = (bf16_t*)(ws + OFF_ZA); ldc = 512; colt = (pn - 10) * 256; act = 1; }
      else if (pn < 16) { base = gsga; ldc = 1024; colt = (pn - 12) * 256; act = 2; }
      else { base = gsga + (size_t)MT * 1024; ldc = 1024; colt = (pn - 16) * 256; act = 2; }
#pragma unroll
      for (int ai = 0; ai < 2; ++ai)
#pragma unroll
        for (int m = 0; m < 4; ++m) {
          const int r = row0 + ai * 128 + m * 16; const float rs = rstd[r];
          bf16_t* rowp = base + (size_t)r * ldc + colt + col0;
#pragma unroll
          for (int bj = 0; bj < 2; ++bj) {
            f32x4 v0 = acc[ai][bj][m][0] * rs, v1 = acc[ai][bj][m][1] * rs;
            if (act == 1) {
#pragma unroll
              for (int j = 0; j < 4; ++j) { v0[j] = siluf_(v0[j]); v1[j] = siluf_(v1[j]); } }
            else if (act == 2) {
#pragma unroll
              for (int j = 0; j < 4; ++j) { v0[j] = sigmoidf_(v0[j]); v1[j] = sigmoidf_(v1[j]); } }
            *(u32x4*)(rowp + bj * 128) = pack8(v0, v1);
          }
        }
    }
  }
};
struct EpiGlu {
  static constexpr bool PERM = true;
  const bf16_t* ysg; const bf16_t* zs; const float* bias; bf16_t* out;
  __device__ __forceinline__ void operator()(const f32x4 (&acc)[2][2][4][2], const pg8::Unit& u, int wr, int wc, int fr, int fq) const {
    const int row0 = u.pm * 256 + wr * 64 + fr, col0 = u.pn * 256 + wc * 32 + 8 * fq;
#pragma unroll
    for (int ai = 0; ai < 2; ++ai)
#pragma unroll
      for (int m = 0; m < 4; ++m) {
        const size_t ro = (size_t)(row0 + ai * 128 + m * 16) * 512 + col0;
#pragma unroll
        for (int bj = 0; bj < 2; ++bj) {
          const f32x4 bb0 = *(const f32x4*)(bias + col0 + bj * 128), bb1 = *(const f32x4*)(bias + col0 + bj * 128 + 4);
          f32x4 y0, y1, z0, z1; unpack8(*(const u32x4*)(ysg + ro + bj * 128), y0, y1); unpack8(*(const u32x4*)(zs + ro + bj * 128), z0, z1);
          f32x4 v0 = acc[ai][bj][m][0] + bb0, v1 = acc[ai][bj][m][1] + bb1;
#pragma unroll
          for (int j = 0; j < 4; ++j) { v0[j] = y0[j] * sigmoidf_(v0[j]) * z0[j]; v1[j] = y1[j] * sigmoidf_(v1[j]) * z1[j]; }
          *(u32x4*)(out + ro + bj * 128) = pack8(v0, v1);
        }
      }
  }
};
template <int MODE> struct EpiBr {
  static constexpr bool PERM = true;
  const bf16_t* gate; bf16_t* ps; bf16_t* out;
  __device__ __forceinline__ void operator()(const f32x4 (&acc)[2][2][4][2], const pg8::Unit& u, int wr, int wc, int fr, int fq) const {
    const int row0 = u.pm * 256 + wr * 64 + fr, col0 = u.pn * 256 + wc * 32 + 8 * fq;
#pragma unroll
    for (int ai = 0; ai < 2; ++ai)
#pragma unroll
      for (int m = 0; m < 4; ++m) {
        const size_t ro = (size_t)(row0 + ai * 128 + m * 16) * 1024 + col0;
#pragma unroll
        for (int bj = 0; bj < 2; ++bj) {
          f32x4 g0, g1; unpack8(*(const u32x4*)(gate + ro + bj * 128), g0, g1);
          f32x4 v0 = acc[ai][bj][m][0] * g0, v1 = acc[ai][bj][m][1] * g1;
          if (MODE == 1) { f32x4 p0, p1; unpack8(*(const u32x4*)(ps + ro + bj * 128), p0, p1); v0 += p0; v1 += p1; *(u32x4*)(out + ro + bj * 128) = pack8(v0, v1); }
          else *(u32x4*)(ps + ro + bj * 128) = pack8(v0, v1);
        }
      }
  }
};
struct EpiOut {
  static constexpr bool PERM = false;
  const float* x_p; const float* x_s; float* out; float* ssq;
  __device__ __forceinline__ void operator()(const f32x4 (&acc)[2][2][4][2], const pg8::Unit& u, int wr, int wc, int fr, int fq) const {
    const int row0 = u.pm * 256 + wr * 64 + fr, col0 = u.pn * 256 + wc * 32 + 4 * fq;
#pragma unroll
    for (int ai = 0; ai < 2; ++ai)
#pragma unroll
      for (int m = 0; m < 4; ++m) {
        const int r = row0 + ai * 128 + m * 16;
        const float* xr = (r < MP ? x_p + (size_t)r * 1024 : x_s + (size_t)(r - MP) * 1024) + col0;
        float* orow = out + (size_t)r * 1024 + col0; float s = 0.f;
#pragma unroll
        for (int bj = 0; bj < 2; ++bj)
#pragma unroll
          for (int n = 0; n < 2; ++n) { const f32x4 y = acc[ai][bj][m][n] + *(const f32x4*)(xr + bj * 128 + n * 16);
            *(f32x4*)(orow + bj * 128 + n * 16) = y; s += y[0] * y[0] + y[1] * y[1] + y[2] * y[2] + y[3] * y[3]; }
        s += __shfl_xor(s, 16); s += __shfl_xor(s, 32);
        if (fq == 0) atomicAdd(ssq + r, s);
      }
  }
};

namespace att {
constexpr int NW = 8, QBLK = 32, KVBLK = 64, LD = 512, LDO = 1024;
constexpr float SCALE = 0.125f, THR = 8.f;
constexpr int SHM_V = KVBLK * 128 * 2, SHM_K = KVBLK * 64 * 2;
#define KSWZ(row, colB) ((row) * 128 + ((colB) ^ ((((row) >> 1) & 7) << 4)))
#define SBAR() __builtin_amdgcn_sched_barrier(0)
__device__ __forceinline__ int crow(int r, int hi) { return (r & 3) + 8 * (r >> 2) + 4 * hi; }
__device__ __forceinline__ void partialSM(f32x16& p0, f32x16& p1, float& m_reg, float& mn, float& alpha) {
  constexpr float C = SCALE * 1.4426950408889634f;
  float pmax = p0[0];
#pragma unroll
  for (int r = 1; r < 16; ++r) pmax = fmaxf(pmax, p0[r]);
#pragma unroll
  for (int r = 0; r < 16; ++r) pmax = fmaxf(pmax, p1[r]);
  { auto rr = __builtin_amdgcn_permlane32_swap(__float_as_uint(pmax), __float_as_uint(pmax), false, false);
    pmax = fmaxf(__uint_as_float(rr[0]), __uint_as_float(rr[1])); }
  if (__builtin_expect(__all(pmax - m_reg <= THR / SCALE), 1)) { mn = m_reg; alpha = 1.f; }
  else { mn = fmaxf(m_reg, pmax); alpha = __builtin_amdgcn_exp2f((m_reg - mn) * C); m_reg = mn; }
  const float mnC = -mn * C;
#pragma unroll
  for (int r = 0; r < 16; ++r) p0[r] = fmaf(p0[r], C, mnC);
#pragma unroll
  for (int r = 0; r < 16; ++r) p1[r] = fmaf(p1[r], C, mnC);
#pragma unroll
  for (int r = 0; r < 16; ++r) p0[r] = __builtin_amdgcn_exp2f(p0[r]);
}
__device__ __forceinline__ void finishSM(f32x16& p0, f32x16& p1, float alpha, float& l_reg, bf16x8& pa0, bf16x8& pa1, bf16x8& pa2, bf16x8& pa3) {
#pragma unroll
  for (int r = 0; r < 16; ++r) p1[r] = __builtin_amdgcn_exp2f(p1[r]);
  float ps = 0;
#pragma unroll
  for (int r = 0; r < 16; ++r) ps += p0[r];
#pragma unroll
  for (int r = 0; r < 16; ++r) ps += p1[r];
  { auto rr = __builtin_amdgcn_permlane32_swap(__float_as_uint(ps), __float_as_uint(ps), false, false);
    ps = __uint_as_float(rr[0]) + __uint_as_float(rr[1]); }
  l_reg = l_reg * alpha + ps;
#define PK4(P, BASE, OUT) do { unsigned a0 = cvtpk(P[BASE + 0], P[BASE + 1]), a1 = cvtpk(P[BASE + 2], P[BASE + 3]);   \
    unsigned b0 = cvtpk(P[BASE + 4], P[BASE + 5]), b1 = cvtpk(P[BASE + 6], P[BASE + 7]);                              \
    auto r0 = __builtin_amdgcn_permlane32_swap(a0, b0, false, false); auto r1 = __builtin_amdgcn_permlane32_swap(a1, b1, false, false); \
    u32x4 w = {r0[0], r1[0], r0[1], r1[1]}; OUT = *reinterpret_cast<bf16x8*>(&w); } while (0)
  PK4(p0, 0, pa0); PK4(p0, 8, pa1); PK4(p1, 0, pa2); PK4(p1, 8, pa3);
#undef PK4
}
__device__ __forceinline__ void qkt(f32x16& p0, f32x16& p1, const char* Ks, const bf16x8* qr, int r32, int hi) {
  p0 = f32x16{}; p1 = f32x16{};
#pragma unroll
  for (int d0 = 0; d0 < 4; ++d0) { const int cb = (d0 * 16 + hi * 8) * 2;
    bf16x8 b0 = *reinterpret_cast<const bf16x8*>(Ks + KSWZ(r32, cb));
    bf16x8 b1 = *reinterpret_cast<const bf16x8*>(Ks + KSWZ(32 + r32, cb));
    p0 = __builtin_amdgcn_mfma_f32_32x32x16_bf16(b0, qr[d0], p0, 0, 0, 0);
    p1 = __builtin_amdgcn_mfma_f32_32x32x16_bf16(b1, qr[d0], p1, 0, 0, 0); }
}
__device__ __forceinline__ int v_st(int k, int c) { const int kk = (k & ~0xC) | ((k & 4) << 1) | ((k & 8) >> 1); return ((kk >> 3) * 4 + (c >> 5)) * 512 + ((kk & 7) * 32 + (c & 31)) * 2; }
__device__ __forceinline__ int v_rd_base(int lane) { return ((lane & 3) << 3) | (((lane >> 2) & 3) << 6) | (((lane >> 4) & 1) << 5) | (((lane >> 5) & 1) << 8); }
constexpr int v_rd_off(int d0, int ks, int half) { return d0 * 512 + ks * 4096 + half * 2048; }
template <int OFF> __device__ __forceinline__ s16x4 tr_read(int vb) {
  s16x4 r; asm volatile("ds_read_b64_tr_b16 %0, %1 offset:%2" : "=&v"(r) : "v"(vb), "i"(OFF) : "memory"); return r;
}
template <int D0> __device__ __forceinline__ void pv_one(f32x16& od, int vb, bf16x8 pa0, bf16x8 pa1, bf16x8 pa2, bf16x8 pa3) {
  const s16x4 l0 = tr_read<v_rd_off(D0, 0, 0)>(vb), h0 = tr_read<v_rd_off(D0, 0, 1)>(vb), l1 = tr_read<v_rd_off(D0, 1, 0)>(vb), h1 = tr_read<v_rd_off(D0, 1, 1)>(vb);
  const s16x4 l2 = tr_read<v_rd_off(D0, 2, 0)>(vb), h2 = tr_read<v_rd_off(D0, 2, 1)>(vb), l3 = tr_read<v_rd_off(D0, 3, 0)>(vb), h3 = tr_read<v_rd_off(D0, 3, 1)>(vb);
  asm volatile("s_waitcnt lgkmcnt(0)" ::: "memory"); SBAR();
#define PK(L, H) (bf16x8){L[0], L[1], L[2], L[3], H[0], H[1], H[2], H[3]}
  od = __builtin_amdgcn_mfma_f32_32x32x16_bf16(pa0, PK(l0, h0), od, 0, 0, 0);
  od = __builtin_amdgcn_mfma_f32_32x32x16_bf16(pa1, PK(l1, h1), od, 0, 0, 0);
  od = __builtin_amdgcn_mfma_f32_32x32x16_bf16(pa2, PK(l2, h2), od, 0, 0, 0);
  od = __builtin_amdgcn_mfma_f32_32x32x16_bf16(pa3, PK(l3, h3), od, 0, 0, 0);
#undef PK
}
__device__ __forceinline__ void pv_d0(f32x16* o, int vb, bf16x8 pa0, bf16x8 pa1, bf16x8 pa2, bf16x8 pa3) {
  pv_one<0>(o[0], vb, pa0, pa1, pa2, pa3); pv_one<1>(o[1], vb, pa0, pa1, pa2, pa3); pv_one<2>(o[2], vb, pa0, pa1, pa2, pa3); pv_one<3>(o[3], vb, pa0, pa1, pa2, pa3);
}
__device__ __forceinline__ void attn_unit(const bf16_t* __restrict__ Qb, const bf16_t* __restrict__ Kh, const bf16_t* __restrict__ Vh, bf16_t* __restrict__ Ob, int seq, char* lds) {
  const int tid = threadIdx.x, wid = tid >> 6, lane = tid & 63, r32 = lane & 31, hi = lane >> 5;
  char* V_lds = lds; char* K_lds = lds + 2 * SHM_V;
  float* ws = (float*)(lds + 2 * SHM_V + 2 * SHM_K) + wid * 64; float* li_l = ws; float* al_l = ws + 32;
  float m_reg = -1e30f, l_reg = 0; f32x16 o[4] = {}; bf16x8 qr[4];
  const bf16_t* Qw = Qb + (long)(wid * QBLK + r32) * LD + hi * 8;
#pragma unroll
  for (int d0 = 0; d0 < 4; ++d0) qr[d0] = *reinterpret_cast<const bf16x8*>(Qw + d0 * 16);
  const int sr = tid >> 4, sc = (tid & 15) * 8, vst0 = v_st(sr, sc), vst1 = v_st(32 + sr, sc);
  const int ksr = tid >> 3, ksc = (tid & 7) * 8, kst = KSWZ(ksr, ksc * 2);
  const int vb0 = (int)(uintptr_t)V_lds + v_rd_base(lane);
  struct { bf16x8 vs0, vs1, ks0; } sr_[1];
#define SLOAD(i, k0) do { sr_[i].vs0 = *reinterpret_cast<const bf16x8*>(&Vh[(long)((k0) + sr) * LD + sc]); sr_[i].vs1 = *reinterpret_cast<const bf16x8*>(&Vh[(long)((k0) + 32 + sr) * LD + sc]); \
    sr_[i].ks0 = *reinterpret_cast<const bf16x8*>(&Kh[(long)((k0) + ksr) * LD + ksc]); } while (0)
#define SWRITE(b, i) do { *(bf16x8*)(V_lds + (b) * SHM_V + vst0) = sr_[i].vs0; *(bf16x8*)(V_lds + (b) * SHM_V + vst1) = sr_[i].vs1; \
    *(bf16x8*)(K_lds + (b) * SHM_K + kst) = sr_[i].ks0; } while (0)
#define SWAIT() asm volatile("s_waitcnt vmcnt(0)" ::: "memory")
#define RESC(a) do { if (__any((a) < 1.f)) { if (hi == 0) al_l[r32] = (a); asm volatile("s_waitcnt lgkmcnt(0)" ::: "memory"); \
    _Pragma("unroll") for (int d = 0; d < 4; ++d) _Pragma("unroll") for (int r = 0; r < 16; ++r) o[d][r] *= al_l[crow(r, hi)]; } } while (0)
  f32x16 pA0, pA1, pB0, pB1; float mnA, mnB, alA, alB; bf16x8 pa0, pa1, pa2, pa3; const int NT = seq / KVBLK;
  constexpr int SE = 0, SO = 0;
  SLOAD(SE, 0); asm volatile("s_waitcnt vmcnt(0)" ::: "memory"); SWRITE(0, SE); __syncthreads();
  qkt(pA0, pA1, K_lds, qr, r32, hi); partialSM(pA0, pA1, m_reg, mnA, alA);
  SLOAD(SO, KVBLK);
  SWAIT(); SWRITE(1, SO); __syncthreads();
  for (int j = 1; j + 1 < NT; j += 2) {
    SBAR(); qkt(pB0, pB1, K_lds + SHM_K, qr, r32, hi);
    finishSM(pA0, pA1, alA, l_reg, pa0, pa1, pa2, pa3); SBAR();
    SLOAD(SO, (j + 1) * KVBLK); SBAR();
    pv_d0(o, vb0, pa0, pa1, pa2, pa3); partialSM(pB0, pB1, m_reg, mnB, alB);
    __syncthreads(); SWAIT(); SWRITE(0, SE);
    RESC(alB); __syncthreads();
    SBAR(); qkt(pA0, pA1, K_lds, qr, r32, hi);
    finishSM(pB0, pB1, alB, l_reg, pa0, pa1, pa2, pa3); SBAR();
    SLOAD(SE, (j + 2) * KVBLK); SBAR();
    pv_d0(o, vb0 + SHM_V, pa0, pa1, pa2, pa3); partialSM(pA0, pA1, m_reg, mnA, alA);
    __syncthreads(); SWAIT(); SWRITE(1, SO);
    RESC(alA); __syncthreads();
  }
  SBAR(); qkt(pB0, pB1, K_lds + SHM_K, qr, r32, hi);
  finishSM(pA0, pA1, alA, l_reg, pa0, pa1, pa2, pa3); SBAR();
  pv_d0(o, vb0, pa0, pa1, pa2, pa3); partialSM(pB0, pB1, m_reg, mnB, alB);
  __syncthreads(); RESC(alB);
  finishSM(pB0, pB1, alB, l_reg, pa0, pa1, pa2, pa3); SBAR();
  pv_d0(o, vb0 + SHM_V, pa0, pa1, pa2, pa3);
  if (hi == 0) li_l[r32] = l_reg; asm volatile("s_waitcnt lgkmcnt(0)" ::: "memory");
  float rli[16];
#pragma unroll
  for (int r = 0; r < 16; ++r) rli[r] = __builtin_amdgcn_rcpf(li_l[crow(r, hi)]);
  bf16_t* Ow = Ob + (long)(wid * QBLK) * LDO;
#pragma unroll
  for (int r = 0; r < 16; ++r) { const int orow = crow(r, hi);
#pragma unroll
    for (int d0 = 0; d0 < 4; ++d0) Ow[(long)orow * LDO + d0 * 32 + r32] = (bf16_t)(cvtpk(o[d0][r] * rli[r], 0.f) & 0xffffu); }
  __syncthreads();
#undef SLOAD
#undef SWRITE
#undef SWAIT
#undef RESC
}
}

constexpr int SCAN_ROWB = 272, SCAN_WAVE_LDS = 32 * SCAN_ROWB;
__device__ __forceinline__ void scan_seq(const unsigned char* wsb, int rowbase, int L, int g, int dir, char* ldsw, int lane) {
  const int j = lane & 31, hi = lane >> 5, l16 = lane & 15, q4 = lane >> 4;
  const float* LAMp = (const float*)(wsb + OFF_LAM) + ((size_t)(dir * 32 + g) * 64 + lane) * 2;
  const float lr = LAMp[0], li = LAMp[1];
  const bf16_t* BBp = (const bf16_t*)(wsb + OFF_BB) + (size_t)(dir * 32 + g) * 128 * 16;
  const bf16_t* CBp = (const bf16_t*)(wsb + OFF_CB) + (size_t)(dir * 32 + g) * 128 * 16;
  bf16x8 bb[4], cb[4];
#pragma unroll
  for (int nb = 0; nb < 4; ++nb) bb[nb] = *(const bf16x8*)(BBp + (nb * 32 + j) * 16 + 8 * hi);
#pragma unroll
  for (int kk = 0; kk < 4; ++kk) cb[kk] = *(const bf16x8*)(CBp + (kk * 16 + l16) * 32 + 8 * q4);
  const bf16_t* XS = (const bf16_t*)(wsb + OFF_XS) + (size_t)rowbase * 512 + g * 16;
  bf16_t* Y = (bf16_t*)(wsb + (dir ? OFF_YB : OFF_YF)) + (size_t)rowbase * 512 + g * 16;
  float hr = 0.f, him = 0.f;
  const int nch = L / 32;
  auto tok = [&](int c, int t) { const int p = c * 32 + t; return dir ? (L - 1 - p) : p; };
  bf16x8 a_next = *(const bf16x8*)(XS + (size_t)tok(0, j) * 512 + 8 * hi);
  for (int c = 0; c < nch; ++c) {
    const bf16x8 a = a_next;
    if (c + 1 < nch) a_next = *(const bf16x8*)(XS + (size_t)tok(c + 1, j) * 512 + 8 * hi);
    const f32x16 z = {};
    f32x16 d0 = __builtin_amdgcn_mfma_f32_32x32x16_bf16(a, bb[0], z, 0, 0, 0);
    f32x16 d1 = __builtin_amdgcn_mfma_f32_32x32x16_bf16(a, bb[1], z, 0, 0, 0);
    f32x16 d2 = __builtin_amdgcn_mfma_f32_32x32x16_bf16(a, bb[2], z, 0, 0, 0);
    f32x16 d3 = __builtin_amdgcn_mfma_f32_32x32x16_bf16(a, bb[3], z, 0, 0, 0);
#pragma unroll
    for (int a4 = 0; a4 < 4; ++a4) {
      float re[2][4], im[2][4];
#pragma unroll
      for (int i = 0; i < 4; ++i) { const int r = 4 * a4 + i;
        auto s0 = __builtin_amdgcn_permlane32_swap(__float_as_uint(d0[r]), __float_as_uint(d2[r]), false, false);
        auto s1 = __builtin_amdgcn_permlane32_swap(__float_as_uint(d1[r]), __float_as_uint(d3[r]), false, false);
        re[0][i] = __uint_as_float(s0[0]); re[1][i] = __uint_as_float(s0[1]); im[0][i] = __uint_as_float(s1[0]); im[1][i] = __uint_as_float(s1[1]); }
#pragma unroll
      for (int h = 0; h < 2; ++h)
#pragma unroll
        for (int i = 0; i < 4; ++i) { const int t = 8 * a4 + 4 * h + i;
          const float nr = fmaf(lr, hr, fmaf(-li, him, re[h][i])), ni = fmaf(lr, him, fmaf(li, hr, im[h][i]));
          hr = nr; him = ni;
          *(unsigned*)(ldsw + t * SCAN_ROWB + lane * 4) = cvtpk(hr, him); }
    }
    __builtin_amdgcn_wave_barrier();
#pragma unroll
    for (int tb = 0; tb < 2; ++tb) {
      f32x4 acc = {0.f, 0.f, 0.f, 0.f};
#pragma unroll
      for (int kk = 0; kk < 4; ++kk) { const bf16x8 hf = *(const bf16x8*)(ldsw + (tb * 16 + l16) * SCAN_ROWB + (kk * 32 + 8 * q4) * 2);
        acc = __builtin_amdgcn_mfma_f32_16x16x32_bf16(cb[kk], hf, acc, 0, 0, 0); }
      u32x2 w; w.x = cvtpk(acc[0], acc[1]); w.y = cvtpk(acc[2], acc[3]);
      *(u32x2*)(Y + (size_t)tok(c, tb * 16 + l16) * 512 + 4 * q4) = w;
    }
    __builtin_amdgcn_wave_barrier();
  }
}

__device__ __forceinline__ int win_drow(int n) {
  if (n < 1024 || n >= 2048) return n;
  const int c = n & 255, tb = n - c, gi = c >> 6, d = c & 63;
  return tb + (d >> 5) * 128 + gi * 32 + (d & 31);
}
__device__ __forceinline__ void transpose_job(const float* src, int ldn, int K, int k0, int n0, bf16_t* dst, const float* gscale, bool perm, float* tile) {
  const int tid = threadIdx.x;
#pragma unroll
  for (int pss = 0; pss < 2; ++pss) { const int kr = (tid >> 4) + pss * 32, nc = (tid & 15) * 4;
    f32x4 v = *(const f32x4*)(src + (size_t)(k0 + kr) * ldn + n0 + nc);
    if (gscale) v = v * gscale[k0 + kr];
    tile[kr * 65 + nc] = v[0]; tile[kr * 65 + nc + 1] = v[1]; tile[kr * 65 + nc + 2] = v[2]; tile[kr * 65 + nc + 3] = v[3]; }
  __syncthreads();
  { const int nl = tid >> 3, kc = (tid & 7) * 8; f32x4 a, b;
#pragma unroll
    for (int i = 0; i < 4; ++i) { a[i] = tile[(kc + i) * 65 + nl]; b[i] = tile[(kc + 4 + i) * 65 + nl]; }
    const int n = n0 + nl, dr = perm ? win_drow(n) : n;
    *(u32x4*)(dst + (size_t)dr * K + k0 + kc) = pack8(a, b); }
  __syncthreads();
}

__global__ void __launch_bounds__(512, 2) fwd_mega(Params p) {
  extern __shared__ __attribute__((aligned(16))) unsigned char smem[];
  cg::grid_group grid = cg::this_grid();
  const int tid = threadIdx.x, lane = tid & 63, wid = tid >> 6, G = gridDim.x, bx = blockIdx.x;
  unsigned char* ws = p.ws;
  bf16_t* gsga = (bf16_t*)p.out;
  const int lo = p.ph_lo, hi_ = p.ph_hi;
#ifndef PHMASK
#define PHMASK 255
#endif
#define IN(k) (((PHMASK >> (k)) & 1) && lo <= (k) && (k) < hi_)
#ifdef DUMP
#undef IN
#define IN(k) (((k) == 8 || ((PHMASK >> (k)) & 1)) && lo <= (k) && (k) < hi_)
#endif
#define SEAM(k) do { if (IN(k) && IN((k) + 1)) grid.sync(); } while (0)

  if (IN(0)) {
    for (int r = bx * 8 + wid; r < MT; r += G * 8) {
      const float* xr = r < MP ? p.x_p + (size_t)r * 1024 : p.x_s + (size_t)(r - MP) * 1024;
      bf16_t* xb = (bf16_t*)(ws + OFF_XB) + (size_t)r * 1024; float s = 0.f;
#pragma unroll
      for (int i = 0; i < 4; ++i) { const f32x4 v = *(const f32x4*)(xr + i * 256 + lane * 4); s += v[0] * v[0] + v[1] * v[1] + v[2] * v[2] + v[3] * v[3];
        u32x2 w; w.x = cvtpk(v[0], v[1]); w.y = cvtpk(v[2], v[3]); *(u32x2*)(xb + i * 256 + lane * 4) = w; }
#pragma unroll
      for (int o = 32; o > 0; o >>= 1) s += __shfl_xor(s, o);
      if (lane == 0) ((float*)(ws + OFF_RSTD))[r] = rsqrtf(s * (1.f / 1024.f) + 1e-6f);
    }
    for (int jb = bx; jb < 1856; jb += G) {
      float* tile = (float*)smem;
      if (jb < 1280) transpose_job(p.w_in, NIN, 1024, (jb / 80) * 64, (jb % 80) * 64, (bf16_t*)(ws + OFF_WIN), p.norm_g, true, tile);
      else if (jb < 1344) { const int q = jb - 1280; transpose_job(p.w_glu, 512, 512, (q / 8) * 64, (q % 8) * 64, (bf16_t*)(ws + OFF_WGLU), nullptr, false, tile); }
      else if (jb < 1600) { const int q = jb - 1344, i = q / 128, r = q % 128;
        transpose_job(p.w_branch + (size_t)i * 512 * 1024, 1024, 512, (r / 16) * 64, (r % 16) * 64, (bf16_t*)(ws + OFF_WBR) + (size_t)i * 1024 * 512, nullptr, false, tile); }
      else { const int q = jb - 1600; transpose_job(p.w_out, 1024, 1024, (q / 16) * 64, (q % 16) * 64, (bf16_t*)(ws + OFF_WOUT), nullptr, false, tile); }
    }
    const int gt = bx * 512 + tid, GT = G * 512;
    for (int i = gt; i < 8192 * 32; i += GT) { const int pos = i >> 5, k = i & 31;
      const float ex = (float)k * 2.0f / 64.0f; const float invf = (float)(1.0 / pow(10000.0, (double)ex));
      const float ang = (float)pos * invf; const double rev = (double)ang * 0.15915494309189535; const float fr2 = (float)(2.0 * (rev - floor(rev)));
      float* rt = (float*)(ws + OFF_ROT) + (size_t)pos * 64; rt[k] = cospif(fr2); rt[32 + k] = sinpif(fr2); }
    for (int i = gt; i < MT; i += GT) ((float*)(ws + OFF_SSQ))[i] = 0.f;
    if (gt < 4096) { const int dir = gt >> 11, g = (gt >> 6) & 31, s = gt & 63;
      const double dt = exp((double)p.log_dt[dir * 32 + g]);
      const double ar = (double)p.a_re[gt], ai = (double)p.a_im[gt];
      const double mag = exp(ar * dt); const double ph = ai * dt * 0.3183098861837907; const float ph2 = (float)(ph - 2.0 * floor(ph * 0.5));
      const double lr = mag * (double)cospif(ph2), li = mag * (double)sinpif(ph2);
      float* lm = (float*)(ws + OFF_LAM) + (size_t)gt * 2; lm[0] = (float)lr; lm[1] = (float)li;
      const double den = ar * ar + ai * ai, cr = ((lr - 1.0) * ar + li * ai) / den, ci = (li * ar - (lr - 1.0) * ai) / den;
      bf16_t* BBp = (bf16_t*)(ws + OFF_BB) + (size_t)(dir * 32 + g) * 128 * 16;
      const int nbr = (s >> 5) * 2, jj = s & 31;
      for (int c = 0; c < 16; ++c) { const double br = (double)p.b_re[(size_t)gt * 16 + c], bi = (double)p.b_im[(size_t)gt * 16 + c];
        BBp[((nbr) * 32 + jj) * 16 + c] = (bf16_t)(cvtpk((float)(cr * br - ci * bi), 0.f) & 0xffffu);
        BBp[((nbr + 1) * 32 + jj) * 16 + c] = (bf16_t)(cvtpk((float)(cr * bi + ci * br), 0.f) & 0xffffu); }
      bf16_t* CBp = (bf16_t*)(ws + OFF_CB) + (size_t)(dir * 32 + g) * 128 * 16;
      for (int c = 0; c < 16; ++c) { const float cre = p.c_re[((size_t)(dir * 32 + g) * 16 + c) * 64 + s], cim = p.c_im[((size_t)(dir * 32 + g) * 16 + c) * 64 + s];
        const int k = 2 * s, kk = k >> 5, kp = k & 31;
        *(unsigned*)(CBp + (kk * 16 + c) * 32 + kp) = cvtpk(cre, -cim); }
    }
    if (gt == 0) { float s1 = 0.f, s2 = 0.f; for (int i = 0; i < 64; ++i) { s1 += p.lq1[i] * p.lk1[i]; s2 += p.lq2[i] * p.lk2[i]; }
      ((float*)(ws + OFF_CTL))[8] = expf(s1) - expf(s2) + 0.2f; ((unsigned*)(ws + OFF_CTL))[0] = 0u; }
  }
  SEAM(0);

  if (IN(1)) {
    pg8::Gemm g{(const bf16_t*)(ws + OFF_XB), (const bf16_t*)(ws + OFF_WIN), MT, NIN, 1024}; pg8::StaticOrder S; S.init(MT, NIN, G, bx);
    EpiIn E{ws, gsga, (const float*)(ws + OFF_RSTD), (const float*)(ws + OFF_ROT)};
    pg8::gemm_phase<EpiIn>((LAS unsigned char*)smem, g, S, E);
  }
  SEAM(1);

  if (IN(2)) {
    unsigned* ctr = (unsigned*)(ws + OFF_CTL); volatile unsigned* bc = (volatile unsigned*)(smem + LDS_BYTES - 16);
    const bf16_t* QB = (const bf16_t*)(ws + OFF_QB); const bf16_t* KB = (const bf16_t*)(ws + OFF_KB); const bf16_t* VB = (const bf16_t*)(ws + OFF_VB); bf16_t* AO = (bf16_t*)(ws + OFF_AO);
    for (;;) {
      __syncthreads();
      if (tid == 0) *bc = atomicAdd(ctr, 1u);
      __syncthreads();
      const int it = (int)*bc;
      if (it >= 2688) break;
      if (it < 64 || (it >= 2112 && it < 2176)) {
        const bool lng = it < 64; const int s = (lng ? it : it - 2112) * 8 + wid;
        const int b = s >> 6, g = (s >> 1) & 31, dir = s & 1;
        scan_seq(ws, lng ? MP + b * 8192 : b * 2048, lng ? 8192 : 2048, g, dir, (char*)smem + wid * SCAN_WAVE_LDS, lane);
      } else {
        const bool lng = it < 2112; const int u = lng ? it - 64 : it - 2176;
        const int nqb = lng ? 32 : 8, L = lng ? 8192 : 2048;
        const int qb = u % nqb, bh = u / nqb, vh = bh & 7, b = bh >> 3;
        const size_t rb = lng ? (size_t)MP + (size_t)b * 8192 : (size_t)b * 2048;
        att::attn_unit(QB + (rb + qb * 256) * 512 + vh * 64, KB + rb * 512 + vh * 64, VB + rb * 512 + (vh >> 1) * 128, AO + (rb + qb * 256) * 1024 + vh * 128, L, (char*)smem);
      }
    }
  }
  SEAM(2);

  if (IN(3)) {
    const float lam = ((const float*)(ws + OFF_CTL))[8];
    const bf16_t* YF = (const bf16_t*)(ws + OFF_YF); const bf16_t* YB = (const bf16_t*)(ws + OFF_YB); const bf16_t* XS = (const bf16_t*)(ws + OFF_XS);
    const bf16_t* AO = (const bf16_t*)(ws + OFF_AO); const bf16_t* ZA = (const bf16_t*)(ws + OFF_ZA);
    bf16_t* YSG = (bf16_t*)(ws + OFF_YSG); bf16_t* YAN = (bf16_t*)(ws + OFF_YAN);
    const int c0 = lane * 8; const f32x4 dk0 = *(const f32x4*)(p.ssm_d + c0), dk1 = *(const f32x4*)(p.ssm_d + c0 + 4);
    const int h = lane >> 4, e0 = (lane & 15) * 8; const f32x4 sg0 = *(const f32x4*)(p.subln_g + e0) * 0.8f, sg1 = *(const f32x4*)(p.subln_g + e0 + 4) * 0.8f;
    for (int r = bx * 8 + wid; r < MT; r += G * 8) {
      f32x4 f0, f1, b0, b1, x0, x1;
      unpack8(*(const u32x4*)(YF + (size_t)r * 512 + c0), f0, f1); unpack8(*(const u32x4*)(YB + (size_t)r * 512 + c0), b0, b1); unpack8(*(const u32x4*)(XS + (size_t)r * 512 + c0), x0, x1);
      f32x4 v0 = f0 + b0 + dk0 * x0, v1 = f1 + b1 + dk1 * x1;
#pragma unroll
      for (int i = 0; i < 4; ++i) { v0[i] = gelu_tanh(v0[i]); v1[i] = gelu_tanh(v1[i]); }
      f32x4 p0, p1, q0, q1, z0, z1;
      unpack8(*(const u32x4*)(AO + (size_t)r * 1024 + (2 * h) * 128 + e0), p0, p1); unpack8(*(const u32x4*)(AO + (size_t)r * 1024 + (2 * h + 1) * 128 + e0), q0, q1);
      unpack8(*(const u32x4*)(ZA + (size_t)r * 512 + h * 128 + e0), z0, z1);
      *(u32x4*)(YSG + (size_t)r * 512 + c0) = pack8(v0, v1);
      f32x4 o0 = p0 - lam * q0, o1 = p1 - lam * q1;
      float ss = 0.f;
#pragma unroll
      for (int i = 0; i < 4; ++i) ss += o0[i] * o0[i] + o1[i] * o1[i];
      ss += __shfl_xor(ss, 1); ss += __shfl_xor(ss, 2); ss += __shfl_xor(ss, 4); ss += __shfl_xor(ss, 8);
      const float rn = rsqrtf(ss * (1.f / 128.f) + 1e-5f);
      o0 = o0 * rn * sg0 * z0; o1 = o1 * rn * sg1 * z1;
      *(u32x4*)(YAN + (size_t)r * 512 + h * 128 + e0) = pack8(o0, o1);
    }
  }
  SEAM(3);

  if (IN(4)) {
    pg8::Gemm g{(const bf16_t*)(ws + OFF_YSG), (const bf16_t*)(ws + OFF_WGLU), MT, 512, 512}; pg8::StaticOrder S; S.init(MT, 512, G, bx);
    EpiGlu E{(const bf16_t*)(ws + OFF_YSG), (const bf16_t*)(ws + OFF_ZS), p.b_glu, (bf16_t*)(ws + OFF_YS2)};
    pg8::gemm_phase<EpiGlu>((LAS unsigned char*)smem, g, S, E);
  }
  SEAM(4);

  if (IN(5)) {
    pg8::StaticOrder S; S.init(MT, 1024, G, bx);
    { pg8::Gemm g{(const bf16_t*)(ws + OFF_YS2), (const bf16_t*)(ws + OFF_WBR), MT, 1024, 512};
      EpiBr<0> E{gsga, (bf16_t*)(ws + OFF_PS), nullptr}; pg8::gemm_phase<EpiBr<0>>((LAS unsigned char*)smem, g, S, E); }
    __syncthreads();
    { pg8::Gemm g{(const bf16_t*)(ws + OFF_YAN), (const bf16_t*)(ws + OFF_WBR) + (size_t)1024 * 512, MT, 1024, 512};
      EpiBr<1> E{gsga + (size_t)MT * 1024, (bf16_t*)(ws + OFF_PS), (bf16_t*)(ws + OFF_MG)}; pg8::gemm_phase<EpiBr<1>>((LAS unsigned char*)smem, g, S, E); }
  }
  SEAM(5);

  if (IN(6)) {
    pg8::Gemm g{(const bf16_t*)(ws + OFF_MG), (const bf16_t*)(ws + OFF_WOUT), MT, 1024, 1024}; pg8::StaticOrder S; S.init(MT, 1024, G, bx);
    EpiOut E{p.x_p, p.x_s, p.out, (float*)(ws + OFF_SSQ)};
    pg8::gemm_phase<EpiOut>((LAS unsigned char*)smem, g, S, E);
  }
  SEAM(6);

  if (IN(7)) {
    const float* ssq = (const float*)(ws + OFF_SSQ);
    f32x4 fg[4];
#pragma unroll
    for (int i = 0; i < 4; ++i) fg[i] = *(const f32x4*)(p.final_g + i * 256 + lane * 4);
    for (int r = bx * 8 + wid; r < MT; r += G * 8) {
      const float rn = rsqrtf(ssq[r] * (1.f / 1024.f) + 1e-6f); float* orow = p.out + (size_t)r * 1024;
#pragma unroll
      for (int i = 0; i < 4; ++i) { f32x4 v = *(f32x4*)(orow + i * 256 + lane * 4); *(f32x4*)(orow + i * 256 + lane * 4) = v * rn * fg[i]; }
    }
  }

#ifdef DUMP
  if (IN(8)) {
    for (int r = bx * 8 + wid; r < MT; r += G * 8) {
      float* orow = p.out + (size_t)r * 1024;
      for (int c = lane; c < 512; c += 64) {
        float a = 0.f, b = 0.f; const size_t i5 = (size_t)r * 512 + c, i1 = (size_t)r * 1024 + c;
#define BF(off, idx) bflo((unsigned)((const bf16_t*)(ws + (off)))[idx])
        if (DUMP == 1) { a = BF(OFF_XS, i5) + BF(OFF_ZS, i5) + BF(OFF_VB, i5); b = BF(OFF_QB, i5) + BF(OFF_KB, i5) + BF(OFF_ZA, i5); }
        if (DUMP == 2) { a = BF(OFF_YF, i5) + BF(OFF_YB, i5); b = BF(OFF_AO, i1) + BF(OFF_AO, i1 + 512); }
        if (DUMP == 3) { a = BF(OFF_YSG, i5) + BF(OFF_YAN, i5) + BF(OFF_YS2, i5); b = BF(OFF_MG, i1) + BF(OFF_MG, i1 + 512); }
        if (DUMP == 4) { a = BF(OFF_YF, i5); b = BF(OFF_YB, i5); }
        if (DUMP == 5) { a = BF(OFF_AO, i1); b = BF(OFF_AO, i1 + 512); }
#undef BF
        orow[c] = a; orow[512 + c] = b;
      }
    }
  }
#endif
#undef IN
#undef SEAM
}

#ifndef N_LAUNCH_PER_PHASE
#define N_LAUNCH_PER_PHASE 1
#endif
extern "C" void kernel_launch(void* const* d_in, const int* in_sizes, int n_in, void* d_out, int out_size, void* d_ws, size_t ws_size, hipStream_t stream) {
  static int grid = 0;
  if (grid == 0) {
    if (n_in != 22 || out_size != MT * 1024 || ws_size < WS_END) { fprintf(stderr, "kernel_launch: unexpected shapes n_in %d out %d ws %zu (need %zu)\n", n_in, out_size, ws_size, (size_t)WS_END); grid = -1; return; }
    int dev = 0, cus = 0, per_cu = 0;
    hipGetDevice(&dev); hipDeviceGetAttribute(&cus, hipDeviceAttributeMultiprocessorCount, dev);
    if (hipFuncSetAttribute((const void*)fwd_mega, hipFuncAttributeMaxDynamicSharedMemorySize, LDS_BYTES) != hipSuccess) { fprintf(stderr, "kernel_launch: hipFuncSetAttribute failed\n"); grid = -1; return; }
    if (hipOccupancyMaxActiveBlocksPerMultiprocessor(&per_cu, (const void*)fwd_mega, 512, LDS_BYTES) != hipSuccess || per_cu < 1) { fprintf(stderr, "kernel_launch: occupancy query says %d\n", per_cu); per_cu = 1; }
    (void)hipGetLastError();
    grid = cus * 1;
  }
  if (grid < 0) return;
  Params p{};
  p.x_p = (const float*)d_in[0]; p.x_s = (const float*)d_in[1]; p.norm_g = (const float*)d_in[2]; p.w_in = (const float*)d_in[3];
  p.a_re = (const float*)d_in[4]; p.a_im = (const float*)d_in[5]; p.log_dt = (const float*)d_in[6]; p.b_re = (const float*)d_in[7]; p.b_im = (const float*)d_in[8];
  p.c_re = (const float*)d_in[9]; p.c_im = (const float*)d_in[10]; p.ssm_d = (const float*)d_in[11]; p.w_glu = (const float*)d_in[12]; p.b_glu = (const float*)d_in[13];
  p.lq1 = (const float*)d_in[14]; p.lk1 = (const float*)d_in[15]; p.lq2 = (const float*)d_in[16]; p.lk2 = (const float*)d_in[17]; p.subln_g = (const float*)d_in[18];
  p.w_branch = (const float*)d_in[19]; p.w_out = (const float*)d_in[20]; p.final_g = (const float*)d_in[21];
  p.out = (float*)d_out; p.ws = (unsigned char*)d_ws;
#if N_LAUNCH_PER_PHASE
  #ifdef DUMP
  const int nph = 9;
#else
  const int nph = 8;
#endif
  for (int ph = 0; ph < nph; ++ph) { p.ph_lo = ph; p.ph_hi = ph + 1; hipLaunchKernelGGL(fwd_mega, dim3(grid), dim3(512), LDS_BYTES, stream, p); }
#else
  p.ph_lo = 0; p.ph_hi = 8;
  void* args[] = {&p};
  hipError_t e = hipLaunchCooperativeKernel((const void*)fwd_mega, dim3(grid), dim3(512), args, LDS_BYTES, stream);
  if (e != hipSuccess) fprintf(stderr, "cooperative launch failed: %s (grid %d)\n", hipGetErrorString(e), grid);
#endif
}
```

```cpp
#include <hip/hip_runtime.h>
#include <hip/hip_cooperative_groups.h>
#include <cstdio>
#include <cstdint>
namespace cg = cooperative_groups;

#define LAS __attribute__((address_space(3)))
typedef unsigned short bf16_t;
typedef short bf16x8 __attribute__((ext_vector_type(8)));
typedef short s16x4 __attribute__((ext_vector_type(4)));
typedef float f32x4 __attribute__((ext_vector_type(4)));
typedef float f32x16 __attribute__((ext_vector_type(16)));
typedef unsigned u32x4 __attribute__((ext_vector_type(4)));
typedef unsigned u32x2 __attribute__((ext_vector_type(2)));

constexpr int DM = 1024, NIN = 5120, MP = 8 * 2048, MS = 8 * 8192, MT = MP + MS;
constexpr size_t UB = (size_t)MT * 512 * 2;
constexpr size_t OFF_XB = 0;
constexpr size_t OFF_XS = 2 * UB, OFF_ZS = 3 * UB, OFF_QB = 4 * UB, OFF_KB = 5 * UB, OFF_VB = 6 * UB, OFF_ZA = 7 * UB;
constexpr size_t OFF_YF = 8 * UB, OFF_YB = 9 * UB;
constexpr size_t OFF_YSG = OFF_QB, OFF_YAN = OFF_KB, OFF_YS2 = OFF_VB, OFF_AO = OFF_XB, OFF_PS = OFF_XB, OFF_MG = OFF_YF;
constexpr size_t OFF_WIN = 10 * UB;
constexpr size_t OFF_WGLU = OFF_WIN + (size_t)NIN * DM * 2;
constexpr size_t OFF_WBR = OFF_WGLU + 512 * 512 * 2;
constexpr size_t OFF_WOUT = OFF_WBR + 2 * 1024 * 512 * 2;
constexpr size_t OFF_RSTD = OFF_WOUT + 1024 * 1024 * 2;
constexpr size_t OFF_SSQ = OFF_RSTD + (size_t)MT * 4;
constexpr size_t OFF_ROT = OFF_SSQ + (size_t)MT * 4;
constexpr size_t OFF_LAM = OFF_ROT + 8192 * 64 * 4;
constexpr size_t OFF_BB = OFF_LAM + 2 * 32 * 64 * 2 * 4;
constexpr size_t OFF_CB = OFF_BB + 2 * 32 * 128 * 16 * 2;
constexpr size_t OFF_CTL = OFF_CB + 2 * 32 * 128 * 16 * 2;
constexpr size_t WS_END = OFF_CTL + 256;
constexpr int LDS_BYTES = 131072;

struct Params {
  const float* x_p; const float* x_s; const float* norm_g; const float* w_in;
  const float* a_re; const float* a_im; const float* log_dt; const float* b_re; const float* b_im;
  const float* c_re; const float* c_im; const float* ssm_d; const float* w_glu; const float* b_glu;
  const float* lq1; const float* lk1; const float* lq2; const float* lk2; const float* subln_g;
  const float* w_branch; const float* w_out; const float* final_g;
  float* out; unsigned char* ws; int ph_lo, ph_hi;
};

typedef __bf16 bf16x2_t __attribute__((ext_vector_type(2)));
typedef float f32x2_t __attribute__((ext_vector_type(2)));
__device__ __forceinline__ unsigned cvtpk(float lo, float hi) { f32x2_t v = {lo, hi}; bf16x2_t b = __builtin_convertvector(v, bf16x2_t); return *reinterpret_cast<unsigned*>(&b); }
__device__ __forceinline__ float bflo(unsigned w) { return __uint_as_float(w << 16); }
__device__ __forceinline__ float bfhi(unsigned w) { return __uint_as_float(w & 0xffff0000u); }
__device__ __forceinline__ float sigmoidf_(float x) { return __builtin_amdgcn_rcpf(1.f + __builtin_amdgcn_exp2f(-1.4426950408889634f * x)); }
__device__ __forceinline__ float siluf_(float x) { return x * sigmoidf_(x); }
__device__ __forceinline__ float gelu_tanh(float x) { const float u = x + 0.044715f * x * x * x; return x * sigmoidf_(1.5957691216057308f * u); }
__device__ __forceinline__ u32x4 pack8(f32x4 a, f32x4 b) { u32x4 w; w.x = cvtpk(a[0], a[1]); w.y = cvtpk(a[2], a[3]); w.z = cvtpk(b[0], b[1]); w.w = cvtpk(b[2], b[3]); return w; }
__device__ __forceinline__ void unpack8(u32x4 w, f32x4& a, f32x4& b) { a = (f32x4){bflo(w.x), bfhi(w.x), bflo(w.y), bfhi(w.y)}; b = (f32x4){bflo(w.z), bfhi(w.z), bflo(w.w), bfhi(w.w)}; }
__device__ __forceinline__ int row_pos(int r) { return r < MP ? (r & 2047) : (r & 8191); }

namespace pg8 {
constexpr int BM = 256, BK = 64, HALF = 128, HTB = HALF * BK * 2, STAGE_BYTES = 8 * HTB, NXCD = 8, WGM = 8;
__host__ __device__ __forceinline__ int lds_byte(int r, int c) { const int st = (r >> 4) * 2 + (c >> 5), rr = r & 15, cc = c & 31, ob = rr * 64 + cc * 2; return st * 1024 + (ob ^ (((ob >> 9) & 1) << 5)); }
__host__ __device__ __forceinline__ void stage_rc(int b, int& R, int& C) { const int st = b / 1024, sb = b % 1024, swz = sb ^ (((sb >> 9) & 1) << 5); R = (st >> 1) * 16 + swz / 64; C = (st & 1) * 32 + (swz % 64) / 2; }
__host__ __device__ __forceinline__ int perm32(int rho) { const int n = rho >> 4, i = rho & 15; return 8 * (i >> 2) + 4 * n + (i & 3); }
struct Unit { int pm, pn; };
struct Gemm { const bf16_t* A; const bf16_t* Bt; int M, N, K; };
struct StaticOrder {
  int nM, nN, nwg, G, c;
  __device__ void init(int M, int N, int G_, int c_) { nM = M / BM; nN = N / BM; nwg = nM * nN; G = G_; c = c_; }
  __device__ bool next(int i, Unit& u) const {
    const long L = (long)i * G + c; if (L >= nwg) return false;
    int wgid = (int)L; { const int q = nwg / NXCD, r = nwg % NXCD, xcd = wgid % NXCD, off = wgid / NXCD; wgid = (xcd < r ? xcd * (q + 1) : r * (q + 1) + (xcd - r) * q) + off; }
    const int nig = WGM * nN, gid = wgid / nig, fm = gid * WGM, gsz = (nM - fm) < WGM ? (nM - fm) : WGM;
    u.pm = fm + ((wgid % nig) % gsz); u.pn = (wgid % nig) / gsz; return true;
  }
};
template <class Epi>
__device__ __forceinline__ void gemm_phase(LAS unsigned char* lds, const Gemm g, const StaticOrder& S, const Epi& E) {
  const int tid = threadIdx.x, wid = __builtin_amdgcn_readfirstlane(tid >> 6), lane = tid & 63, wr = wid >> 2, wc = wid & 3, fr = lane & 15, fq = lane >> 4;
  const int K = g.K, nt = K / BK;
  unsigned voffA[2], voffB[2];
#pragma unroll
  for (int i = 0; i < 2; ++i) { int R, C; stage_rc(tid * 16 + i * 8192, R, C); const int Rb = Epi::PERM ? ((R & ~31) + perm32(R & 31)) : R;
    voffA[i] = (unsigned)(R * K + C) * 2u; voffB[i] = (unsigned)(Rb * K + C) * 2u; }
  const size_t kstep = (size_t)(BK * 2), hstep = (size_t)HALF * K * 2, tstep = 2 * hstep;
  const unsigned ldsw = (unsigned)wid * 1024u;
  const int aoff = lds_byte(wr * 64 + fr, fq * 8), boff = lds_byte(wc * 32 + fr, fq * 8);
#define PG8_SA(b, h) (((b) * 2 + (h)) * HTB)
#define PG8_SB(b, h) ((4 + (b) * 2 + (h)) * HTB)
#define PG8_STAGE(bufoff, gbase, voff) do { _Pragma("unroll") for (int _i = 0; _i < 2; ++_i) \
    __builtin_amdgcn_global_load_lds((const unsigned*)((const char*)(gbase) + (voff)[_i]), (LAS unsigned*)(lds + (bufoff) + ldsw + _i * 8192), 16, 0, 0); } while (0)
#define PG8_LDA(dst, b, h) do { _Pragma("unroll") for (int m = 0; m < 4; ++m) _Pragma("unroll") for (int k = 0; k < 2; ++k) dst[m][k] = *(const LAS bf16x8*)(lds + PG8_SA(b, h) + aoff + m * 2048 + k * 1024); } while (0)
#define PG8_LDB(dst, b, h) do { _Pragma("unroll") for (int n = 0; n < 2; ++n) _Pragma("unroll") for (int k = 0; k < 2; ++k) dst[n][k] = *(const LAS bf16x8*)(lds + PG8_SB(b, h) + boff + n * 2048 + k * 1024); } while (0)
#define PG8_MMA(ai, bj, At, Bt) do { __builtin_amdgcn_s_setprio(1); _Pragma("unroll") for (int m = 0; m < 4; ++m) _Pragma("unroll") for (int n = 0; n < 2; ++n) _Pragma("unroll") for (int k = 0; k < 2; ++k) \
    acc[ai][bj][m][n] = __builtin_amdgcn_mfma_f32_16x16x32_bf16(Bt[n][k], At[m][k], acc[ai][bj][m][n], 0, 0, 0); __builtin_amdgcn_s_setprio(0); } while (0)
#define PG8_WAIT_V(n) asm volatile("s_waitcnt vmcnt(" #n ")" ::: "memory")
#define PG8_WAIT_L(n) asm volatile("s_waitcnt lgkmcnt(" #n ")" ::: "memory")
#define PG8_BAR __builtin_amdgcn_s_barrier()
#define PG8_SCHED __builtin_amdgcn_sched_barrier(0)
  Unit cur, nxt; int ui = 0;
  if (!S.next(0, cur)) return;
  f32x4 acc[2][2][4][2];
#pragma unroll
  for (int a = 0; a < 2; ++a)
#pragma unroll
    for (int b = 0; b < 2; ++b)
#pragma unroll
      for (int m = 0; m < 4; ++m)
#pragma unroll
        for (int n = 0; n < 2; ++n) acc[a][b][m][n] = (f32x4){0.f, 0.f, 0.f, 0.f};
  bf16x8 At[4][2], B0[2][2], B1[2][2];
  const char* cA = (const char*)g.A + (size_t)cur.pm * tstep; const char* cB = (const char*)g.Bt + (size_t)cur.pn * tstep;
  PG8_STAGE(PG8_SB(0, 0), cB, voffB); PG8_STAGE(PG8_SA(0, 0), cA, voffA); PG8_STAGE(PG8_SB(0, 1), cB + hstep, voffB); PG8_STAGE(PG8_SA(0, 1), cA + hstep, voffA);
  if (wr == 1) PG8_BAR;
  PG8_WAIT_V(4); PG8_BAR;
  PG8_STAGE(PG8_SB(1, 0), cB + kstep, voffB); PG8_STAGE(PG8_SA(1, 0), cA + kstep, voffA); PG8_STAGE(PG8_SB(1, 1), cB + hstep + kstep, voffB);
  PG8_WAIT_V(6); PG8_BAR;
  for (;;) {
    const bool has_next = S.next(ui + 1, nxt);
    const char* nA = has_next ? (const char*)g.A + (size_t)nxt.pm * tstep : cA; const char* nB = has_next ? (const char*)g.Bt + (size_t)nxt.pn * tstep : cB;
    for (int t = 0; t < nt; t += 2) {
      const bool last = (t == nt - 2);
      const char* a1 = cA + (size_t)(t + 1) * kstep;
      const char* a2 = last ? nA : cA + (size_t)(t + 2) * kstep; const char* b2 = last ? nB : cB + (size_t)(t + 2) * kstep;
      const char* a3 = a2 + kstep; const char* b3 = b2 + kstep;
      PG8_LDB(B0, 0, 0); PG8_SCHED; PG8_LDA(At, 0, 0); PG8_STAGE(PG8_SA(1, 1), a1 + hstep, voffA);
      PG8_WAIT_L(8); PG8_BAR; PG8_WAIT_L(0); PG8_MMA(0, 0, At, B0); PG8_BAR; PG8_SCHED;
      PG8_LDB(B1, 0, 1); PG8_STAGE(PG8_SB(0, 0), b2, voffB);
      PG8_BAR; PG8_WAIT_L(0); PG8_MMA(0, 1, At, B1); PG8_BAR;
      PG8_LDA(At, 0, 1); PG8_STAGE(PG8_SA(0, 0), a2, voffA);
      PG8_BAR; PG8_WAIT_L(0); PG8_MMA(1, 0, At, B0); PG8_BAR; PG8_SCHED;
      PG8_STAGE(PG8_SB(0, 1), b2 + hstep, voffB);
      PG8_WAIT_V(6); PG8_BAR; PG8_MMA(1, 1, At, B1); PG8_BAR;
      PG8_LDB(B0, 1, 0); PG8_SCHED; PG8_LDA(At, 1, 0); PG8_STAGE(PG8_SA(0, 1), a2 + hstep, voffA);
      PG8_WAIT_L(8); PG8_BAR; PG8_WAIT_L(0); PG8_MMA(0, 0, At, B0); PG8_BAR; PG8_SCHED;
      PG8_LDB(B1, 1, 1); PG8_STAGE(PG8_SB(1, 0), b3, voffB);
      PG8_BAR; PG8_WAIT_L(0); PG8_MMA(0, 1, At, B1); PG8_BAR;
      PG8_LDA(At, 1, 1); PG8_STAGE(PG8_SA(1, 0), a3, voffA);
      PG8_BAR; PG8_WAIT_L(0); PG8_MMA(1, 0, At, B0); PG8_BAR; PG8_SCHED;
      PG8_STAGE(PG8_SB(1, 1), b3 + hstep, voffB);
      PG8_WAIT_V(6); PG8_BAR; PG8_MMA(1, 1, At, B1); PG8_BAR;
    }
    E(acc, cur, wr, wc, fr, fq);
    if (!has_next) break;
#pragma unroll
    for (int a = 0; a < 2; ++a)
#pragma unroll
      for (int b = 0; b < 2; ++b)
#pragma unroll
        for (int m = 0; m < 4; ++m)
#pragma unroll
          for (int n = 0; n < 2; ++n) acc[a][b][m][n] = (f32x4){0.f, 0.f, 0.f, 0.f};
    cur = nxt; cA = nA; cB = nB; ++ui;
  }
  PG8_WAIT_V(0);
  if (wr == 0) PG8_BAR;
  PG8_BAR;
#undef PG8_SA
#undef PG8_SB
#undef PG8_STAGE
#undef PG8_LDA
#undef PG8_LDB
#undef PG8_MMA
#undef PG8_WAIT_V
#undef PG8_WAIT_L
#undef PG8_BAR
#undef PG8_SCHED
}
}

struct EpiIn {
  static constexpr bool PERM = true;
  unsigned char* ws; bf16_t* gsga; const float* rstd; const float* rot;
  __device__ __forceinline__ void operator()(const f32x4 (&acc)[2][2][4][2], const pg8::Unit& u, int wr, int wc, int fr, int fq) const {
    const int pn = u.pn, row0 = u.pm * 256 + wr * 64 + fr, col0 = wc * 32 + 8 * fq;
    if (pn >= 4 && pn < 8) {
      bf16_t* base = (bf16_t*)(ws + (pn < 6 ? OFF_QB : OFF_KB));
      const int lc = ((pn & 1) * 4 + wc) * 64 + 8 * fq;
#pragma unroll
      for (int ai = 0; ai < 2; ++ai)
#pragma unroll
        for (int m = 0; m < 4; ++m) {
          const int r = row0 + ai * 128 + m * 16; const float rs = rstd[r];
          const float* rp = rot + (size_t)row_pos(r) * 64 + 8 * fq;
          const f32x4 c0 = *(const f32x4*)(rp), c1 = *(const f32x4*)(rp + 4), s0 = *(const f32x4*)(rp + 32), s1 = *(const f32x4*)(rp + 36);
          const f32x4 a0 = acc[ai][0][m][0] * rs, a1 = acc[ai][0][m][1] * rs, b0 = acc[ai][1][m][0] * rs, b1 = acc[ai][1][m][1] * rs;
          const f32x4 o10 = a0 * c0 - b0 * s0, o11 = a1 * c1 - b1 * s1, o20 = b0 * c0 + a0 * s0, o21 = b1 * c1 + a1 * s1;
          bf16_t* rowp = base + (size_t)r * 512 + lc;
          *(u32x4*)(rowp) = pack8(o10, o11); *(u32x4*)(rowp + 32) = pack8(o20, o21);
        }
    } else {
      bf16_t* base; int ldc, colt, act;
      if (pn < 2) { base = (bf16_t*)(ws + OFF_XS); ldc = 512; colt = pn * 256; act = 0; }
      else if (pn < 4) { base = (bf16_t*)(ws + OFF_ZS); ldc = 512; colt = (pn - 2) * 256; act = 1; }
      else if (pn < 10) { base = (bf16_t*)(ws + OFF_VB); ldc = 512; colt = (pn - 8) * 256; act = 0; }
      else if (pn < 12) { base = (bf16_t*)(ws + OFF_ZA); ldc = 512; colt = (pn - 10) * 256; act = 1; }
      else if (pn < 16) { base = gsga; ldc = 1024; colt = (pn - 12) * 256; act = 2; }
      else { base = gsga + (size_t)MT * 1024; ldc = 1024; colt = (pn - 16) * 256; act = 2; }
#pragma unroll
      for (int ai = 0; ai < 2; ++ai)
#pragma unroll
        for (int m = 0; m < 4; ++m) {
          const int r = row0 + ai * 128 + m * 16; const float rs = rstd[r];
          bf16_t* rowp = base + (size_t)r * ldc + colt + col0;
#pragma unroll
          for (int bj = 0; bj < 2; ++bj) {
            f32x4 v0 = acc[ai][bj][m][0] * rs, v1 = acc[ai][bj][m][1] * rs;
            if (act == 1) {
#pragma unroll
              for (int j = 0; j < 4; ++j) { v0[j] = siluf_(v0[j]); v1[j] = siluf_(v1[j]); } }
            else if (act == 2) {
#pragma unroll
              for (int j = 0; j < 4; ++j) { v0[j] = sigmoidf_(v0[j]); v1[j] = sigmoidf_(v1[j]); } }
            *(u32x4*)(rowp + bj * 128) = pack8(v0, v1);
          }
        }
    }
  }
};
struct EpiGlu {
  static constexpr bool PERM = true;
  const bf16_t* ysg; const bf16_t* zs; const float* bias; bf16_t* out;
  __device__ __forceinline__ void operator()(const f32x4 (&acc)[2][2][4][2], const pg8::Unit& u, int wr, int wc, int fr, int fq) const {
    const int row0 = u.pm * 256 + wr * 64 + fr, col0 = u.pn * 256 + wc * 32 + 8 * fq;
#pragma unroll
    for (int ai = 0; ai < 2; ++ai)
#pragma unroll
      for (int m = 0; m < 4; ++m) {
        const size_t ro = (size_t)(row0 + ai * 128 + m * 16) * 512 + col0;
#pragma unroll
        for (int bj = 0; bj < 2; ++bj) {
          const f32x4 bb0 = *(const f32x4*)(bias + col0 + bj * 128), bb1 = *(const f32x4*)(bias + col0 + bj * 128 + 4);
          f32x4 y0, y1, z0, z1; unpack8(*(const u32x4*)(ysg + ro + bj * 128), y0, y1); unpack8(*(const u32x4*)(zs + ro + bj * 128), z0, z1);
          f32x4 v0 = acc[ai][bj][m][0] + bb0, v1 = acc[ai][bj][m][1] + bb1;
#pragma unroll
          for (int j = 0; j < 4; ++j) { v0[j] = y0[j] * sigmoidf_(v0[j]) * z0[j]; v1[j] = y1[j] * sigmoidf_(v1[j]) * z1[j]; }
          *(u32x4*)(out + ro + bj * 128) = pack8(v0, v1);
        }
      }
  }
};
template <int MODE> struct EpiBr {
  static constexpr bool PERM = true;
  const bf16_t* gate; bf16_t* ps; bf16_t* out;
  __device__ __forceinline__ void operator()(const f32x4 (&acc)[2][2][4][2], const pg8::Unit& u, int wr, int wc, int fr, int fq) const {
    const int row0 = u.pm * 256 + wr * 64 + fr, col0 = u.pn * 256 + wc * 32 + 8 * fq;
#pragma unroll
    for (int ai = 0; ai < 2; ++ai)
#pragma unroll
      for (int m = 0; m < 4; ++m) {
        const size_t ro = (size_t)(row0 + ai * 128 + m * 16) * 1024 + col0;
#pragma unroll
        for (int bj = 0; bj < 2; ++bj) {
          f32x4 g0, g1; unpack8(*(const u32x4*)(gate + ro + bj * 128), g0, g1);
          f32x4 v0 = acc[ai][bj][m][0] * g0, v1 = acc[ai][bj][m][1] * g1;
          if (MODE == 1) { f32x4 p0, p1; unpack8(*(const u32x4*)(ps + ro + bj * 128), p0, p1); v0 += p0; v1 += p1; *(u32x4*)(out + ro + bj * 128) = pack8(v0, v1); }
          else *(u32x4*)(ps + ro + bj * 128) = pack8(v0, v1);
        }
      }
  }
};
struct EpiOut {
  static constexpr bool PERM = false;
  const float* x_p; const float* x_s; float* out; float* ssq;
  __device__ __forceinline__ void operator()(const f32x4 (&acc)[2][2][4][2], const pg8::Unit& u, int wr, int wc, int fr, int fq) const {
    const int row0 = u.pm * 256 + wr * 64 + fr, col0 = u.pn * 256 + wc * 32 + 4 * fq;
#pragma unroll
    for (int ai = 0; ai < 2; ++ai)
#pragma unroll
      for (int m = 0; m < 4; ++m) {
        const int r = row0 + ai * 128 + m * 16;
        const float* xr = (r < MP ? x_p + (size_t)r * 1024 : x_s + (size_t)(r - MP) * 1024) + col0;
        float* orow = out + (size_t)r * 1024 + col0; float s = 0.f;
#pragma unroll
        for (int bj = 0; bj < 2; ++bj)
#pragma unroll
          for (int n = 0; n < 2; ++n) { const f32x4 y = acc[ai][bj][m][n] + *(const f32x4*)(xr + bj * 128 + n * 16);
            *(f32x4*)(orow + bj * 128 + n * 16) = y; s += y[0] * y[0] + y[1] * y[1] + y[2] * y[2] + y[3] * y[3]; }
        s += __shfl_xor(s, 16); s += __shfl_xor(s, 32);
        if (fq == 0) atomicAdd(ssq + r, s);
      }
  }
};

namespace att {
constexpr int NW = 8, QBLK = 32, KVBLK = 64, LD = 512, LDO = 1024;
constexpr float SCALE = 0.125f, THR = 8.f;
constexpr int SHM_V = KVBLK * 128 * 2, SHM_K = KVBLK * 64 * 2;
#define KSWZ(row, colB) ((row) * 128 + ((colB) ^ ((((row) >> 1) & 7) << 4)))
#define SBAR() __builtin_amdgcn_sched_barrier(0)
__device__ __forceinline__ int crow(int r, int hi) { return (r & 3) + 8 * (r >> 2) + 4 * hi; }
__device__ __forceinline__ void partialSM(f32x16& p0, f32x16& p1, float& m_reg, float& mn, float& alpha) {
  constexpr float C = SCALE * 1.4426950408889634f;
  float pmax = p0[0];
#pragma unroll
  for (int r = 1; r < 16; ++r) pmax = fmaxf(pmax, p0[r]);
#pragma unroll
  for (int r = 0; r < 16; ++r) pmax = fmaxf(pmax, p1[r]);
  { auto rr = __builtin_amdgcn_permlane32_swap(__float_as_uint(pmax), __float_as_uint(pmax), false, false);
    pmax = fmaxf(__uint_as_float(rr[0]), __uint_as_float(rr[1])); }
  if (__builtin_expect(__all(pmax - m_reg <= THR / SCALE), 1)) { mn = m_reg; alpha = 1.f; }
  else { mn = fmaxf(m_reg, pmax); alpha = __builtin_amdgcn_exp2f((m_reg - mn) * C); m_reg = mn; }
  const float mnC = -mn * C;
#pragma unroll
  for (int r = 0; r < 16; ++r) p0[r] = fmaf(p0[r], C, mnC);
#pragma unroll
  for (int r = 0; r < 16; ++r) p1[r] = fmaf(p1[r], C, mnC);
#pragma unroll
  for (int r = 0; r < 16; ++r) p0[r] = __builtin_amdgcn_exp2f(p0[r]);
}
__device__ __forceinline__ void finishSM(f32x16& p0, f32x16& p1, float alpha, float& l_reg, bf16x8& pa0, bf16x8& pa1, bf16x8& pa2, bf16x8& pa3) {
#pragma unroll
  for (int r = 0; r < 16; ++r) p1[r] = __builtin_amdgcn_exp2f(p1[r]);
  float ps = 0;
#pragma unroll
  for (int r = 0; r < 16; ++r) ps += p0[r];
#pragma unroll
  for (int r = 0; r < 16; ++r) ps += p1[r];
  { auto rr = __builtin_amdgcn_permlane32_swap(__float_as_uint(ps), __float_as_uint(ps), false, false);
    ps = __uint_as_float(rr[0]) + __uint_as_float(rr[1]); }
  l_reg = l_reg * alpha + ps;
#define PK4(P, BASE, OUT) do { unsigned a0 = cvtpk(P[BASE + 0], P[BASE + 1]), a1 = cvtpk(P[BASE + 2], P[BASE + 3]);   \
    unsigned b0 = cvtpk(P[BASE + 4], P[BASE + 5]), b1 = cvtpk(P[BASE + 6], P[BASE + 7]);                              \
    auto r0 = __builtin_amdgcn_permlane32_swap(a0, b0, false, false); auto r1 = __builtin_amdgcn_permlane32_swap(a1, b1, false, false); \
    u32x4 w = {r0[0], r1[0], r0[1], r1[1]}; OUT = *reinterpret_cast<bf16x8*>(&w); } while (0)
  PK4(p0, 0, pa0); PK4(p0, 8, pa1); PK4(p1, 0, pa2); PK4(p1, 8, pa3);
#undef PK4
}
__device__ __forceinline__ void qkt(f32x16& p0, f32x16& p1, const char* Ks, const bf16x8* qr, int r32, int hi) {
  p0 = f32x16{}; p1 = f32x16{};
#pragma unroll
  for (int d0 = 0; d0 < 4; ++d0) { const int cb = (d0 * 16 + hi * 8) * 2;
    bf16x8 b0 = *reinterpret_cast<const bf16x8*>(Ks + KSWZ(r32, cb));
    bf16x8 b1 = *reinterpret_cast<const bf16x8*>(Ks + KSWZ(32 + r32, cb));
    p0 = __builtin_amdgcn_mfma_f32_32x32x16_bf16(b0, qr[d0], p0, 0, 0, 0);
    p1 = __builtin_amdgcn_mfma_f32_32x32x16_bf16(b1, qr[d0], p1, 0, 0, 0); }
}
__device__ __forceinline__ int v_st(int k, int c) { const int kk = (k & ~0xC) | ((k & 4) << 1) | ((k & 8) >> 1); return ((kk >> 3) * 4 + (c >> 5)) * 512 + ((kk & 7) * 32 + (c & 31)) * 2; }
__device__ __forceinline__ int v_rd_base(int lane) { return ((lane & 3) << 3) | (((lane >> 2) & 3) << 6) | (((lane >> 4) & 1) << 5) | (((lane >> 5) & 1) << 8); }
constexpr int v_rd_off(int d0, int ks, int half) { return d0 * 512 + ks * 4096 + half * 2048; }
template <int OFF> __device__ __forceinline__ s16x4 tr_read(int vb) {
  s16x4 r; asm volatile("ds_read_b64_tr_b16 %0, %1 offset:%2" : "=&v"(r) : "v"(vb), "i"(OFF) : "memory"); return r;
}
template <int D0> __device__ __forceinline__ void pv_one(f32x16& od, int vb, bf16x8 pa0, bf16x8 pa1, bf16x8 pa2, bf16x8 pa3) {
  const s16x4 l0 = tr_read<v_rd_off(D0, 0, 0)>(vb), h0 = tr_read<v_rd_off(D0, 0, 1)>(vb), l1 = tr_read<v_rd_off(D0, 1, 0)>(vb), h1 = tr_read<v_rd_off(D0, 1, 1)>(vb);
  const s16x4 l2 = tr_read<v_rd_off(D0, 2, 0)>(vb), h2 = tr_read<v_rd_off(D0, 2, 1)>(vb), l3 = tr_read<v_rd_off(D0, 3, 0)>(vb), h3 = tr_read<v_rd_off(D0, 3, 1)>(vb);
  asm volatile("s_waitcnt lgkmcnt(0)" ::: "memory"); SBAR();
#define PK(L, H) (bf16x8){L[0], L[1], L[2], L[3], H[0], H[1], H[2], H[3]}
  od = __builtin_amdgcn_mfma_f32_32x32x16_bf16(pa0, PK(l0, h0), od, 0, 0, 0);
  od = __builtin_amdgcn_mfma_f32_32x32x16_bf16(pa1, PK(l1, h1), od, 0, 0, 0);
  od = __builtin_amdgcn_mfma_f32_32x32x16_bf16(pa2, PK(l2, h2), od, 0, 0, 0);
  od = __builtin_amdgcn_mfma_f32_32x32x16_bf16(pa3, PK(l3, h3), od, 0, 0, 0);
#undef PK
}
__device__ __forceinline__ void pv_d0(f32x16* o, int vb, bf16x8 pa0, bf16x8 pa1, bf16x8 pa2, bf16x8 pa3) {
  pv_one<0>(o[0], vb, pa0, pa1, pa2, pa3); pv_one<1>(o[1], vb, pa0, pa1, pa2, pa3); pv_one<2>(o[2], vb, pa0, pa1, pa2, pa3); pv_one<3>(o[3], vb, pa0, pa1, pa2, pa3);
}
__device__ __forceinline__ void attn_unit(const bf16_t* __restrict__ Qb, const bf16_t* __restrict__ Kh, const bf16_t* __restrict__ Vh, bf16_t* __restrict__ Ob, int seq, char* lds) {
  const int tid = threadIdx.x, wid = tid >> 6, lane = tid & 63, r32 = lane & 31, hi = lane >> 5;
  char* V_lds = lds; char* K_lds = lds + 2 * SHM_V;
  float* ws = (float*)(lds + 2 * SHM_V + 2 * SHM_K) + wid * 64; float* li_l = ws; float* al_l = ws + 32;
  float m_reg = -1e30f, l_reg = 0; f32x16 o[4] = {}; bf16x8 qr[4];
  const bf16_t* Qw = Qb + (long)(wid * QBLK + r32) * LD + hi * 8;
#pragma unroll
  for (int d0 = 0; d0 < 4; ++d0) qr[d0] = *reinterpret_cast<const bf16x8*>(Qw + d0 * 16);
  const int sr = tid >> 4, sc = (tid & 15) * 8, vst0 = v_st(sr, sc), vst1 = v_st(32 + sr, sc);
  const int ksr = tid >> 3, ksc = (tid & 7) * 8, kst = KSWZ(ksr, ksc * 2);
  const int vb0 = (int)(uintptr_t)V_lds + v_rd_base(lane);
  struct { bf16x8 vs0, vs1, ks0; } sr_[1];
#define SLOAD(i, k0) do { sr_[i].vs0 = *reinterpret_cast<const bf16x8*>(&Vh[(long)((k0) + sr) * LD + sc]); sr_[i].vs1 = *reinterpret_cast<const bf16x8*>(&Vh[(long)((k0) + 32 + sr) * LD + sc]); \
    sr_[i].ks0 = *reinterpret_cast<const bf16x8*>(&Kh[(long)((k0) + ksr) * LD + ksc]); } while (0)
#define SWRITE(b, i) do { *(bf16x8*)(V_lds + (b) * SHM_V + vst0) = sr_[i].vs0; *(bf16x8*)(V_lds + (b) * SHM_V + vst1) = sr_[i].vs1; \
    *(bf16x8*)(K_lds + (b) * SHM_K + kst) = sr_[i].ks0; } while (0)
#define SWAIT() asm volatile("s_waitcnt vmcnt(0)" ::: "memory")
#define RESC(a) do { if (__any((a) < 1.f)) { if (hi == 0) al_l[r32] = (a); asm volatile("s_waitcnt lgkmcnt(0)" ::: "memory"); \
    _Pragma("unroll") for (int d = 0; d < 4; ++d) _Pragma("unroll") for (int r = 0; r < 16; ++r) o[d][r] *= al_l[crow(r, hi)]; } } while (0)
  f32x16 pA0, pA1, pB0, pB1; float mnA, mnB, alA, alB; bf16x8 pa0, pa1, pa2, pa3; const int NT = seq / KVBLK;
  constexpr int SE = 0, SO = 0;
  SLOAD(SE, 0); asm volatile("s_waitcnt vmcnt(0)" ::: "memory"); SWRITE(0, SE); __syncthreads();
  qkt(pA0, pA1, K_lds, qr, r32, hi); partialSM(pA0, pA1, m_reg, mnA, alA);
  SLOAD(SO, KVBLK);
  SWAIT(); SWRITE(1, SO); __syncthreads();
  for (int j = 1; j + 1 < NT; j += 2) {
    SBAR(); qkt(pB0, pB1, K_lds + SHM_K, qr, r32, hi);
    finishSM(pA0, pA1, alA, l_reg, pa0, pa1, pa2, pa3); SBAR();
    SLOAD(SO, (j + 1) * KVBLK); SBAR();
    pv_d0(o, vb0, pa0, pa1, pa2, pa3); partialSM(pB0, pB1, m_reg, mnB, alB);
    __syncthreads(); SWAIT(); SWRITE(0, SE);
    RESC(alB); __syncthreads();
    SBAR(); qkt(pA0, pA1, K_lds, qr, r32, hi);
    finishSM(pB0, pB1, alB, l_reg, pa0, pa1, pa2, pa3); SBAR();
    SLOAD(SE, (j + 2) * KVBLK); SBAR();
    pv_d0(o, vb0 + SHM_V, pa0, pa1, pa2, pa3); partialSM(pA0, pA1, m_reg, mnA, alA);
    __syncthreads(); SWAIT(); SWRITE(1, SO);
    RESC(alA); __syncthreads();
  }
  SBAR(); qkt(pB0, pB1, K_lds + SHM_K, qr, r32, hi);
  finishSM(pA0, pA1, alA, l_reg, pa0, pa1, pa2, pa3); SBAR();
  pv_d0(o, vb0, pa0, pa1, pa2, pa3); partialSM(pB0, pB1, m_reg, mnB, alB);
  __syncthreads(); RESC(alB);
  finishSM(pB0, pB1, alB, l_reg, pa0, pa1, pa2, pa3); SBAR();
  pv_d0(o, vb0 + SHM_V, pa0, pa1, pa2, pa3);
  if (hi == 0) li_l[r32] = l_reg; asm volatile("s_waitcnt lgkmcnt(0)" ::: "memory");
  float rli[16];
#pragma unroll
  for (int r = 0; r < 16; ++r) rli[r] = __builtin_amdgcn_rcpf(li_l[crow(r, hi)]);
  bf16_t* Ow = Ob + (long)(wid * QBLK) * LDO;
#pragma unroll
  for (int r = 0; r < 16; ++r) { const int orow = crow(r, hi);
#pragma unroll
    for (int d0 = 0; d0 < 4; ++d0) Ow[(long)orow * LDO + d0 * 32 + r32] = (bf16_t)(cvtpk(o[d0][r] * rli[r], 0.f) & 0xffffu); }
  __syncthreads();
#undef SLOAD
#undef SWRITE
#undef SWAIT
#undef RESC
}
}

constexpr int SCAN_ROWB = 272, SCAN_WAVE_LDS = 32 * SCAN_ROWB;
__device__ __forceinline__ void scan_seq(const unsigned char* wsb, int rowbase, int L, int g, int dir, char* ldsw, int lane) {
  const int j = lane & 31, hi = lane >> 5, l16 = lane & 15, q4 = lane >> 4;
  const float* LAMp = (const float*)(wsb + OFF_LAM) + ((size_t)(dir * 32 + g) * 64 + lane) * 2;
  const float lr = LAMp[0], li = LAMp[1];
  const bf16_t* BBp = (const bf16_t*)(wsb + OFF_BB) + (size_t)(dir * 32 + g) * 128 * 16;
  const bf16_t* CBp = (const bf16_t*)(wsb + OFF_CB) + (size_t)(dir * 32 + g) * 128 * 16;
  bf16x8 bb[4], cb[4];
#pragma unroll
  for (int nb = 0; nb < 4; ++nb) bb[nb] = *(const bf16x8*)(BBp + (nb * 32 + j) * 16 + 8 * hi);
#pragma unroll
  for (int kk = 0; kk < 4; ++kk) cb[kk] = *(const bf16x8*)(CBp + (kk * 16 + l16) * 32 + 8 * q4);
  const bf16_t* XS = (const bf16_t*)(wsb + OFF_XS) + (size_t)rowbase * 512 + g * 16;
  bf16_t* Y = (bf16_t*)(wsb + (dir ? OFF_YB : OFF_YF)) + (size_t)rowbase * 512 + g * 16;
  float hr = 0.f, him = 0.f;
  const int nch = L / 32;
  auto tok = [&](int c, int t) { const int p = c * 32 + t; return dir ? (L - 1 - p) : p; };
  bf16x8 a_next = *(const bf16x8*)(XS + (size_t)tok(0, j) * 512 + 8 * hi);
  for (int c = 0; c < nch; ++c) {
    const bf16x8 a = a_next;
    if (c + 1 < nch) a_next = *(const bf16x8*)(XS + (size_t)tok(c + 1, j) * 512 + 8 * hi);
    const f32x16 z = {};
    f32x16 d0 = __builtin_amdgcn_mfma_f32_32x32x16_bf16(a, bb[0], z, 0, 0, 0);
    f32x16 d1 = __builtin_amdgcn_mfma_f32_32x32x16_bf16(a, bb[1], z, 0, 0, 0);
    f32x16 d2 = __builtin_amdgcn_mfma_f32_32x32x16_bf16(a, bb[2], z, 0, 0, 0);
    f32x16 d3 = __builtin_amdgcn_mfma_f32_32x32x16_bf16(a, bb[3], z, 0, 0, 0);
#pragma unroll
    for (int a4 = 0; a4 < 4; ++a4) {
      float re[2][4], im[2][4];
#pragma unroll
      for (int i = 0; i < 4; ++i) { const int r = 4 * a4 + i;
        auto s0 = __builtin_amdgcn_permlane32_swap(__float_as_uint(d0[r]), __float_as_uint(d2[r]), false, false);
        auto s1 = __builtin_amdgcn_permlane32_swap(__float_as_uint(d1[r]), __float_as_uint(d3[r]), false, false);
        re[0][i] = __uint_as_float(s0[0]); re[1][i] = __uint_as_float(s0[1]); im[0][i] = __uint_as_float(s1[0]); im[1][i] = __uint_as_float(s1[1]); }
#pragma unroll
      for (int h = 0; h < 2; ++h)
#pragma unroll
        for (int i = 0; i < 4; ++i) { const int t = 8 * a4 + 4 * h + i;
          const float nr = fmaf(lr, hr, fmaf(-li, him, re[h][i])), ni = fmaf(lr, him, fmaf(li, hr, im[h][i]));
          hr = nr; him = ni;
          *(unsigned*)(ldsw + t * SCAN_ROWB + lane * 4) = cvtpk(hr, him); }
    }
    __builtin_amdgcn_wave_barrier();
#pragma unroll
    for (int tb = 0; tb < 2; ++tb) {
      f32x4 acc = {0.f, 0.f, 0.f, 0.f};
#pragma unroll
      for (int kk = 0; kk < 4; ++kk) { const bf16x8 hf = *(const bf16x8*)(ldsw + (tb * 16 + l16) * SCAN_ROWB + (kk * 32 + 8 * q4) * 2);
        acc = __builtin_amdgcn_mfma_f32_16x16x32_bf16(cb[kk], hf, acc, 0, 0, 0); }
      u32x2 w; w.x = cvtpk(acc[0], acc[1]); w.y = cvtpk(acc[2], acc[3]);
      *(u32x2*)(Y + (size_t)tok(c, tb * 16 + l16) * 512 + 4 * q4) = w;
    }
    __builtin_amdgcn_wave_barrier();
  }
}

__device__ __forceinline__ int win_drow(int n) {
  if (n < 1024 || n >= 2048) return n;
  const int c = n & 255, tb = n - c, gi = c >> 6, d = c & 63;
  return tb + (d >> 5) * 128 + gi * 32 + (d & 31);
}
__device__ __forceinline__ void transpose_job(const float* src, int ldn, int K, int k0, int n0, bf16_t* dst, const float* gscale, bool perm, float* tile) {
  const int tid = threadIdx.x;
#pragma unroll
  for (int pss = 0; pss < 2; ++pss) { const int kr = (tid >> 4) + pss * 32, nc = (tid & 15) * 4;
    f32x4 v = *(const f32x4*)(src + (size_t)(k0 + kr) * ldn + n0 + nc);
    if (gscale) v = v * gscale[k0 + kr];
    tile[kr * 65 + nc] = v[0]; tile[kr * 65 + nc + 1] = v[1]; tile[kr * 65 + nc + 2] = v[2]; tile[kr * 65 + nc + 3] = v[3]; }
  __syncthreads();
  { const int nl = tid >> 3, kc = (tid & 7) * 8; f32x4 a, b;
#pragma unroll
    for (int i = 0; i < 4; ++i) { a[i] = tile[(kc + i) * 65 + nl]; b[i] = tile[(kc + 4 + i) * 65 + nl]; }
    const int n = n0 + nl, dr = perm ? win_drow(n) : n;
    *(u32x4*)(dst + (size_t)dr * K + k0 + kc) = pack8(a, b); }
  __syncthreads();
}

__global__ void __launch_bounds__(512, 2) fwd_mega(Params p) {
  extern __shared__ __attribute__((aligned(16))) unsigned char smem[];
  cg::grid_group grid = cg::this_grid();
  const int tid = threadIdx.x, lane = tid & 63, wid = tid >> 6, G = gridDim.x, bx = blockIdx.x;
  unsigned char* ws = p.ws;
  bf16_t* gsga = (bf16_t*)p.out;
  const int lo = p.ph_lo, hi_ = p.ph_hi;
#ifndef PHMASK
#define PHMASK 255
#endif
#define IN(k) (((PHMASK >> (k)) & 1) && lo <= (k) && (k) < hi_)
#ifdef DUMP
#undef IN
#define IN(k) (((k) == 8 || ((PHMASK >> (k)) & 1)) && lo <= (k) && (k) < hi_)
#endif
#define SEAM(k) do { if (IN(k) && IN((k) + 1)) grid.sync(); } while (0)

  if (IN(0)) {
    for (int r = bx * 8 + wid; r < MT; r += G * 8) {
      const float* xr = r < MP ? p.x_p + (size_t)r * 1024 : p.x_s + (size_t)(r - MP) * 1024;
      bf16_t* xb = (bf16_t*)(ws + OFF_XB) + (size_t)r * 1024; float s = 0.f;
#pragma unroll
      for (int i = 0; i < 4; ++i) { const f32x4 v = *(const f32x4*)(xr + i * 256 + lane * 4); s += v[0] * v[0] + v[1] * v[1] + v[2] * v[2] + v[3] * v[3];
        u32x2 w; w.x = cvtpk(v[0], v[1]); w.y = cvtpk(v[2], v[3]); *(u32x2*)(xb + i * 256 + lane * 4) = w; }
#pragma unroll
      for (int o = 32; o > 0; o >>= 1) s += __shfl_xor(s, o);
      if (lane == 0) ((float*)(ws + OFF_RSTD))[r] = rsqrtf(s * (1.f / 1024.f) + 1e-6f);
    }
    for (int jb = bx; jb < 1856; jb += G) {
      float* tile = (float*)smem;
      if (jb < 1280) transpose_job(p.w_in, NIN, 1024, (jb / 80) * 64, (jb % 80) * 64, (bf16_t*)(ws + OFF_WIN), p.norm_g, true, tile);
      else if (jb < 1344) { const int q = jb - 1280; transpose_job(p.w_glu, 512, 512, (q / 8) * 64, (q % 8) * 64, (bf16_t*)(ws + OFF_WGLU), nullptr, false, tile); }
      else if (jb < 1600) { const int q = jb - 1344, i = q / 128, r = q % 128;
        transpose_job(p.w_branch + (size_t)i * 512 * 1024, 1024, 512, (r / 16) * 64, (r % 16) * 64, (bf16_t*)(ws + OFF_WBR) + (size_t)i * 1024 * 512, nullptr, false, tile); }
      else { const int q = jb - 1600; transpose_job(p.w_out, 1024, 1024, (q / 16) * 64, (q % 16) * 64, (bf16_t*)(ws + OFF_WOUT), nullptr, false, tile); }
    }
    const int gt = bx * 512 + tid, GT = G * 512;
    for (int i = gt; i < 8192 * 32; i += GT) { const int pos = i >> 5, k = i & 31;
      const float ex = (float)k * 2.0f / 64.0f; const float invf = (float)(1.0 / pow(10000.0, (double)ex));
      const float ang = (float)pos * invf; const double rev = (double)ang * 0.15915494309189535; const float fr2 = (float)(2.0 * (rev - floor(rev)));
      float* rt = (float*)(ws + OFF_ROT) + (size_t)pos * 64; rt[k] = cospif(fr2); rt[32 + k] = sinpif(fr2); }
    for (int i = gt; i < MT; i += GT) ((float*)(ws + OFF_SSQ))[i] = 0.f;
    if (gt < 4096) { const int dir = gt >> 11, g = (gt >> 6) & 31, s = gt & 63;
      const double dt = exp((double)p.log_dt[dir * 32 + g]);
      const double ar = (double)p.a_re[gt], ai = (double)p.a_im[gt];
      const double mag = exp(ar * dt); const double ph = ai * dt * 0.3183098861837907; const float ph2 = (float)(ph - 2.0 * floor(ph * 0.5));
      const double lr = mag * (double)cospif(ph2), li = mag * (double)sinpif(ph2);
      float* lm = (float*)(ws + OFF_LAM) + (size_t)gt * 2; lm[0] = (float)lr; lm[1] = (float)li;
      const double den = ar * ar + ai * ai, cr = ((lr - 1.0) * ar + li * ai) / den, ci = (li * ar - (lr - 1.0) * ai) / den;
      bf16_t* BBp = (bf16_t*)(ws + OFF_BB) + (size_t)(dir * 32 + g) * 128 * 16;
      const int nbr = (s >> 5) * 2, jj = s & 31;
      for (int c = 0; c < 16; ++c) { const double br = (double)p.b_re[(size_t)gt * 16 + c], bi = (double)p.b_im[(size_t)gt * 16 + c];
        BBp[((nbr) * 32 + jj) * 16 + c] = (bf16_t)(cvtpk((float)(cr * br - ci * bi), 0.f) & 0xffffu);
        BBp[((nbr + 1) * 32 + jj) * 16 + c] = (bf16_t)(cvtpk((float)(cr * bi + ci * br), 0.f) & 0xffffu); }
      bf16_t* CBp = (bf16_t*)(ws + OFF_CB) + (size_t)(dir * 32 + g) * 128 * 16;
      for (int c = 0; c < 16; ++c) { const float cre = p.c_re[((size_t)(dir * 32 + g) * 16 + c) * 64 + s], cim = p.c_im[((size_t)(dir * 32 + g) * 16 + c) * 64 + s];
        const int k = 2 * s, kk = k >> 5, kp = k & 31;
        *(unsigned*)(CBp + (kk * 16 + c) * 32 + kp) = cvtpk(cre, -cim); }
    }
    if (gt == 0) { float s1 = 0.f, s2 = 0.f; for (int i = 0; i < 64; ++i) { s1 += p.lq1[i] * p.lk1[i]; s2 += p.lq2[i] * p.lk2[i]; }
      ((float*)(ws + OFF_CTL))[8] = expf(s1) - expf(s2) + 0.2f; ((unsigned*)(ws + OFF_CTL))[0] = 0u; }
  }
  SEAM(0);

  if (IN(1)) {
    pg8::Gemm g{(const bf16_t*)(ws + OFF_XB), (const bf16_t*)(ws + OFF_WIN), MT, NIN, 1024}; pg8::StaticOrder S; S.init(MT, NIN, G, bx);
    EpiIn E{ws, gsga, (const float*)(ws + OFF_RSTD), (const float*)(ws + OFF_ROT)};
    pg8::gemm_phase<EpiIn>((LAS unsigned char*)smem, g, S, E);
  }
  SEAM(1);

  if (IN(2)) {
    unsigned* ctr = (unsigned*)(ws + OFF_CTL); volatile unsigned* bc = (volatile unsigned*)(smem + LDS_BYTES - 16);
    const bf16_t* QB = (const bf16_t*)(ws + OFF_QB); const bf16_t* KB = (const bf16_t*)(ws + OFF_KB); const bf16_t* VB = (const bf16_t*)(ws + OFF_VB); bf16_t* AO = (bf16_t*)(ws + OFF_AO);
    for (;;) {
      __syncthreads();
      if (tid == 0) *bc = atomicAdd(ctr, 1u);
      __syncthreads();
      const int it = (int)*bc;
      if (it >= 2688) break;
      if (it < 64 || (it >= 2112 && it < 2176)) {
        const bool lng = it < 64; const int s = (lng ? it : it - 2112) * 8 + wid;
        const int b = s >> 6, g = (s >> 1) & 31, dir = s & 1;
        scan_seq(ws, lng ? MP + b * 8192 : b * 2048, lng ? 8192 : 2048, g, dir, (char*)smem + wid * SCAN_WAVE_LDS, lane);
      } else {
        const bool lng = it < 2112; const int u = lng ? it - 64 : it - 2176;
        const int nqb = lng ? 32 : 8, L = lng ? 8192 : 2048;
        const int qb = u % nqb, bh = u / nqb, vh = bh & 7, b = bh >> 3;
        const size_t rb = lng ? (size_t)MP + (size_t)b * 8192 : (size_t)b * 2048;
        att::attn_unit(QB + (rb + qb * 256) * 512 + vh * 64, KB + rb * 512 + vh * 64, VB + rb * 512 + (vh >> 1) * 128, AO + (rb + qb * 256) * 1024 + vh * 128, L, (char*)smem);
      }
    }
  }
  SEAM(2);

  if (IN(3)) {
    const float lam = ((const float*)(ws + OFF_CTL))[8];
    const bf16_t* YF = (const bf16_t*)(ws + OFF_YF); const bf16_t* YB = (const bf16_t*)(ws + OFF_YB); const bf16_t* XS = (const bf16_t*)(ws + OFF_XS);
    const bf16_t* AO = (const bf16_t*)(ws + OFF_AO); const bf16_t* ZA = (const bf16_t*)(ws + OFF_ZA);
    bf16_t* YSG = (bf16_t*)(ws + OFF_YSG); bf16_t* YAN = (bf16_t*)(ws + OFF_YAN);
    const int c0 = lane * 8; const f32x4 dk0 = *(const f32x4*)(p.ssm_d + c0), dk1 = *(const f32x4*)(p.ssm_d + c0 + 4);
    const int h = lane >> 4, e0 = (lane & 15) * 8; const f32x4 sg0 = *(const f32x4*)(p.subln_g + e0) * 0.8f, sg1 = *(const f32x4*)(p.subln_g + e0 + 4) * 0.8f;
    for (int r = bx * 8 + wid; r < MT; r += G * 8) {
      f32x4 f0, f1, b0, b1, x0, x1;
      unpack8(*(const u32x4*)(YF + (size_t)r * 512 + c0), f0, f1); unpack8(*(const u32x4*)(YB + (size_t)r * 512 + c0), b0, b1); unpack8(*(const u32x4*)(XS + (size_t)r * 512 + c0), x0, x1);
      f32x4 v0 = f0 + b0 + dk0 * x0, v1 = f1 + b1 + dk1 * x1;
#pragma unroll
      for (int i = 0; i < 4; ++i) { v0[i] = gelu_tanh(v0[i]); v1[i] = gelu_tanh(v1[i]); }
      f32x4 p0, p1, q0, q1, z0, z1;
      unpack8(*(const u32x4*)(AO + (size_t)r * 1024 + (2 * h) * 128 + e0), p0, p1); unpack8(*(const u32x4*)(AO + (size_t)r * 1024 + (2 * h + 1) * 128 + e0), q0, q1);
      unpack8(*(const u32x4*)(ZA + (size_t)r * 512 + h * 128 + e0), z0, z1);
      *(u32x4*)(YSG + (size_t)r * 512 + c0) = pack8(v0, v1);
      f32x4 o0 = p0 - lam * q0, o1 = p1 - lam * q1;
      float ss = 0.f;
#pragma unroll
      for (int i = 0; i < 4; ++i) ss += o0[i] * o0[i] + o1[i] * o1[i];
      ss += __shfl_xor(ss, 1); ss += __shfl_xor(ss, 2); ss += __shfl_xor(ss, 4); ss += __shfl_xor(ss, 8);
      const float rn = rsqrtf(ss * (1.f / 128.f) + 1e-5f);
      o0 = o0 * rn * sg0 * z0; o1 = o1 * rn * sg1 * z1;
      *(u32x4*)(YAN + (size_t)r * 512 + h * 128 + e0) = pack8(o0, o1);
    }
  }
  SEAM(3);

  if (IN(4)) {
    pg8::Gemm g{(const bf16_t*)(ws + OFF_YSG), (const bf16_t*)(ws + OFF_WGLU), MT, 512, 512}; pg8::StaticOrder S; S.init(MT, 512, G, bx);
    EpiGlu E{(const bf16_t*)(ws + OFF_YSG), (const bf16_t*)(ws + OFF_ZS), p.b_glu, (bf16_t*)(ws + OFF_YS2)};
    pg8::gemm_phase<EpiGlu>((LAS unsigned char*)smem, g, S, E);
  }
  SEAM(4);

  if (IN(5)) {
    pg8::StaticOrder S; S.init(MT, 1024, G, bx);
    { pg8::Gemm g{(const bf16_t*)(ws + OFF_YS2), (const bf16_t*)(ws + OFF_WBR), MT, 1024, 512};
      EpiBr<0> E{gsga, (bf16_t*)(ws + OFF_PS), nullptr}; pg8::gemm_phase<EpiBr<0>>((LAS unsigned char*)smem, g, S, E); }
    __syncthreads();
    { pg8::Gemm g{(const bf16_t*)(ws + OFF_YAN), (const bf16_t*)(ws + OFF_WBR) + (size_t)1024 * 512, MT, 1024, 512};
      EpiBr<1> E{gsga + (size_t)MT * 1024, (bf16_t*)(ws + OFF_PS), (bf16_t*)(ws + OFF_MG)}; pg8::gemm_phase<EpiBr<1>>((LAS unsigned char*)smem, g, S, E); }
  }
  SEAM(5);

  if (IN(6)) {
    pg8::Gemm g{(const bf16_t*)(ws + OFF_MG), (const bf16_t*)(ws + OFF_WOUT), MT, 1024, 1024}; pg8::StaticOrder S; S.init(MT, 1024, G, bx);
    EpiOut E{p.x_p, p.x_s, p.out, (float*)(ws + OFF_SSQ)};
    pg8::gemm_phase<EpiOut>((LAS unsigned char*)smem, g, S, E);
  }
  SEAM(6);

  if (IN(7)) {
    const float* ssq = (const float*)(ws + OFF_SSQ);
    f32x4 fg[4];
#pragma unroll
    for (int i = 0; i < 4; ++i) fg[i] = *(const f32x4*)(p.final_g + i * 256 + lane * 4);
    for (int r = bx * 8 + wid; r < MT; r += G * 8) {
      const float rn = rsqrtf(ssq[r] * (1.f / 1024.f) + 1e-6f); float* orow = p.out + (size_t)r * 1024;
#pragma unroll
      for (int i = 0; i < 4; ++i) { f32x4 v = *(f32x4*)(orow + i * 256 + lane * 4); *(f32x4*)(orow + i * 256 + lane * 4) = v * rn * fg[i]; }
    }
  }

#ifdef DUMP
  if (IN(8)) {
    for (int r = bx * 8 + wid; r < MT; r += G * 8) {
      float* orow = p.out + (size_t)r * 1024;
      for (int c = lane; c < 512; c += 64) {
        float a = 0.f, b = 0.f; const size_t i5 = (size_t)r * 512 + c, i1 = (size_t)r * 1024 + c;
#define BF(off, idx) bflo((unsigned)((const bf16_t*)(ws + (off)))[idx])
        if (DUMP == 1) { a = BF(OFF_XS, i5) + BF(OFF_ZS, i5) + BF(OFF_VB, i5); b = BF(OFF_QB, i5) + BF(OFF_KB, i5) + BF(OFF_ZA, i5); }
        if (DUMP == 2) { a = BF(OFF_YF, i5) + BF(OFF_YB, i5); b = BF(OFF_AO, i1) + BF(OFF_AO, i1 + 512); }
        if (DUMP == 3) { a = BF(OFF_YSG, i5) + BF(OFF_YAN, i5) + BF(OFF_YS2, i5); b = BF(OFF_MG, i1) + BF(OFF_MG, i1 + 512); }
        if (DUMP == 4) { a = BF(OFF_YF, i5); b = BF(OFF_YB, i5); }
        if (DUMP == 5) { a = BF(OFF_AO, i1); b = BF(OFF_AO, i1 + 512); }
#undef BF
        orow[c] = a; orow[512 + c] = b;
      }
    }
  }
#endif
#undef IN
#undef SEAM
}

#ifndef N_LAUNCH_PER_PHASE
#define N_LAUNCH_PER_PHASE 0
#endif
extern "C" void kernel_launch(void* const* d_in, const int* in_sizes, int n_in, void* d_out, int out_size, void* d_ws, size_t ws_size, hipStream_t stream) {
  static int grid = 0;
  if (grid == 0) {
    if (n_in != 22 || out_size != MT * 1024 || ws_size < WS_END) { fprintf(stderr, "kernel_launch: unexpected shapes n_in %d out %d ws %zu (need %zu)\n", n_in, out_size, ws_size, (size_t)WS_END); grid = -1; return; }
    int dev = 0, cus = 0, per_cu = 0;
    hipGetDevice(&dev); hipDeviceGetAttribute(&cus, hipDeviceAttributeMultiprocessorCount, dev);
    if (hipFuncSetAttribute((const void*)fwd_mega, hipFuncAttributeMaxDynamicSharedMemorySize, LDS_BYTES) != hipSuccess) { fprintf(stderr, "kernel_launch: hipFuncSetAttribute failed\n"); grid = -1; return; }
    if (hipOccupancyMaxActiveBlocksPerMultiprocessor(&per_cu, (const void*)fwd_mega, 512, LDS_BYTES) != hipSuccess || per_cu < 1) { fprintf(stderr, "kernel_launch: occupancy query says %d\n", per_cu); per_cu = 1; }
    (void)hipGetLastError();
    grid = cus * 1;
  }
  if (grid < 0) return;
  Params p{};
  p.x_p = (const float*)d_in[0]; p.x_s = (const float*)d_in[1]; p.norm_g = (const float*)d_in[2]; p.w_in = (const float*)d_in[3];
  p.a_re = (const float*)d_in[4]; p.a_im = (const float*)d_in[5]; p.log_dt = (const float*)d_in[6]; p.b_re = (const float*)d_in[7]; p.b_im = (const float*)d_in[8];
  p.c_re = (const float*)d_in[9]; p.c_im = (const float*)d_in[10]; p.ssm_d = (const float*)d_in[11]; p.w_glu = (const float*)d_in[12]; p.b_glu = (const float*)d_in[13];
  p.lq1 = (const float*)d_in[14]; p.lk1 = (const float*)d_in[15]; p.lq2 = (const float*)d_in[16]; p.lk2 = (const float*)d_in[17]; p.subln_g = (const float*)d_in[18];
  p.w_branch = (const float*)d_in[19]; p.w_out = (const float*)d_in[20]; p.final_g = (const float*)d_in[21];
  p.out = (float*)d_out; p.ws = (unsigned char*)d_ws;
#if N_LAUNCH_PER_PHASE
  #ifdef DUMP
  const int nph = 9;
#else
  const int nph = 8;
#endif
  for (int ph = 0; ph < nph; ++ph) { p.ph_lo = ph; p.ph_hi = ph + 1; hipLaunchKernelGGL(fwd_mega, dim3(grid), dim3(512), LDS_BYTES, stream, p); }
#else
  p.ph_lo = 0; p.ph_hi = 8;
  void* args[] = {&p};
  hipError_t e = hipLaunchCooperativeKernel((const void*)fwd_mega, dim3(grid), dim3(512), args, LDS_BYTES, stream);
  if (e != hipSuccess) fprintf(stderr, "cooperative launch failed: %s (grid %d)\n", hipGetErrorString(e), grid);
#endif
}
```

```cpp
#include <hip/hip_runtime.h>
#include <hip/hip_cooperative_groups.h>
#include <cstdio>
#include <cstdint>
namespace cg = cooperative_groups;

#define LAS __attribute__((address_space(3)))
typedef unsigned short bf16_t;
typedef short bf16x8 __attribute__((ext_vector_type(8)));
typedef short s16x4 __attribute__((ext_vector_type(4)));
typedef float f32x4 __attribute__((ext_vector_type(4)));
typedef float f32x16 __attribute__((ext_vector_type(16)));
typedef unsigned u32x4 __attribute__((ext_vector_type(4)));
typedef unsigned u32x2 __attribute__((ext_vector_type(2)));

constexpr int DM = 1024, NIN = 5120, MP = 8 * 2048, MS = 8 * 8192, MT = MP + MS;
constexpr size_t UB = (size_t)MT * 512 * 2;
constexpr size_t OFF_XB = 0;
constexpr size_t OFF_XS = 2 * UB, OFF_ZS = 3 * UB, OFF_QB = 4 * UB, OFF_KB = 5 * UB, OFF_VB = 6 * UB, OFF_ZA = 7 * UB;
constexpr size_t OFF_YF = 8 * UB, OFF_YB = 9 * UB;
constexpr size_t OFF_YSG = OFF_QB, OFF_YAN = OFF_KB, OFF_YS2 = OFF_VB, OFF_AO = OFF_XB, OFF_PS = OFF_XB, OFF_MG = OFF_YF;
constexpr size_t OFF_WIN = 10 * UB;
constexpr size_t OFF_WGLU = OFF_WIN + (size_t)NIN * DM * 2;
constexpr size_t OFF_WBR = OFF_WGLU + 512 * 512 * 2;
constexpr size_t OFF_WOUT = OFF_WBR + 2 * 1024 * 512 * 2;
constexpr size_t OFF_RSTD = OFF_WOUT + 1024 * 1024 * 2;
constexpr size_t OFF_SSQ = OFF_RSTD + (size_t)MT * 4;
constexpr size_t OFF_ROT = OFF_SSQ + (size_t)MT * 4;
constexpr size_t OFF_LAM = OFF_ROT + 8192 * 64 * 4;
constexpr size_t OFF_BB = OFF_LAM + 2 * 32 * 64 * 2 * 4;
constexpr size_t OFF_CB = OFF_BB + 2 * 32 * 128 * 16 * 2;
constexpr size_t OFF_CTL = OFF_CB + 2 * 32 * 128 * 16 * 2;
constexpr size_t WS_END = OFF_CTL + 256;
constexpr int LDS_BYTES = 131072;

struct Params {
  const float* x_p; const float* x_s; const float* norm_g; const float* w_in;
  const float* a_re; const float* a_im; const float* log_dt; const float* b_re; const float* b_im;
  const float* c_re; const float* c_im; const float* ssm_d; const float* w_glu; const float* b_glu;
  const float* lq1; const float* lk1; const float* lq2; const float* lk2; const float* subln_g;
  const float* w_branch; const float* w_out; const float* final_g;
  float* out; unsigned char* ws; int ph_lo, ph_hi;
};

typedef __bf16 bf16x2_t __attribute__((ext_vector_type(2)));
typedef float f32x2_t __attribute__((ext_vector_type(2)));
__device__ __forceinline__ unsigned cvtpk(float lo, float hi) { f32x2_t v = {lo, hi}; bf16x2_t b = __builtin_convertvector(v, bf16x2_t); return *reinterpret_cast<unsigned*>(&b); }
__device__ __forceinline__ float bflo(unsigned w) { return __uint_as_float(w << 16); }
__device__ __forceinline__ float bfhi(unsigned w) { return __uint_as_float(w & 0xffff0000u); }
__device__ __forceinline__ float sigmoidf_(float x) { return __builtin_amdgcn_rcpf(1.f + __builtin_amdgcn_exp2f(-1.4426950408889634f * x)); }
__device__ __forceinline__ float siluf_(float x) { return x * sigmoidf_(x); }
__device__ __forceinline__ float gelu_tanh(float x) { const float u = x + 0.044715f * x * x * x; return x * sigmoidf_(1.5957691216057308f * u); }
__device__ __forceinline__ u32x4 pack8(f32x4 a, f32x4 b) { u32x4 w; w.x = cvtpk(a[0], a[1]); w.y = cvtpk(a[2], a[3]); w.z = cvtpk(b[0], b[1]); w.w = cvtpk(b[2], b[3]); return w; }
__device__ __forceinline__ void unpack8(u32x4 w, f32x4& a, f32x4& b) { a = (f32x4){bflo(w.x), bfhi(w.x), bflo(w.y), bfhi(w.y)}; b = (f32x4){bflo(w.z), bfhi(w.z), bflo(w.w), bfhi(w.w)}; }
__device__ __forceinline__ int tid_now() { const int w = __builtin_amdgcn_readfirstlane((int)threadIdx.x >> 6); return w * 64 + (int)__builtin_amdgcn_mbcnt_hi(~0u, __builtin_amdgcn_mbcnt_lo(~0u, 0u)); }
__device__ __forceinline__ int row_pos(int r) { return r < MP ? (r & 2047) : (r & 8191); }

namespace pg8 {
constexpr int BM = 256, BK = 64, HALF = 128, HTB = HALF * BK * 2, STAGE_BYTES = 8 * HTB, NXCD = 8, WGM = 8;
__host__ __device__ __forceinline__ int lds_byte(int r, int c) { const int st = (r >> 4) * 2 + (c >> 5), rr = r & 15, cc = c & 31, ob = rr * 64 + cc * 2; return st * 1024 + (ob ^ (((ob >> 9) & 1) << 5)); }
__host__ __device__ __forceinline__ void stage_rc(int b, int& R, int& C) { const int st = b / 1024, sb = b % 1024, swz = sb ^ (((sb >> 9) & 1) << 5); R = (st >> 1) * 16 + swz / 64; C = (st & 1) * 32 + (swz % 64) / 2; }
__host__ __device__ __forceinline__ int perm32(int rho) { const int n = rho >> 4, i = rho & 15; return 8 * (i >> 2) + 4 * n + (i & 3); }
struct Unit { int pm, pn; };
struct Gemm { const bf16_t* A; const bf16_t* Bt; int M, N, K; };
struct StaticOrder {
  int nM, nN, nwg, G, c;
  __device__ void init(int M, int N, int G_, int c_) { nM = M / BM; nN = N / BM; nwg = nM * nN; G = G_; c = c_; }
  __device__ bool next(int i, Unit& u) const {
    const long L = (long)i * G + c; if (L >= nwg) return false;
    int wgid = (int)L; { const int q = nwg / NXCD, r = nwg % NXCD, xcd = wgid % NXCD, off = wgid / NXCD; wgid = (xcd < r ? xcd * (q + 1) : r * (q + 1) + (xcd - r) * q) + off; }
    const int nig = WGM * nN, gid = wgid / nig, fm = gid * WGM, gsz = (nM - fm) < WGM ? (nM - fm) : WGM;
    u.pm = fm + ((wgid % nig) % gsz); u.pn = (wgid % nig) / gsz; return true;
  }
};
template <class Epi>
__device__ __forceinline__ void gemm_phase(LAS unsigned char* lds, const Gemm g, const StaticOrder& S, const Epi& E) {
  const int tid = tid_now(), wid = __builtin_amdgcn_readfirstlane(tid >> 6), lane = tid & 63, wr = wid >> 2, wc = wid & 3, fr = lane & 15, fq = lane >> 4;
  const int K = g.K, nt = K / BK;
  unsigned voffA[2], voffB[2];
#pragma unroll
  for (int i = 0; i < 2; ++i) { int R, C; stage_rc(tid * 16 + i * 8192, R, C); const int Rb = Epi::PERM ? ((R & ~31) + perm32(R & 31)) : R;
    voffA[i] = (unsigned)(R * K + C) * 2u; voffB[i] = (unsigned)(Rb * K + C) * 2u; }
  const size_t kstep = (size_t)(BK * 2), hstep = (size_t)HALF * K * 2, tstep = 2 * hstep;
  const unsigned ldsw = (unsigned)wid * 1024u;
  const int aoff = lds_byte(wr * 64 + fr, fq * 8), boff = lds_byte(wc * 32 + fr, fq * 8);
#define PG8_SA(b, h) (((b) * 2 + (h)) * HTB)
#define PG8_SB(b, h) ((4 + (b) * 2 + (h)) * HTB)
#define PG8_STAGE(bufoff, gbase, voff) do { _Pragma("unroll") for (int _i = 0; _i < 2; ++_i) \
    __builtin_amdgcn_global_load_lds((const unsigned*)((const char*)(gbase) + (voff)[_i]), (LAS unsigned*)(lds + (bufoff) + ldsw + _i * 8192), 16, 0, 0); } while (0)
#define PG8_LDA(dst, b, h) do { _Pragma("unroll") for (int m = 0; m < 4; ++m) _Pragma("unroll") for (int k = 0; k < 2; ++k) dst[m][k] = *(const LAS bf16x8*)(lds + PG8_SA(b, h) + aoff + m * 2048 + k * 1024); } while (0)
#define PG8_LDB(dst, b, h) do { _Pragma("unroll") for (int n = 0; n < 2; ++n) _Pragma("unroll") for (int k = 0; k < 2; ++k) dst[n][k] = *(const LAS bf16x8*)(lds + PG8_SB(b, h) + boff + n * 2048 + k * 1024); } while (0)
#define PG8_MMA(ai, bj, At, Bt) do { __builtin_amdgcn_s_setprio(1); _Pragma("unroll") for (int m = 0; m < 4; ++m) _Pragma("unroll") for (int n = 0; n < 2; ++n) _Pragma("unroll") for (int k = 0; k < 2; ++k) \
    acc[ai][bj][m][n] = __builtin_amdgcn_mfma_f32_16x16x32_bf16(Bt[n][k], At[m][k], acc[ai][bj][m][n], 0, 0, 0); __builtin_amdgcn_s_setprio(0); } while (0)
#define PG8_WAIT_V(n) asm volatile("s_waitcnt vmcnt(" #n ")" ::: "memory")
#define PG8_WAIT_L(n) asm volatile("s_waitcnt lgkmcnt(" #n ")" ::: "memory")
#define PG8_BAR __builtin_amdgcn_s_barrier()
#define PG8_SCHED __builtin_amdgcn_sched_barrier(0)
  Unit cur, nxt; int ui = 0;
  if (!S.next(0, cur)) return;
  f32x4 acc[2][2][4][2];
#pragma unroll
  for (int a = 0; a < 2; ++a)
#pragma unroll
    for (int b = 0; b < 2; ++b)
#pragma unroll
      for (int m = 0; m < 4; ++m)
#pragma unroll
        for (int n = 0; n < 2; ++n) acc[a][b][m][n] = (f32x4){0.f, 0.f, 0.f, 0.f};
  bf16x8 At[4][2], B0[2][2], B1[2][2];
  const char* cA = (const char*)g.A + (size_t)cur.pm * tstep; const char* cB = (const char*)g.Bt + (size_t)cur.pn * tstep;
  PG8_STAGE(PG8_SB(0, 0), cB, voffB); PG8_STAGE(PG8_SA(0, 0), cA, voffA); PG8_STAGE(PG8_SB(0, 1), cB + hstep, voffB); PG8_STAGE(PG8_SA(0, 1), cA + hstep, voffA);
  if (wr == 1) PG8_BAR;
  PG8_WAIT_V(4); PG8_BAR;
  PG8_STAGE(PG8_SB(1, 0), cB + kstep, voffB); PG8_STAGE(PG8_SA(1, 0), cA + kstep, voffA); PG8_STAGE(PG8_SB(1, 1), cB + hstep + kstep, voffB);
  PG8_WAIT_V(6); PG8_BAR;
  for (;;) {
    const bool has_next = S.next(ui + 1, nxt);
    const char* nA = has_next ? (const char*)g.A + (size_t)nxt.pm * tstep : cA; const char* nB = has_next ? (const char*)g.Bt + (size_t)nxt.pn * tstep : cB;
    for (int t = 0; t < nt; t += 2) {
      const bool last = (t == nt - 2);
      const char* a1 = cA + (size_t)(t + 1) * kstep;
      const char* a2 = last ? nA : cA + (size_t)(t + 2) * kstep; const char* b2 = last ? nB : cB + (size_t)(t + 2) * kstep;
      const char* a3 = a2 + kstep; const char* b3 = b2 + kstep;
      PG8_LDB(B0, 0, 0); PG8_SCHED; PG8_LDA(At, 0, 0); PG8_STAGE(PG8_SA(1, 1), a1 + hstep, voffA);
      PG8_WAIT_L(8); PG8_BAR; PG8_WAIT_L(0); PG8_MMA(0, 0, At, B0); PG8_BAR; PG8_SCHED;
      PG8_LDB(B1, 0, 1); PG8_STAGE(PG8_SB(0, 0), b2, voffB);
      PG8_BAR; PG8_WAIT_L(0); PG8_MMA(0, 1, At, B1); PG8_BAR;
      PG8_LDA(At, 0, 1); PG8_STAGE(PG8_SA(0, 0), a2, voffA);
      PG8_BAR; PG8_WAIT_L(0); PG8_MMA(1, 0, At, B0); PG8_BAR; PG8_SCHED;
      PG8_STAGE(PG8_SB(0, 1), b2 + hstep, voffB);
      PG8_WAIT_V(6); PG8_BAR; PG8_MMA(1, 1, At, B1); PG8_BAR;
      PG8_LDB(B0, 1, 0); PG8_SCHED; PG8_LDA(At, 1, 0); PG8_STAGE(PG8_SA(0, 1), a2 + hstep, voffA);
      PG8_WAIT_L(8); PG8_BAR; PG8_WAIT_L(0); PG8_MMA(0, 0, At, B0); PG8_BAR; PG8_SCHED;
      PG8_LDB(B1, 1, 1); PG8_STAGE(PG8_SB(1, 0), b3, voffB);
      PG8_BAR; PG8_WAIT_L(0); PG8_MMA(0, 1, At, B1); PG8_BAR;
      PG8_LDA(At, 1, 1); PG8_STAGE(PG8_SA(1, 0), a3, voffA);
      PG8_BAR; PG8_WAIT_L(0); PG8_MMA(1, 0, At, B0); PG8_BAR; PG8_SCHED;
      PG8_STAGE(PG8_SB(1, 1), b3 + hstep, voffB);
      PG8_WAIT_V(6); PG8_BAR; PG8_MMA(1, 1, At, B1); PG8_BAR;
    }
    E(acc, cur, wr, wc, fr, fq);
    if (!has_next) break;
#pragma unroll
    for (int a = 0; a < 2; ++a)
#pragma unroll
      for (int b = 0; b < 2; ++b)
#pragma unroll
        for (int m = 0; m < 4; ++m)
#pragma unroll
          for (int n = 0; n < 2; ++n) acc[a][b][m][n] = (f32x4){0.f, 0.f, 0.f, 0.f};
    cur = nxt; cA = nA; cB = nB; ++ui;
  }
  PG8_WAIT_V(0);
  if (wr == 0) PG8_BAR;
  PG8_BAR;
#undef PG8_SA
#undef PG8_SB
#undef PG8_STAGE
#undef PG8_LDA
#undef PG8_LDB
#undef PG8_MMA
#undef PG8_WAIT_V
#undef PG8_WAIT_L
#undef PG8_BAR
#undef PG8_SCHED
}
}

struct EpiIn {
  static constexpr bool PERM = true;
  unsigned char* ws; bf16_t* gsga; const float* rstd; const float* rot;
  __device__ __forceinline__ void operator()(const f32x4 (&acc)[2][2][4][2], const pg8::Unit& u, int wr, int wc, int fr, int fq) const {
    const int pn = u.pn, row0 = u.pm * 256 + wr * 64 + fr, col0 = wc * 32 + 8 * fq;
    if (pn >= 4 && pn < 8) {
      bf16_t* base = (bf16_t*)(ws + (pn < 6 ? OFF_QB : OFF_KB));
      const int lc = ((pn & 1) * 4 + wc) * 64 + 8 * fq;
#pragma unroll
      for (int ai = 0; ai < 2; ++ai)
#pragma unroll
        for (int m = 0; m < 4; ++m) {
          const int r = row0 + ai * 128 + m * 16; const float rs = rstd[r];
          const float* rp = rot + (size_t)row_pos(r) * 64 + 8 * fq;
          const f32x4 c0 = *(const f32x4*)(rp), c1 = *(const f32x4*)(rp + 4), s0 = *(const f32x4*)(rp + 32), s1 = *(const f32x4*)(rp + 36);
          const f32x4 a0 = acc[ai][0][m][0] * rs, a1 = acc[ai][0][m][1] * rs, b0 = acc[ai][1][m][0] * rs, b1 = acc[ai][1][m][1] * rs;
          const f32x4 o10 = a0 * c0 - b0 * s0, o11 = a1 * c1 - b1 * s1, o20 = b0 * c0 + a0 * s0, o21 = b1 * c1 + a1 * s1;
          bf16_t* rowp = base + (size_t)r * 512 + lc;
          *(u32x4*)(rowp) = pack8(o10, o11); *(u32x4*)(rowp + 32) = pack8(o20, o21);
        }
    } else {
      bf16_t* base; int ldc, colt, act;
      if (pn < 2) { base = (bf16_t*)(ws + OFF_XS); ldc = 512; colt = pn * 256; act = 0; }
      else if (pn < 4) { base = (bf16_t*)(ws + OFF_ZS); ldc = 512; colt = (pn - 2) * 256; act = 1; }
      else if (pn < 10) { base = (bf16_t*)(ws + OFF_VB); ldc = 512; colt = (pn - 8) * 256; act = 0; }
      else if (pn < 12) { base = (bf16_t*)(ws + OFF_ZA); ldc = 512; colt = (pn - 10) * 256; act = 1; }
      else if (pn < 16) { base = gsga; ldc = 1024; colt = (pn - 12) * 256; act = 2; }
      else { base = gsga + (size_t)MT * 1024; ldc = 1024; colt = (pn - 16) * 256; act = 2; }
#pragma unroll
      for (int ai = 0; ai < 2; ++ai)
#pragma unroll
        for (int m = 0; m < 4; ++m) {
          const int r = row0 + ai * 128 + m * 16; const float rs = rstd[r];
          bf16_t* rowp = base + (size_t)r * ldc + colt + col0;
#pragma unroll
          for (int bj = 0; bj < 2; ++bj) {
            f32x4 v0 = acc[ai][bj][m][0] * rs, v1 = acc[ai][bj][m][1] * rs;
            if (act == 1) {
#pragma unroll
              for (int j = 0; j < 4; ++j) { v0[j] = siluf_(v0[j]); v1[j] = siluf_(v1[j]); } }
            else if (act == 2) {
#pragma unroll
              for (int j = 0; j < 4; ++j) { v0[j] = sigmoidf_(v0[j]); v1[j] = sigmoidf_(v1[j]); } }
            *(u32x4*)(rowp + bj * 128) = pack8(v0, v1);
          }
        }
    }
  }
};
struct EpiGlu {
  static constexpr bool PERM = true;
  const bf16_t* ysg; const bf16_t* zs; const float* bias; bf16_t* out;
  __device__ __forceinline__ void operator()(const f32x4 (&acc)[2][2][4][2], const pg8::Unit& u, int wr, int wc, int fr, int fq) const {
    const int row0 = u.pm * 256 + wr * 64 + fr, col0 = u.pn * 256 + wc * 32 + 8 * fq;
#pragma unroll
    for (int ai = 0; ai < 2; ++ai)
#pragma unroll
      for (int m = 0; m < 4; ++m) {
        const size_t ro = (size_t)(row0 + ai * 128 + m * 16) * 512 + col0;
#pragma unroll
        for (int bj = 0; bj < 2; ++bj) {
          const f32x4 bb0 = *(const f32x4*)(bias + col0 + bj * 128), bb1 = *(const f32x4*)(bias + col0 + bj * 128 + 4);
          f32x4 y0, y1, z0, z1; unpack8(*(const u32x4*)(ysg + ro + bj * 128), y0, y1); unpack8(*(const u32x4*)(zs + ro + bj * 128), z0, z1);
          f32x4 v0 = acc[ai][bj][m][0] + bb0, v1 = acc[ai][bj][m][1] + bb1;
#pragma unroll
          for (int j = 0; j < 4; ++j) { v0[j] = y0[j] * sigmoidf_(v0[j]) * z0[j]; v1[j] = y1[j] * sigmoidf_(v1[j]) * z1[j]; }
          *(u32x4*)(out + ro + bj * 128) = pack8(v0, v1);
        }
      }
  }
};
template <int MODE> struct EpiBr {
  static constexpr bool PERM = true;
  const bf16_t* gate; bf16_t* ps; bf16_t* out;
  __device__ __forceinline__ void operator()(const f32x4 (&acc)[2][2][4][2], const pg8::Unit& u, int wr, int wc, int fr, int fq) const {
    const int row0 = u.pm * 256 + wr * 64 + fr, col0 = u.pn * 256 + wc * 32 + 8 * fq;
#pragma unroll
    for (int ai = 0; ai < 2; ++ai)
#pragma unroll
      for (int m = 0; m < 4; ++m) {
        const size_t ro = (size_t)(row0 + ai * 128 + m * 16) * 1024 + col0;
#pragma unroll
        for (int bj = 0; bj < 2; ++bj) {
          f32x4 g0, g1; unpack8(*(const u32x4*)(gate + ro + bj * 128), g0, g1);
          f32x4 v0 = acc[ai][bj][m][0] * g0, v1 = acc[ai][bj][m][1] * g1;
          if (MODE == 1) { f32x4 p0, p1; unpack8(*(const u32x4*)(ps + ro + bj * 128), p0, p1); v0 += p0; v1 += p1; *(u32x4*)(out + ro + bj * 128) = pack8(v0, v1); }
          else *(u32x4*)(ps + ro + bj * 128) = pack8(v0, v1);
        }
      }
  }
};
struct EpiOut {
  static constexpr bool PERM = false;
  const float* x_p; const float* x_s; float* out; float* ssq;
  __device__ __forceinline__ void operator()(const f32x4 (&acc)[2][2][4][2], const pg8::Unit& u, int wr, int wc, int fr, int fq) const {
    const int row0 = u.pm * 256 + wr * 64 + fr, col0 = u.pn * 256 + wc * 32 + 4 * fq;
#pragma unroll
    for (int ai = 0; ai < 2; ++ai)
#pragma unroll
      for (int m = 0; m < 4; ++m) {
        const int r = row0 + ai * 128 + m * 16;
        const float* xr = (r < MP ? x_p + (size_t)r * 1024 : x_s + (size_t)(r - MP) * 1024) + col0;
        float* orow = out + (size_t)r * 1024 + col0; float s = 0.f;
#pragma unroll
        for (int bj = 0; bj < 2; ++bj)
#pragma unroll
          for (int n = 0; n < 2; ++n) { const f32x4 y = acc[ai][bj][m][n] + *(const f32x4*)(xr + bj * 128 + n * 16);
            *(f32x4*)(orow + bj * 128 + n * 16) = y; s += y[0] * y[0] + y[1] * y[1] + y[2] * y[2] + y[3] * y[3]; }
        s += __shfl_xor(s, 16); s += __shfl_xor(s, 32);
        if (fq == 0) atomicAdd(ssq + r, s);
      }
  }
};

namespace att {
constexpr int NW = 8, QBLK = 32, KVBLK = 64, LD = 512, LDO = 1024;
constexpr float SCALE = 0.125f, THR = 8.f;
constexpr int SHM_K = KVBLK * 64 * 2, SHM_V = KVBLK * 128 * 2, OFF_KB0 = 0, OFF_VB0 = 2 * SHM_K, OFF_AUX = 2 * SHM_K + 2 * SHM_V;
#define KSWZ(row, colB) ((row) * 128 + ((colB) ^ ((((row) >> 1) & 7) << 4)))
__device__ __forceinline__ int crow(int r, int hi) { return (r & 3) + 8 * (r >> 2) + 4 * hi; }
__device__ __forceinline__ void sm_tile(f32x16& p0, f32x16& p1, float& m_reg, float& l_reg, float& alpha, bf16x8& pa0, bf16x8& pa1, bf16x8& pa2, bf16x8& pa3) {
  constexpr float C = SCALE * 1.4426950408889634f;
  float pmax = p0[0];
#pragma unroll
  for (int r = 1; r < 16; ++r) pmax = fmaxf(pmax, p0[r]);
#pragma unroll
  for (int r = 0; r < 16; ++r) pmax = fmaxf(pmax, p1[r]);
  { auto rr = __builtin_amdgcn_permlane32_swap(__float_as_uint(pmax), __float_as_uint(pmax), false, false);
    pmax = fmaxf(__uint_as_float(rr[0]), __uint_as_float(rr[1])); }
  const bool ok = __all(pmax - m_reg <= THR / SCALE);
  const float mn = ok ? m_reg : fmaxf(m_reg, pmax);
  alpha = __builtin_amdgcn_exp2f((m_reg - mn) * C);
  m_reg = mn;
  const float mnC = -mn * C;
#pragma unroll
  for (int r = 0; r < 16; ++r) p0[r] = __builtin_amdgcn_exp2f(fmaf(p0[r], C, mnC));
#pragma unroll
  for (int r = 0; r < 16; ++r) p1[r] = __builtin_amdgcn_exp2f(fmaf(p1[r], C, mnC));
  float ps = 0;
#pragma unroll
  for (int r = 0; r < 16; ++r) ps += p0[r];
#pragma unroll
  for (int r = 0; r < 16; ++r) ps += p1[r];
  { auto rr = __builtin_amdgcn_permlane32_swap(__float_as_uint(ps), __float_as_uint(ps), false, false);
    ps = __uint_as_float(rr[0]) + __uint_as_float(rr[1]); }
  l_reg = l_reg * alpha + ps;
#define PK4(P, BASE, OUT) do { u32x4 w = {cvtpk(P[BASE + 0], P[BASE + 1]), cvtpk(P[BASE + 2], P[BASE + 3]), cvtpk(P[BASE + 4], P[BASE + 5]), cvtpk(P[BASE + 6], P[BASE + 7])}; \
    OUT = *reinterpret_cast<bf16x8*>(&w); } while (0)
  PK4(p0, 0, pa0); PK4(p0, 8, pa1); PK4(p1, 0, pa2); PK4(p1, 8, pa3);
#undef PK4
}
__device__ __forceinline__ int v_st(int k, int c) { const int kk = k; return ((kk >> 3) * 4 + (c >> 5)) * 512 + ((kk & 7) * 32 + (c & 31)) * 2; }
__device__ __forceinline__ int v_rd_base(int lane) { return ((lane & 3) << 3) | (((lane >> 2) & 3) << 6) | (((lane >> 4) & 1) << 5) | (((lane >> 5) & 1) << 8); }
constexpr int v_rd_off(int d0, int ks, int half) { return d0 * 512 + ks * 4096 + half * 2048; }
__device__ __forceinline__ s16x4 tr_read(const LAS unsigned char* p) { return __builtin_amdgcn_ds_read_tr16_b64_v4i16((LAS s16x4*)p); }
#define SBAR() __builtin_amdgcn_sched_barrier(0)
#define PKF(L, H) (bf16x8){L[0], L[1], L[2], L[3], H[0], H[1], H[2], H[3]}
#define ABAR() do { asm volatile("s_waitcnt lgkmcnt(0)" ::: "memory"); __builtin_amdgcn_s_barrier(); asm volatile("" ::: "memory"); } while (0)
__device__ __forceinline__ void qk_tile(f32x16& n0, f32x16& n1, const LAS unsigned char* Ks, const bf16x8* qr, int r32, int hi) {
  n0 = f32x16{}; n1 = f32x16{};
#pragma unroll
  for (int d0 = 0; d0 < 4; ++d0) { const int cb = (d0 * 16 + hi * 8) * 2;
    const bf16x8 b0 = *(const LAS bf16x8*)(Ks + KSWZ(r32, cb)); const bf16x8 b1 = *(const LAS bf16x8*)(Ks + KSWZ(32 + r32, cb));
    n0 = __builtin_amdgcn_mfma_f32_32x32x16_bf16(b0, qr[d0], n0, 0, 0, 0); n1 = __builtin_amdgcn_mfma_f32_32x32x16_bf16(b1, qr[d0], n1, 0, 0, 0); }
}
__device__ __forceinline__ void pv_tile(f32x16* o, const LAS unsigned char* vb, bf16x8 pa0, bf16x8 pa1, bf16x8 pa2, bf16x8 pa3) {
#pragma unroll
  for (int d0 = 0; d0 < 4; ++d0) {
    const s16x4 l0 = tr_read(vb + v_rd_off(d0, 0, 0)), h0 = tr_read(vb + v_rd_off(d0, 0, 1)), l1 = tr_read(vb + v_rd_off(d0, 1, 0)), h1 = tr_read(vb + v_rd_off(d0, 1, 1));
    const s16x4 l2 = tr_read(vb + v_rd_off(d0, 2, 0)), h2 = tr_read(vb + v_rd_off(d0, 2, 1)), l3 = tr_read(vb + v_rd_off(d0, 3, 0)), h3 = tr_read(vb + v_rd_off(d0, 3, 1));
    o[d0] = __builtin_amdgcn_mfma_f32_32x32x16_bf16(pa0, PKF(l0, h0), o[d0], 0, 0, 0);
    o[d0] = __builtin_amdgcn_mfma_f32_32x32x16_bf16(pa1, PKF(l1, h1), o[d0], 0, 0, 0);
    o[d0] = __builtin_amdgcn_mfma_f32_32x32x16_bf16(pa2, PKF(l2, h2), o[d0], 0, 0, 0);
    o[d0] = __builtin_amdgcn_mfma_f32_32x32x16_bf16(pa3, PKF(l3, h3), o[d0], 0, 0, 0);
  }
}
__device__ __forceinline__ void attn_unit(const bf16_t* __restrict__ Qb, const bf16_t* __restrict__ Kh, const bf16_t* __restrict__ Vh, bf16_t* __restrict__ Ob, int seq, LAS unsigned char* lds) {
  const int tid = tid_now(), wid = tid >> 6, lane = tid & 63, r32 = lane & 31, hi = lane >> 5;
  LAS float* wsl = (LAS float*)(lds + OFF_AUX) + wid * 64; LAS float* li_l = wsl; LAS float* al_l = wsl + 32;
  float m_reg = -1e30f, l_reg = 0; f32x16 o[4] = {}; bf16x8 qr[4];
  const bf16_t* Qw = Qb + (long)(wid * QBLK + r32) * LD + hi * 8;
#pragma unroll
  for (int d0 = 0; d0 < 4; ++d0) qr[d0] = *reinterpret_cast<const bf16x8*>(Qw + d0 * 16);
  const int sr = tid >> 4, sc = (tid & 15) * 8, ksr = tid >> 3, ksc = (tid & 7) * 8;
  const int vst0 = OFF_VB0 + v_st(sr, sc), vst1 = OFF_VB0 + v_st(32 + sr, sc), kst = OFF_KB0 + KSWZ(ksr, ksc * 2);
  const LAS unsigned char* vrd = lds + OFF_VB0 + v_rd_base(lane);
  const int NT = seq / KVBLK;
  bf16x8 sv0, sv1, sk0;
#define SLOAD(j) do { const int kt_ = ((j) + 2 < NT ? (j) + 2 : NT - 1) * KVBLK; \
    sv0 = *reinterpret_cast<const bf16x8*>(&Vh[(long)((j) * KVBLK + sr) * LD + sc]); sv1 = *reinterpret_cast<const bf16x8*>(&Vh[(long)((j) * KVBLK + 32 + sr) * LD + sc]); \
    sk0 = *reinterpret_cast<const bf16x8*>(&Kh[(long)(kt_ + ksr) * LD + ksc]); } while (0)
#define SWRITE(par) do { *(LAS bf16x8*)(lds + (par) * SHM_V + vst0) = sv0; *(LAS bf16x8*)(lds + (par) * SHM_V + vst1) = sv1; *(LAS bf16x8*)(lds + (par) * SHM_K + kst) = sk0; } while (0)
#define RESC(a) do { if (__any((a) < 1.f)) { if (hi == 0) al_l[r32] = (a); asm volatile("s_waitcnt lgkmcnt(0)" ::: "memory"); \
    _Pragma("unroll") for (int d = 0; d < 4; ++d) _Pragma("unroll") for (int r = 0; r < 16; ++r) o[d][r] *= al_l[crow(r, hi)]; } } while (0)
#define SCHED_ITER() do { __builtin_amdgcn_sched_group_barrier(0x100, 6, 0); \
    _Pragma("unroll") for (int i_ = 0; i_ < 16; ++i_) { __builtin_amdgcn_sched_group_barrier(0x008, 1, 0); __builtin_amdgcn_sched_group_barrier(0x100, 2, 0); \
      __builtin_amdgcn_sched_group_barrier(0x002, 11, 0); } \
    _Pragma("unroll") for (int i_ = 0; i_ < 8; ++i_) { __builtin_amdgcn_sched_group_barrier(0x008, 1, 0); __builtin_amdgcn_sched_group_barrier(0x100, 1, 0); __builtin_amdgcn_sched_group_barrier(0x002, 2, 0); } \
    __builtin_amdgcn_sched_group_barrier(0x200, 3, 0); __builtin_amdgcn_sched_group_barrier(0x020, 3, 0); } while (0)
  { const bf16x8 k0 = *reinterpret_cast<const bf16x8*>(&Kh[(long)ksr * LD + ksc]); const bf16x8 k1 = *reinterpret_cast<const bf16x8*>(&Kh[(long)(KVBLK + ksr) * LD + ksc]);
    *(LAS bf16x8*)(lds + kst) = k0; *(LAS bf16x8*)(lds + SHM_K + kst) = k1; }
  SLOAD(0);
  ABAR();
  f32x16 s0, s1; float alpha; bf16x8 xa0, xa1, xa2, xa3, ya0, ya1, ya2, ya3;
  qk_tile(s0, s1, lds + OFF_KB0, qr, r32, hi);
  ABAR();
  SBAR();
  sm_tile(s0, s1, m_reg, l_reg, alpha, xa0, xa1, xa2, xa3);
  qk_tile(s0, s1, lds + OFF_KB0 + SHM_K, qr, r32, hi);
  SWRITE(0); SLOAD(1);
  SBAR(); ABAR();
  for (int j = 1; j + 1 < NT; j += 2) {
    RESC(alpha);
    SBAR();
    pv_tile(o, vrd, xa0, xa1, xa2, xa3);
    sm_tile(s0, s1, m_reg, l_reg, alpha, ya0, ya1, ya2, ya3);
    qk_tile(s0, s1, lds + OFF_KB0, qr, r32, hi);
    SWRITE(1); SLOAD(j + 1);
    SCHED_ITER();
    SBAR(); ABAR();
    RESC(alpha);
    SBAR();
    pv_tile(o, vrd + SHM_V, ya0, ya1, ya2, ya3);
    sm_tile(s0, s1, m_reg, l_reg, alpha, xa0, xa1, xa2, xa3);
    qk_tile(s0, s1, lds + OFF_KB0 + SHM_K, qr, r32, hi);
    SWRITE(0); if (j + 2 < NT) SLOAD(j + 2);
    SCHED_ITER();
    SBAR(); ABAR();
  }
  RESC(alpha);
  SBAR();
  pv_tile(o, vrd, xa0, xa1, xa2, xa3);
  sm_tile(s0, s1, m_reg, l_reg, alpha, ya0, ya1, ya2, ya3);
  SWRITE(1);
  SBAR(); ABAR();
  RESC(alpha);
  pv_tile(o, vrd + SHM_V, ya0, ya1, ya2, ya3);
  if (hi == 0) li_l[r32] = l_reg; asm volatile("s_waitcnt lgkmcnt(0)" ::: "memory");
  float rli[16];
#pragma unroll
  for (int r = 0; r < 16; ++r) rli[r] = __builtin_amdgcn_rcpf(li_l[crow(r, hi)]);
  bf16_t* Ow = Ob + (long)(wid * QBLK) * LDO;
#pragma unroll
  for (int r = 0; r < 16; ++r) { const int orow = crow(r, hi);
#pragma unroll
    for (int d0 = 0; d0 < 4; ++d0) Ow[(long)orow * LDO + d0 * 32 + r32] = (bf16_t)(cvtpk(o[d0][r] * rli[r], 0.f) & 0xffffu); }
  __syncthreads();
#undef SLOAD
#undef SWRITE
#undef RESC
#undef SCHED_ITER
}
}

constexpr int SCAN_ROWB = 272, SCAN_WAVE_LDS = 32 * SCAN_ROWB;
__device__ __forceinline__ void scan_seq(const unsigned char* wsb, int rowbase, int L, int g, int dir, char* ldsw, int lane) {
  const int j = lane & 31, hi = lane >> 5, l16 = lane & 15, q4 = lane >> 4;
  const float* LAMp = (const float*)(wsb + OFF_LAM) + ((size_t)(dir * 32 + g) * 64 + lane) * 2;
  const float lr = LAMp[0], li = LAMp[1];
  const bf16_t* BBp = (const bf16_t*)(wsb + OFF_BB) + (size_t)(dir * 32 + g) * 128 * 16;
  const bf16_t* CBp = (const bf16_t*)(wsb + OFF_CB) + (size_t)(dir * 32 + g) * 128 * 16;
  bf16x8 bb[4], cb[4];
#pragma unroll
  for (int nb = 0; nb < 4; ++nb) bb[nb] = *(const bf16x8*)(BBp + (nb * 32 + j) * 16 + 8 * hi);
#pragma unroll
  for (int kk = 0; kk < 4; ++kk) cb[kk] = *(const bf16x8*)(CBp + (kk * 16 + l16) * 32 + 8 * q4);
  const bf16_t* XS = (const bf16_t*)(wsb + OFF_XS) + (size_t)rowbase * 512 + g * 16;
  bf16_t* Y = (bf16_t*)(wsb + (dir ? OFF_YB : OFF_YF)) + (size_t)rowbase * 512 + g * 16;
  float hr = 0.f, him = 0.f;
  const int nch = L / 32;
  auto tok = [&](int c, int t) { const int p = c * 32 + t; return dir ? (L - 1 - p) : p; };
  bf16x8 a_next = *(const bf16x8*)(XS + (size_t)tok(0, j) * 512 + 8 * hi);
  for (int c = 0; c < nch; ++c) {
    const bf16x8 a = a_next;
    if (c + 1 < nch) a_next = *(const bf16x8*)(XS + (size_t)tok(c + 1, j) * 512 + 8 * hi);
    const f32x16 z = {};
    f32x16 d0 = __builtin_amdgcn_mfma_f32_32x32x16_bf16(a, bb[0], z, 0, 0, 0);
    f32x16 d1 = __builtin_amdgcn_mfma_f32_32x32x16_bf16(a, bb[1], z, 0, 0, 0);
    f32x16 d2 = __builtin_amdgcn_mfma_f32_32x32x16_bf16(a, bb[2], z, 0, 0, 0);
    f32x16 d3 = __builtin_amdgcn_mfma_f32_32x32x16_bf16(a, bb[3], z, 0, 0, 0);
#pragma unroll
    for (int a4 = 0; a4 < 4; ++a4) {
      float re[2][4], im[2][4];
#pragma unroll
      for (int i = 0; i < 4; ++i) { const int r = 4 * a4 + i;
        auto s0 = __builtin_amdgcn_permlane32_swap(__float_as_uint(d0[r]), __float_as_uint(d2[r]), false, false);
        auto s1 = __builtin_amdgcn_permlane32_swap(__float_as_uint(d1[r]), __float_as_uint(d3[r]), false, false);
        re[0][i] = __uint_as_float(s0[0]); re[1][i] = __uint_as_float(s0[1]); im[0][i] = __uint_as_float(s1[0]); im[1][i] = __uint_as_float(s1[1]); }
#pragma unroll
      for (int h = 0; h < 2; ++h)
#pragma unroll
        for (int i = 0; i < 4; ++i) { const int t = 8 * a4 + 4 * h + i;
          const float nr = fmaf(lr, hr, fmaf(-li, him, re[h][i])), ni = fmaf(lr, him, fmaf(li, hr, im[h][i]));
          hr = nr; him = ni;
          *(unsigned*)(ldsw + t * SCAN_ROWB + lane * 4) = cvtpk(hr, him); }
    }
    __builtin_amdgcn_wave_barrier();
#pragma unroll
    for (int tb = 0; tb < 2; ++tb) {
      f32x4 acc = {0.f, 0.f, 0.f, 0.f};
#pragma unroll
      for (int kk = 0; kk < 4; ++kk) { const bf16x8 hf = *(const bf16x8*)(ldsw + (tb * 16 + l16) * SCAN_ROWB + (kk * 32 + 8 * q4) * 2);
        acc = __builtin_amdgcn_mfma_f32_16x16x32_bf16(cb[kk], hf, acc, 0, 0, 0); }
      u32x2 w; w.x = cvtpk(acc[0], acc[1]); w.y = cvtpk(acc[2], acc[3]);
      *(u32x2*)(Y + (size_t)tok(c, tb * 16 + l16) * 512 + 4 * q4) = w;
    }
    __builtin_amdgcn_wave_barrier();
  }
}

__device__ __forceinline__ int win_drow(int n) {
  if (n < 1024 || n >= 2048) return n;
  const int c = n & 255, tb = n - c, gi = c >> 6, d = c & 63;
  return tb + (d >> 5) * 128 + gi * 32 + (d & 31);
}
__device__ __forceinline__ void transpose_job(const float* src, int ldn, int K, int k0, int n0, bf16_t* dst, const float* gscale, bool perm, float* tile) {
  const int tid = tid_now();
#pragma unroll
  for (int pss = 0; pss < 2; ++pss) { const int kr = (tid >> 4) + pss * 32, nc = (tid & 15) * 4;
    f32x4 v = *(const f32x4*)(src + (size_t)(k0 + kr) * ldn + n0 + nc);
    if (gscale) v = v * gscale[k0 + kr];
    tile[kr * 65 + nc] = v[0]; tile[kr * 65 + nc + 1] = v[1]; tile[kr * 65 + nc + 2] = v[2]; tile[kr * 65 + nc + 3] = v[3]; }
  __syncthreads();
  { const int nl = tid >> 3, kc = (tid & 7) * 8; f32x4 a, b;
#pragma unroll
    for (int i = 0; i < 4; ++i) { a[i] = tile[(kc + i) * 65 + nl]; b[i] = tile[(kc + 4 + i) * 65 + nl]; }
    const int n = n0 + nl, dr = perm ? win_drow(n) : n;
    *(u32x4*)(dst + (size_t)dr * K + k0 + kc) = pack8(a, b); }
  __syncthreads();
}

__global__ void __launch_bounds__(512, 2) fwd_mega(Params p) {
  extern __shared__ __attribute__((aligned(16))) unsigned char smem[];
  cg::grid_group grid = cg::this_grid();
  const int G = gridDim.x, bx = blockIdx.x;
#define tid tid_now()
#define lane (tid_now() & 63)
#define wid (tid_now() >> 6)
  unsigned char* ws = p.ws;
  bf16_t* gsga = (bf16_t*)p.out;
  const int lo = p.ph_lo, hi_ = p.ph_hi & 0xff, p2mode = (p.ph_hi >> 8) & 3;
#ifndef PHMASK
#define PHMASK 255
#endif
#define IN(k) (((PHMASK >> (k)) & 1) && lo <= (k) && (k) < hi_)
#ifdef DUMP
#undef IN
#define IN(k) (((k) == 8 || ((PHMASK >> (k)) & 1)) && lo <= (k) && (k) < hi_)
#endif
#ifndef DUPMASK
#define DUPMASK 0
#endif
#define NREP(k) (((DUPMASK >> (k)) & 1) ? 2 : 1)
#define SEAM(k) do { if (IN(k) && IN((k) + 1)) grid.sync(); } while (0)

  if (IN(0)) {
    for (int r = bx * 8 + wid; r < MT; r += G * 8) {
      const float* xr = r < MP ? p.x_p + (size_t)r * 1024 : p.x_s + (size_t)(r - MP) * 1024;
      bf16_t* xb = (bf16_t*)(ws + OFF_XB) + (size_t)r * 1024; float s = 0.f;
#pragma unroll
      for (int i = 0; i < 4; ++i) { const f32x4 v = *(const f32x4*)(xr + i * 256 + lane * 4); s += v[0] * v[0] + v[1] * v[1] + v[2] * v[2] + v[3] * v[3];
        u32x2 w; w.x = cvtpk(v[0], v[1]); w.y = cvtpk(v[2], v[3]); *(u32x2*)(xb + i * 256 + lane * 4) = w; }
#pragma unroll
      for (int o = 32; o > 0; o >>= 1) s += __shfl_xor(s, o);
      if (lane == 0) ((float*)(ws + OFF_RSTD))[r] = rsqrtf(s * (1.f / 1024.f) + 1e-6f);
    }
    for (int jb = bx; jb < 1856; jb += G) {
      float* tile = (float*)smem;
      if (jb < 1280) transpose_job(p.w_in, NIN, 1024, (jb / 80) * 64, (jb % 80) * 64, (bf16_t*)(ws + OFF_WIN), p.norm_g, true, tile);
      else if (jb < 1344) { const int q = jb - 1280; transpose_job(p.w_glu, 512, 512, (q / 8) * 64, (q % 8) * 64, (bf16_t*)(ws + OFF_WGLU), nullptr, false, tile); }
      else if (jb < 1600) { const int q = jb - 1344, i = q / 128, r = q % 128;
        transpose_job(p.w_branch + (size_t)i * 512 * 1024, 1024, 512, (r / 16) * 64, (r % 16) * 64, (bf16_t*)(ws + OFF_WBR) + (size_t)i * 1024 * 512, nullptr, false, tile); }
      else { const int q = jb - 1600; transpose_job(p.w_out, 1024, 1024, (q / 16) * 64, (q % 16) * 64, (bf16_t*)(ws + OFF_WOUT), nullptr, false, tile); }
    }
    const int gt = bx * 512 + tid, GT = G * 512;
    for (int i = gt; i < 8192 * 32; i += GT) { const int pos = i >> 5, k = i & 31;
      const float ex = (float)k * 2.0f / 64.0f; const float invf = (float)(1.0 / pow(10000.0, (double)ex));
      const float ang = (float)pos * invf; const double rev = (double)ang * 0.15915494309189535; const float fr2 = (float)(2.0 * (rev - floor(rev)));
      float* rt = (float*)(ws + OFF_ROT) + (size_t)pos * 64; rt[k] = cospif(fr2); rt[32 + k] = sinpif(fr2); }
    for (int i = gt; i < MT; i += GT) ((float*)(ws + OFF_SSQ))[i] = 0.f;
    if (gt < 4096) { const int dir = gt >> 11, g = (gt >> 6) & 31, s = gt & 63;
      const double dt = exp((double)p.log_dt[dir * 32 + g]);
      const double ar = (double)p.a_re[gt], ai = (double)p.a_im[gt];
      const double mag = exp(ar * dt); const double ph = ai * dt * 0.3183098861837907; const float ph2 = (float)(ph - 2.0 * floor(ph * 0.5));
      const double lr = mag * (double)cospif(ph2), li = mag * (double)sinpif(ph2);
      float* lm = (float*)(ws + OFF_LAM) + (size_t)gt * 2; lm[0] = (float)lr; lm[1] = (float)li;
      const double den = ar * ar + ai * ai, cr = ((lr - 1.0) * ar + li * ai) / den, ci = (li * ar - (lr - 1.0) * ai) / den;
      bf16_t* BBp = (bf16_t*)(ws + OFF_BB) + (size_t)(dir * 32 + g) * 128 * 16;
      const int nbr = (s >> 5) * 2, jj = s & 31;
      for (int c = 0; c < 16; ++c) { const double br = (double)p.b_re[(size_t)gt * 16 + c], bi = (double)p.b_im[(size_t)gt * 16 + c];
        BBp[((nbr) * 32 + jj) * 16 + c] = (bf16_t)(cvtpk((float)(cr * br - ci * bi), 0.f) & 0xffffu);
        BBp[((nbr + 1) * 32 + jj) * 16 + c] = (bf16_t)(cvtpk((float)(cr * bi + ci * br), 0.f) & 0xffffu); }
      bf16_t* CBp = (bf16_t*)(ws + OFF_CB) + (size_t)(dir * 32 + g) * 128 * 16;
      for (int c = 0; c < 16; ++c) { const float cre = p.c_re[((size_t)(dir * 32 + g) * 16 + c) * 64 + s], cim = p.c_im[((size_t)(dir * 32 + g) * 16 + c) * 64 + s];
        const int k = 2 * s, kk = k >> 5, kp = k & 31;
        *(unsigned*)(CBp + (kk * 16 + c) * 32 + kp) = cvtpk(cre, -cim); }
    }
    if (gt == 0) { float s1 = 0.f, s2 = 0.f; for (int i = 0; i < 64; ++i) { s1 += p.lq1[i] * p.lk1[i]; s2 += p.lq2[i] * p.lk2[i]; }
      ((float*)(ws + OFF_CTL))[8] = expf(s1) - expf(s2) + 0.2f; for (int i = 0; i < 64; ++i) if (i != 8) ((unsigned*)(ws + OFF_CTL))[i] = 0u; }
  }
  SEAM(0);

  if (IN(1)) for (int rep = 0; rep < NREP(1); ++rep) {
    pg8::Gemm g{(const bf16_t*)(ws + OFF_XB), (const bf16_t*)(ws + OFF_WIN), MT, NIN, 1024}; pg8::StaticOrder S; S.init(MT, NIN, G, bx);
    EpiIn E{ws, gsga, (const float*)(ws + OFF_RSTD), (const float*)(ws + OFF_ROT)};
    pg8::gemm_phase<EpiIn>((LAS unsigned char*)smem, g, S, E);
  }
  SEAM(1);

  if (IN(2)) for (int rep = 0; rep < NREP(2); ++rep) {
    const int xq = bx & 7;
    unsigned* ctr = (unsigned*)(ws + OFF_CTL) + 16 + rep * 8 + xq; volatile unsigned* bc = (volatile unsigned*)(smem + LDS_BYTES - 16);
    const bf16_t* QB = (const bf16_t*)(ws + OFF_QB); const bf16_t* KB = (const bf16_t*)(ws + OFF_KB); const bf16_t* VB = (const bf16_t*)(ws + OFF_VB); bf16_t* AO = (bf16_t*)(ws + OFF_AO);
    for (;;) {
      __syncthreads();
      if (tid == 0) *bc = atomicAdd(ctr, 1u);
      __syncthreads();
      const int it = (int)*bc;
      if (it >= 336) break;
      const bool is_scan = it < 8 || (it >= 264 && it < 272);
      if ((p2mode == 1 && !is_scan) || (p2mode == 2 && is_scan)) continue;
      if (is_scan) {
        const bool lng = it < 8; const int s = (xq * 8 + (lng ? it : it - 264)) * 8 + wid;
        const int b = s >> 6, g = (s >> 1) & 31, dir = s & 1;
        scan_seq(ws, lng ? MP + b * 8192 : b * 2048, lng ? 8192 : 2048, g, dir, (char*)smem + wid * SCAN_WAVE_LDS, lane);
      } else {
        const bool lng = it < 264; const int u = lng ? it - 8 : it - 272;
        const int nqb = lng ? 32 : 8, L = lng ? 8192 : 2048;
        const int qb = u % nqb, vh = u / nqb, b = xq;
        const size_t rb = lng ? (size_t)MP + (size_t)b * 8192 : (size_t)b * 2048;
        att::attn_unit(QB + (rb + qb * 256) * 512 + vh * 64, KB + rb * 512 + vh * 64, VB + rb * 512 + (vh >> 1) * 128, AO + (rb + qb * 256) * 1024 + vh * 128, L, (LAS unsigned char*)smem);
      }
    }
  }
  SEAM(2);

  if (IN(3)) for (int rep = 0; rep < NREP(3); ++rep) {
    const float lam = ((const float*)(ws + OFF_CTL))[8];
    const bf16_t* YF = (const bf16_t*)(ws + OFF_YF); const bf16_t* YB = (const bf16_t*)(ws + OFF_YB); const bf16_t* XS = (const bf16_t*)(ws + OFF_XS);
    const bf16_t* AO = (const bf16_t*)(ws + OFF_AO); const bf16_t* ZA = (const bf16_t*)(ws + OFF_ZA);
    bf16_t* YSG = (bf16_t*)(ws + OFF_YSG); bf16_t* YAN = (bf16_t*)(ws + OFF_YAN);
    const int c0 = lane * 8; const f32x4 dk0 = *(const f32x4*)(p.ssm_d + c0), dk1 = *(const f32x4*)(p.ssm_d + c0 + 4);
    const int h = lane >> 4, e0 = (lane & 15) * 8; const f32x4 sg0 = *(const f32x4*)(p.subln_g + e0) * 0.8f, sg1 = *(const f32x4*)(p.subln_g + e0 + 4) * 0.8f;
    for (int r = bx * 8 + wid; r < MT; r += G * 8) {
      f32x4 f0, f1, b0, b1, x0, x1;
      unpack8(*(const u32x4*)(YF + (size_t)r * 512 + c0), f0, f1); unpack8(*(const u32x4*)(YB + (size_t)r * 512 + c0), b0, b1); unpack8(*(const u32x4*)(XS + (size_t)r * 512 + c0), x0, x1);
      f32x4 v0 = f0 + b0 + dk0 * x0, v1 = f1 + b1 + dk1 * x1;
#pragma unroll
      for (int i = 0; i < 4; ++i) { v0[i] = gelu_tanh(v0[i]); v1[i] = gelu_tanh(v1[i]); }
      f32x4 p0, p1, q0, q1, z0, z1;
      unpack8(*(const u32x4*)(AO + (size_t)r * 1024 + (2 * h) * 128 + e0), p0, p1); unpack8(*(const u32x4*)(AO + (size_t)r * 1024 + (2 * h + 1) * 128 + e0), q0, q1);
      unpack8(*(const u32x4*)(ZA + (size_t)r * 512 + h * 128 + e0), z0, z1);
      *(u32x4*)(YSG + (size_t)r * 512 + c0) = pack8(v0, v1);
      f32x4 o0 = p0 - lam * q0, o1 = p1 - lam * q1;
      float ss = 0.f;
#pragma unroll
      for (int i = 0; i < 4; ++i) ss += o0[i] * o0[i] + o1[i] * o1[i];
      ss += __shfl_xor(ss, 1); ss += __shfl_xor(ss, 2); ss += __shfl_xor(ss, 4); ss += __shfl_xor(ss, 8);
      const float rn = rsqrtf(ss * (1.f / 128.f) + 1e-5f);
      o0 = o0 * rn * sg0 * z0; o1 = o1 * rn * sg1 * z1;
      *(u32x4*)(YAN + (size_t)r * 512 + h * 128 + e0) = pack8(o0, o1);
    }
  }
  SEAM(3);

  if (IN(4)) for (int rep = 0; rep < NREP(4); ++rep) {
    pg8::Gemm g{(const bf16_t*)(ws + OFF_YSG), (const bf16_t*)(ws + OFF_WGLU), MT, 512, 512}; pg8::StaticOrder S; S.init(MT, 512, G, bx);
    EpiGlu E{(const bf16_t*)(ws + OFF_YSG), (const bf16_t*)(ws + OFF_ZS), p.b_glu, (bf16_t*)(ws + OFF_YS2)};
    pg8::gemm_phase<EpiGlu>((LAS unsigned char*)smem, g, S, E);
  }
  SEAM(4);

  if (IN(5)) for (int rep = 0; rep < NREP(5); ++rep) {
    pg8::StaticOrder S; S.init(MT, 1024, G, bx);
    { pg8::Gemm g{(const bf16_t*)(ws + OFF_YS2), (const bf16_t*)(ws + OFF_WBR), MT, 1024, 512};
      EpiBr<0> E{gsga, (bf16_t*)(ws + OFF_PS), nullptr}; pg8::gemm_phase<EpiBr<0>>((LAS unsigned char*)smem, g, S, E); }
    __syncthreads();
    { pg8::Gemm g{(const bf16_t*)(ws + OFF_YAN), (const bf16_t*)(ws + OFF_WBR) + (size_t)1024 * 512, MT, 1024, 512};
      EpiBr<1> E{gsga + (size_t)MT * 1024, (bf16_t*)(ws + OFF_PS), (bf16_t*)(ws + OFF_MG)}; pg8::gemm_phase<EpiBr<1>>((LAS unsigned char*)smem, g, S, E); }
  }
  SEAM(5);

  if (IN(6)) {
    pg8::Gemm g{(const bf16_t*)(ws + OFF_MG), (const bf16_t*)(ws + OFF_WOUT), MT, 1024, 1024}; pg8::StaticOrder S; S.init(MT, 1024, G, bx);
    EpiOut E{p.x_p, p.x_s, p.out, (float*)(ws + OFF_SSQ)};
    pg8::gemm_phase<EpiOut>((LAS unsigned char*)smem, g, S, E);
  }
  SEAM(6);

  if (IN(7)) {
    const float* ssq = (const float*)(ws + OFF_SSQ);
    f32x4 fg[4];
#pragma unroll
    for (int i = 0; i < 4; ++i) fg[i] = *(const f32x4*)(p.final_g + i * 256 + lane * 4);
    for (int r = bx * 8 + wid; r < MT; r += G * 8) {
      const float rn = rsqrtf(ssq[r] * (1.f / 1024.f) + 1e-6f); float* orow = p.out + (size_t)r * 1024;
#pragma unroll
      for (int i = 0; i < 4; ++i) { f32x4 v = *(f32x4*)(orow + i * 256 + lane * 4); *(f32x4*)(orow + i * 256 + lane * 4) = v * rn * fg[i]; }
    }
  }

#ifdef DUMP
  if (IN(8)) {
    for (int r = bx * 8 + wid; r < MT; r += G * 8) {
      float* orow = p.out + (size_t)r * 1024;
      for (int c = lane; c < 512; c += 64) {
        float a = 0.f, b = 0.f; const size_t i5 = (size_t)r * 512 + c, i1 = (size_t)r * 1024 + c;
#define BF(off, idx) bflo((unsigned)((const bf16_t*)(ws + (off)))[idx])
        if (DUMP == 1) { a = BF(OFF_XS, i5) + BF(OFF_ZS, i5) + BF(OFF_VB, i5); b = BF(OFF_QB, i5) + BF(OFF_KB, i5) + BF(OFF_ZA, i5); }
        if (DUMP == 2) { a = BF(OFF_YF, i5) + BF(OFF_YB, i5); b = BF(OFF_AO, i1) + BF(OFF_AO, i1 + 512); }
        if (DUMP == 3) { a = BF(OFF_YSG, i5) + BF(OFF_YAN, i5) + BF(OFF_YS2, i5); b = BF(OFF_MG, i1) + BF(OFF_MG, i1 + 512); }
        if (DUMP == 4) { a = BF(OFF_YF, i5); b = BF(OFF_YB, i5); }
        if (DUMP == 5) { a = BF(OFF_AO, i1); b = BF(OFF_AO, i1 + 512); }
#undef BF
        orow[c] = a; orow[512 + c] = b;
      }
    }
  }
#endif
#undef IN
#undef SEAM
#undef tid
#undef lane
#undef wid
}

#ifndef N_LAUNCH_PER_PHASE
#define N_LAUNCH_PER_PHASE 0
#endif
extern "C" void kernel_launch(void* const* d_in, const int* in_sizes, int n_in, void* d_out, int out_size, void* d_ws, size_t ws_size, hipStream_t stream) {
  static int grid = 0;
  if (grid == 0) {
    if (n_in != 22 || out_size != MT * 1024 || ws_size < WS_END) { fprintf(stderr, "kernel_launch: unexpected shapes n_in %d out %d ws %zu (need %zu)\n", n_in, out_size, ws_size, (size_t)WS_END); grid = -1; return; }
    int dev = 0, cus = 0, per_cu = 0;
    hipGetDevice(&dev); hipDeviceGetAttribute(&cus, hipDeviceAttributeMultiprocessorCount, dev);
    if (hipFuncSetAttribute((const void*)fwd_mega, hipFuncAttributeMaxDynamicSharedMemorySize, LDS_BYTES) != hipSuccess) { fprintf(stderr, "kernel_launch: hipFuncSetAttribute failed\n"); grid = -1; return; }
    if (hipOccupancyMaxActiveBlocksPerMultiprocessor(&per_cu, (const void*)fwd_mega, 512, LDS_BYTES) != hipSuccess || per_cu < 1) { fprintf(stderr, "kernel_launch: occupancy query says %d\n", per_cu); per_cu = 1; }
    (void)hipGetLastError();
    grid = cus * 1;
  }
  if (grid < 0) return;
  Params p{};
  p.x_p = (const float*)d_in[0]; p.x_s = (const float*)d_in[1]; p.norm_g = (const float*)d_in[2]; p.w_in = (const float*)d_in[3];
  p.a_re = (const float*)d_in[4]; p.a_im = (const float*)d_in[5]; p.log_dt = (const float*)d_in[6]; p.b_re = (const float*)d_in[7]; p.b_im = (const float*)d_in[8];
  p.c_re = (const float*)d_in[9]; p.c_im = (const float*)d_in[10]; p.ssm_d = (const float*)d_in[11]; p.w_glu = (const float*)d_in[12]; p.b_glu = (const float*)d_in[13];
  p.lq1 = (const float*)d_in[14]; p.lk1 = (const float*)d_in[15]; p.lq2 = (const float*)d_in[16]; p.lk2 = (const float*)d_in[17]; p.subln_g = (const float*)d_in[18];
  p.w_branch = (const float*)d_in[19]; p.w_out = (const float*)d_in[20]; p.final_g = (const float*)d_in[21];
  p.out = (float*)d_out; p.ws = (unsigned char*)d_ws;
#if N_LAUNCH_PER_PHASE
  #ifdef DUMP
  const int nph = 9;
#else
  const int nph = 8;
#endif
  for (int ph = 0; ph < nph; ++ph) { p.ph_lo = ph; p.ph_hi = ph + 1; hipLaunchKernelGGL(fwd_mega, dim3(grid), dim3(512), LDS_BYTES, stream, p); }
#else
#ifdef PREFIX_HI
#ifndef P2MODE
#define P2MODE 0
#endif
  for (int ph = 0; ph < PREFIX_HI; ++ph) { p.ph_lo = ph; p.ph_hi = (ph + 1) | (ph == 2 ? (P2MODE << 8) : 0); hipLaunchKernelGGL(fwd_mega, dim3(grid), dim3(512), LDS_BYTES, stream, p); }
#endif
  p.ph_lo = 0; p.ph_hi = 8;
  void* args[] = {&p};
  hipError_t e = hipLaunchCooperativeKernel((const void*)fwd_mega, dim3(grid), dim3(512), args, LDS_BYTES, stream);
  if (e != hipSuccess) fprintf(stderr, "cooperative launch failed: %s (grid %d)\n", hipGetErrorString(e), grid);
#endif
}
```

```cpp
#include <hip/hip_runtime.h>
#include <hip/hip_cooperative_groups.h>
#include <cstdio>
#include <cstdint>
namespace cg = cooperative_groups;

#define LAS __attribute__((address_space(3)))
typedef unsigned short bf16_t;
typedef short bf16x8 __attribute__((ext_vector_type(8)));
typedef short s16x4 __attribute__((ext_vector_type(4)));
typedef float f32x4 __attribute__((ext_vector_type(4)));
typedef float f32x16 __attribute__((ext_vector_type(16)));
typedef unsigned u32x4 __attribute__((ext_vector_type(4)));
typedef unsigned u32x2 __attribute__((ext_vector_type(2)));

constexpr int DM = 1024, NIN = 5120, MP = 8 * 2048, MS = 8 * 8192, MT = MP + MS;
constexpr size_t UB = (size_t)MT * 512 * 2;
constexpr size_t OFF_XB = 0;
constexpr size_t OFF_XS = 2 * UB, OFF_ZS = 3 * UB, OFF_QB = 4 * UB, OFF_KB = 5 * UB, OFF_VB = 6 * UB, OFF_ZA = 7 * UB;
constexpr size_t OFF_YF = 8 * UB, OFF_YB = 9 * UB;
constexpr size_t OFF_YSG = OFF_QB, OFF_YAN = OFF_KB, OFF_YS2 = OFF_VB, OFF_AO = OFF_XB, OFF_PS = OFF_XB, OFF_MG = OFF_YF;
constexpr size_t OFF_WIN = 10 * UB;
constexpr size_t OFF_WGLU = OFF_WIN + (size_t)NIN * DM * 2;
constexpr size_t OFF_WBR = OFF_WGLU + 512 * 512 * 2;
constexpr size_t OFF_WOUT = OFF_WBR + 2 * 1024 * 512 * 2;
constexpr size_t OFF_RSTD = OFF_WOUT + 1024 * 1024 * 2;
constexpr size_t OFF_SSQ = OFF_RSTD + (size_t)MT * 4;
constexpr size_t OFF_ROT = OFF_SSQ + (size_t)MT * 4;
constexpr size_t OFF_LAM = OFF_ROT + 8192 * 64 * 4;
constexpr size_t OFF_BB = OFF_LAM + 2 * 32 * 64 * 2 * 4;
constexpr size_t OFF_CB = OFF_BB + 2 * 32 * 128 * 16 * 2;
constexpr size_t OFF_CTL = OFF_CB + 2 * 32 * 128 * 16 * 2;
constexpr size_t WS_END = OFF_CTL + 256;
constexpr int LDS_BYTES = 131072;

struct Params {
  const float* x_p; const float* x_s; const float* norm_g; const float* w_in;
  const float* a_re; const float* a_im; const float* log_dt; const float* b_re; const float* b_im;
  const float* c_re; const float* c_im; const float* ssm_d; const float* w_glu; const float* b_glu;
  const float* lq1; const float* lk1; const float* lq2; const float* lk2; const float* subln_g;
  const float* w_branch; const float* w_out; const float* final_g;
  float* out; unsigned char* ws; int ph_lo, ph_hi;
};

typedef __bf16 bf16x2_t __attribute__((ext_vector_type(2)));
typedef float f32x2_t __attribute__((ext_vector_type(2)));
__device__ __forceinline__ unsigned cvtpk(float lo, float hi) { f32x2_t v = {lo, hi}; bf16x2_t b = __builtin_convertvector(v, bf16x2_t); return *reinterpret_cast<unsigned*>(&b); }
__device__ __forceinline__ float bflo(unsigned w) { return __uint_as_float(w << 16); }
__device__ __forceinline__ float bfhi(unsigned w) { return __uint_as_float(w & 0xffff0000u); }
__device__ __forceinline__ float sigmoidf_(float x) { return __builtin_amdgcn_rcpf(1.f + __builtin_amdgcn_exp2f(-1.4426950408889634f * x)); }
__device__ __forceinline__ float siluf_(float x) { return x * sigmoidf_(x); }
__device__ __forceinline__ float gelu_tanh(float x) { const float u = x + 0.044715f * x * x * x; return x * sigmoidf_(1.5957691216057308f * u); }
__device__ __forceinline__ u32x4 pack8(f32x4 a, f32x4 b) { u32x4 w; w.x = cvtpk(a[0], a[1]); w.y = cvtpk(a[2], a[3]); w.z = cvtpk(b[0], b[1]); w.w = cvtpk(b[2], b[3]); return w; }
__device__ __forceinline__ void unpack8(u32x4 w, f32x4& a, f32x4& b) { a = (f32x4){bflo(w.x), bfhi(w.x), bflo(w.y), bfhi(w.y)}; b = (f32x4){bflo(w.z), bfhi(w.z), bflo(w.w), bfhi(w.w)}; }
__device__ __forceinline__ int tid_now() { const int w = __builtin_amdgcn_readfirstlane((int)threadIdx.x >> 6); return w * 64 + (int)__builtin_amdgcn_mbcnt_hi(~0u, __builtin_amdgcn_mbcnt_lo(~0u, 0u)); }
__device__ __forceinline__ int row_pos(int r) { return r < MP ? (r & 2047) : (r & 8191); }

namespace pg8 {
constexpr int BM = 256, BK = 64, HALF = 128, HTB = HALF * BK * 2, STAGE_BYTES = 8 * HTB, NXCD = 8, WGM = 8;
__host__ __device__ __forceinline__ int lds_byte(int r, int c) { const int st = (r >> 4) * 2 + (c >> 5), rr = r & 15, cc = c & 31, ob = rr * 64 + cc * 2; return st * 1024 + (ob ^ (((ob >> 9) & 1) << 5)); }
__host__ __device__ __forceinline__ void stage_rc(int b, int& R, int& C) { const int st = b / 1024, sb = b % 1024, swz = sb ^ (((sb >> 9) & 1) << 5); R = (st >> 1) * 16 + swz / 64; C = (st & 1) * 32 + (swz % 64) / 2; }
__host__ __device__ __forceinline__ int perm32(int rho) { const int n = rho >> 4, i = rho & 15; return 8 * (i >> 2) + 4 * n + (i & 3); }
struct Unit { int pm, pn; };
struct Gemm { const bf16_t* A; const bf16_t* Bt; int M, N, K; };
struct StaticOrder {
  int nM, nN, nwg, G, c;
  __device__ void init(int M, int N, int G_, int c_) { nM = M / BM; nN = N / BM; nwg = nM * nN; G = G_; c = c_; }
  __device__ bool next(int i, Unit& u) const {
    const long L = (long)i * G + c; if (L >= nwg) return false;
    int wgid = (int)L; { const int q = nwg / NXCD, r = nwg % NXCD, xcd = wgid % NXCD, off = wgid / NXCD; wgid = (xcd < r ? xcd * (q + 1) : r * (q + 1) + (xcd - r) * q) + off; }
    const int nig = WGM * nN, gid = wgid / nig, fm = gid * WGM, gsz = (nM - fm) < WGM ? (nM - fm) : WGM;
    u.pm = fm + ((wgid % nig) % gsz); u.pn = (wgid % nig) / gsz; return true;
  }
};
template <class Epi>
__device__ __forceinline__ void gemm_phase(LAS unsigned char* lds, const Gemm g, const StaticOrder& S, const Epi& E) {
  const int tid = tid_now(), wid = __builtin_amdgcn_readfirstlane(tid >> 6), lane = tid & 63, wr = wid >> 2, wc = wid & 3, fr = lane & 15, fq = lane >> 4;
  const int K = g.K, nt = K / BK;
  unsigned voffA[2], voffB[2];
#pragma unroll
  for (int i = 0; i < 2; ++i) { int R, C; stage_rc(tid * 16 + i * 8192, R, C); const int Rb = Epi::PERM ? ((R & ~31) + perm32(R & 31)) : R;
    voffA[i] = (unsigned)(R * K + C) * 2u; voffB[i] = (unsigned)(Rb * K + C) * 2u; }
  const size_t kstep = (size_t)(BK * 2), hstep = (size_t)HALF * K * 2, tstep = 2 * hstep;
  const unsigned ldsw = (unsigned)wid * 1024u;
  const int aoff = lds_byte(wr * 64 + fr, fq * 8), boff = lds_byte(wc * 32 + fr, fq * 8);
#define PG8_SA(b, h) (((b) * 2 + (h)) * HTB)
#define PG8_SB(b, h) ((4 + (b) * 2 + (h)) * HTB)
#define PG8_STAGE(bufoff, gbase, voff) do { _Pragma("unroll") for (int _i = 0; _i < 2; ++_i) \
    __builtin_amdgcn_global_load_lds((const unsigned*)((const char*)(gbase) + (voff)[_i]), (LAS unsigned*)(lds + (bufoff) + ldsw + _i * 8192), 16, 0, 0); } while (0)
#define PG8_LDA(dst, b, h) do { _Pragma("unroll") for (int m = 0; m < 4; ++m) _Pragma("unroll") for (int k = 0; k < 2; ++k) dst[m][k] = *(const LAS bf16x8*)(lds + PG8_SA(b, h) + aoff + m * 2048 + k * 1024); } while (0)
#define PG8_LDB(dst, b, h) do { _Pragma("unroll") for (int n = 0; n < 2; ++n) _Pragma("unroll") for (int k = 0; k < 2; ++k) dst[n][k] = *(const LAS bf16x8*)(lds + PG8_SB(b, h) + boff + n * 2048 + k * 1024); } while (0)
#define PG8_MMA(ai, bj, At, Bt) do { __builtin_amdgcn_s_setprio(1); _Pragma("unroll") for (int m = 0; m < 4; ++m) _Pragma("unroll") for (int n = 0; n < 2; ++n) _Pragma("unroll") for (int k = 0; k < 2; ++k) \
    acc[ai][bj][m][n] = __builtin_amdgcn_mfma_f32_16x16x32_bf16(Bt[n][k], At[m][k], acc[ai][bj][m][n], 0, 0, 0); __builtin_amdgcn_s_setprio(0); } while (0)
#define PG8_WAIT_V(n) asm volatile("s_waitcnt vmcnt(" #n ")" ::: "memory")
#define PG8_WAIT_L(n) asm volatile("s_waitcnt lgkmcnt(" #n ")" ::: "memory")
#define PG8_BAR __builtin_amdgcn_s_barrier()
#define PG8_SCHED __builtin_amdgcn_sched_barrier(0)
  Unit cur, nxt; int ui = 0;
  if (!S.next(0, cur)) return;
  f32x4 acc[2][2][4][2];
#pragma unroll
  for (int a = 0; a < 2; ++a)
#pragma unroll
    for (int b = 0; b < 2; ++b)
#pragma unroll
      for (int m = 0; m < 4; ++m)
#pragma unroll
        for (int n = 0; n < 2; ++n) acc[a][b][m][n] = (f32x4){0.f, 0.f, 0.f, 0.f};
  bf16x8 At[4][2], B0[2][2], B1[2][2];
  const char* cA = (const char*)g.A + (size_t)cur.pm * tstep; const char* cB = (const char*)g.Bt + (size_t)cur.pn * tstep;
  PG8_STAGE(PG8_SB(0, 0), cB, voffB); PG8_STAGE(PG8_SA(0, 0), cA, voffA); PG8_STAGE(PG8_SB(0, 1), cB + hstep, voffB); PG8_STAGE(PG8_SA(0, 1), cA + hstep, voffA);
  if (wr == 1) PG8_BAR;
  PG8_WAIT_V(4); PG8_BAR;
  PG8_STAGE(PG8_SB(1, 0), cB + kstep, voffB); PG8_STAGE(PG8_SA(1, 0), cA + kstep, voffA); PG8_STAGE(PG8_SB(1, 1), cB + hstep + kstep, voffB);
  PG8_WAIT_V(6); PG8_BAR;
  for (;;) {
    const bool has_next = S.next(ui + 1, nxt);
    const char* nA = has_next ? (const char*)g.A + (size_t)nxt.pm * tstep : cA; const char* nB = has_next ? (const char*)g.Bt + (size_t)nxt.pn * tstep : cB;
    for (int t = 0; t < nt; t += 2) {
      const bool last = (t == nt - 2);
      const char* a1 = cA + (size_t)(t + 1) * kstep;
      const char* a2 = last ? nA : cA + (size_t)(t + 2) * kstep; const char* b2 = last ? nB : cB + (size_t)(t + 2) * kstep;
      const char* a3 = a2 + kstep; const char* b3 = b2 + kstep;
      PG8_LDB(B0, 0, 0); PG8_SCHED; PG8_LDA(At, 0, 0); PG8_STAGE(PG8_SA(1, 1), a1 + hstep, voffA);
      PG8_WAIT_L(8); PG8_BAR; PG8_WAIT_L(0); PG8_MMA(0, 0, At, B0); PG8_BAR; PG8_SCHED;
      PG8_LDB(B1, 0, 1); PG8_STAGE(PG8_SB(0, 0), b2, voffB);
      PG8_BAR; PG8_WAIT_L(0); PG8_MMA(0, 1, At, B1); PG8_BAR;
      PG8_LDA(At, 0, 1); PG8_STAGE(PG8_SA(0, 0), a2, voffA);
      PG8_BAR; PG8_WAIT_L(0); PG8_MMA(1, 0, At, B0); PG8_BAR; PG8_SCHED;
      PG8_STAGE(PG8_SB(0, 1), b2 + hstep, voffB);
      PG8_WAIT_V(6); PG8_BAR; PG8_MMA(1, 1, At, B1); PG8_BAR;
      PG8_LDB(B0, 1, 0); PG8_SCHED; PG8_LDA(At, 1, 0); PG8_STAGE(PG8_SA(0, 1), a2 + hstep, voffA);
      PG8_WAIT_L(8); PG8_BAR; PG8_WAIT_L(0); PG8_MMA(0, 0, At, B0); PG8_BAR; PG8_SCHED;
      PG8_LDB(B1, 1, 1); PG8_STAGE(PG8_SB(1, 0), b3, voffB);
      PG8_BAR; PG8_WAIT_L(0); PG8_MMA(0, 1, At, B1); PG8_BAR;
      PG8_LDA(At, 1, 1); PG8_STAGE(PG8_SA(1, 0), a3, voffA);
      PG8_BAR; PG8_WAIT_L(0); PG8_MMA(1, 0, At, B0); PG8_BAR; PG8_SCHED;
      PG8_STAGE(PG8_SB(1, 1), b3 + hstep, voffB);
      PG8_WAIT_V(6); PG8_BAR; PG8_MMA(1, 1, At, B1); PG8_BAR;
    }
    E(acc, cur, wr, wc, fr, fq);
    if (!has_next) break;
#pragma unroll
    for (int a = 0; a < 2; ++a)
#pragma unroll
      for (int b = 0; b < 2; ++b)
#pragma unroll
        for (int m = 0; m < 4; ++m)
#pragma unroll
          for (int n = 0; n < 2; ++n) acc[a][b][m][n] = (f32x4){0.f, 0.f, 0.f, 0.f};
    cur = nxt; cA = nA; cB = nB; ++ui;
  }
  PG8_WAIT_V(0);
  if (wr == 0) PG8_BAR;
  PG8_BAR;
#undef PG8_SA
#undef PG8_SB
#undef PG8_STAGE
#undef PG8_LDA
#undef PG8_LDB
#undef PG8_MMA
#undef PG8_WAIT_V
#undef PG8_WAIT_L
#undef PG8_BAR
#undef PG8_SCHED
}
}

struct EpiIn {
  static constexpr bool PERM = true;
  unsigned char* ws; bf16_t* gsga; const float* rstd; const float* rot;
  __device__ __forceinline__ void operator()(const f32x4 (&acc)[2][2][4][2], const pg8::Unit& u, int wr, int wc, int fr, int fq) const {
    const int pn = u.pn, row0 = u.pm * 256 + wr * 64 + fr, col0 = wc * 32 + 8 * fq;
    if (pn >= 4 && pn < 8) {
      bf16_t* base = (bf16_t*)(ws + (pn < 6 ? OFF_QB : OFF_KB));
      const int lc = ((pn & 1) * 4 + wc) * 64 + 8 * fq;
#pragma unroll
      for (int ai = 0; ai < 2; ++ai)
#pragma unroll
        for (int m = 0; m < 4; ++m) {
          const int r = row0 + ai * 128 + m * 16; const float rs = rstd[r];
          const float* rp = rot + (size_t)row_pos(r) * 64 + 8 * fq;
          const f32x4 c0 = *(const f32x4*)(rp), c1 = *(const f32x4*)(rp + 4), s0 = *(const f32x4*)(rp + 32), s1 = *(const f32x4*)(rp + 36);
          const float rq = pn < 6 ? rs * 0.18033688011112042f : rs;
          const f32x4 a0 = acc[ai][0][m][0] * rq, a1 = acc[ai][0][m][1] * rq, b0 = acc[ai][1][m][0] * rq, b1 = acc[ai][1][m][1] * rq;
          const f32x4 o10 = a0 * c0 - b0 * s0, o11 = a1 * c1 - b1 * s1, o20 = b0 * c0 + a0 * s0, o21 = b1 * c1 + a1 * s1;
          bf16_t* rowp = base + (size_t)r * 512 + lc;
          *(u32x4*)(rowp) = pack8(o10, o11); *(u32x4*)(rowp + 32) = pack8(o20, o21);
        }
    } else {
      bf16_t* base; int ldc, colt, act;
      if (pn < 2) { base = (bf16_t*)(ws + OFF_XS); ldc = 512; colt = pn * 256; act = 0; }
      else if (pn < 4) { base = (bf16_t*)(ws + OFF_ZS); ldc = 512; colt = (pn - 2) * 256; act = 1; }
      else if (pn < 10) { base = (bf16_t*)(ws + OFF_VB); ldc = 512; colt = (pn - 8) * 256; act = 0; }
      else if (pn < 12) { base = (bf16_t*)(ws + OFF_ZA); ldc = 512; colt = (pn - 10) * 256; act = 1; }
      else if (pn < 16) { base = gsga; ldc = 1024; colt = (pn - 12) * 256; act = 2; }
      else { base = gsga + (size_t)MT * 1024; ldc = 1024; colt = (pn - 16) * 256; act = 2; }
#pragma unroll
      for (int ai = 0; ai < 2; ++ai)
#pragma unroll
        for (int m = 0; m < 4; ++m) {
          const int r = row0 + ai * 128 + m * 16; const float rs = rstd[r];
          bf16_t* rowp = base + (size_t)r * ldc + colt + col0;
#pragma unroll
          for (int bj = 0; bj < 2; ++bj) {
            f32x4 v0 = acc[ai][bj][m][0] * rs, v1 = acc[ai][bj][m][1] * rs;
            if (act == 1) {
#pragma unroll
              for (int j = 0; j < 4; ++j) { v0[j] = siluf_(v0[j]); v1[j] = siluf_(v1[j]); } }
            else if (act == 2) {
#pragma unroll
              for (int j = 0; j < 4; ++j) { v0[j] = sigmoidf_(v0[j]); v1[j] = sigmoidf_(v1[j]); } }
            *(u32x4*)(rowp + bj * 128) = pack8(v0, v1);
          }
        }
    }
  }
};
struct EpiGlu {
  static constexpr bool PERM = true;
  const bf16_t* ysg; const bf16_t* zs; const float* bias; bf16_t* out;
  __device__ __forceinline__ void operator()(const f32x4 (&acc)[2][2][4][2], const pg8::Unit& u, int wr, int wc, int fr, int fq) const {
    const int row0 = u.pm * 256 + wr * 64 + fr, col0 = u.pn * 256 + wc * 32 + 8 * fq;
#pragma unroll
    for (int ai = 0; ai < 2; ++ai)
#pragma unroll
      for (int m = 0; m < 4; ++m) {
        const size_t ro = (size_t)(row0 + ai * 128 + m * 16) * 512 + col0;
#pragma unroll
        for (int bj = 0; bj < 2; ++bj) {
          const f32x4 bb0 = *(const f32x4*)(bias + col0 + bj * 128), bb1 = *(const f32x4*)(bias + col0 + bj * 128 + 4);
          f32x4 y0, y1, z0, z1; unpack8(*(const u32x4*)(ysg + ro + bj * 128), y0, y1); unpack8(*(const u32x4*)(zs + ro + bj * 128), z0, z1);
          f32x4 v0 = acc[ai][bj][m][0] + bb0, v1 = acc[ai][bj][m][1] + bb1;
#pragma unroll
          for (int j = 0; j < 4; ++j) { v0[j] = y0[j] * sigmoidf_(v0[j]) * z0[j]; v1[j] = y1[j] * sigmoidf_(v1[j]) * z1[j]; }
          *(u32x4*)(out + ro + bj * 128) = pack8(v0, v1);
        }
      }
  }
};
template <int MODE> struct EpiBr {
  static constexpr bool PERM = true;
  const bf16_t* gate; bf16_t* ps; bf16_t* out;
  __device__ __forceinline__ void operator()(const f32x4 (&acc)[2][2][4][2], const pg8::Unit& u, int wr, int wc, int fr, int fq) const {
    const int row0 = u.pm * 256 + wr * 64 + fr, col0 = u.pn * 256 + wc * 32 + 8 * fq;
#pragma unroll
    for (int ai = 0; ai < 2; ++ai)
#pragma unroll
      for (int m = 0; m < 4; ++m) {
        const size_t ro = (size_t)(row0 + ai * 128 + m * 16) * 1024 + col0;
#pragma unroll
        for (int bj = 0; bj < 2; ++bj) {
          f32x4 g0, g1; unpack8(*(const u32x4*)(gate + ro + bj * 128), g0, g1);
          f32x4 v0 = acc[ai][bj][m][0] * g0, v1 = acc[ai][bj][m][1] * g1;
          if (MODE == 1) { f32x4 p0, p1; unpack8(*(const u32x4*)(ps + ro + bj * 128), p0, p1); v0 += p0; v1 += p1; *(u32x4*)(out + ro + bj * 128) = pack8(v0, v1); }
          else *(u32x4*)(ps + ro + bj * 128) = pack8(v0, v1);
        }
      }
  }
};
struct EpiOut {
  static constexpr bool PERM = false;
  const float* x_p; const float* x_s; float* out; float* ssq;
  __device__ __forceinline__ void operator()(const f32x4 (&acc)[2][2][4][2], const pg8::Unit& u, int wr, int wc, int fr, int fq) const {
    const int row0 = u.pm * 256 + wr * 64 + fr, col0 = u.pn * 256 + wc * 32 + 4 * fq;
#pragma unroll
    for (int ai = 0; ai < 2; ++ai)
#pragma unroll
      for (int m = 0; m < 4; ++m) {
        const int r = row0 + ai * 128 + m * 16;
        const float* xr = (r < MP ? x_p + (size_t)r * 1024 : x_s + (size_t)(r - MP) * 1024) + col0;
        float* orow = out + (size_t)r * 1024 + col0; float s = 0.f;
#pragma unroll
        for (int bj = 0; bj < 2; ++bj)
#pragma unroll
          for (int n = 0; n < 2; ++n) { const f32x4 y = acc[ai][bj][m][n] + *(const f32x4*)(xr + bj * 128 + n * 16);
            *(f32x4*)(orow + bj * 128 + n * 16) = y; s += y[0] * y[0] + y[1] * y[1] + y[2] * y[2] + y[3] * y[3]; }
        s += __shfl_xor(s, 16); s += __shfl_xor(s, 32);
        if (fq == 0) atomicAdd(ssq + r, s);
      }
  }
};

namespace att {
constexpr int NW = 8, QBLK = 32, KVBLK = 64, LD = 512, LDO = 1024;
constexpr float SCALE = 0.125f, THR = 8.f;
constexpr int SHM_K = KVBLK * 64 * 2, SHM_V = KVBLK * 128 * 2, OFF_KB0 = 0, OFF_VB0 = 2 * SHM_K, OFF_AUX = 2 * SHM_K + 2 * SHM_V;
#define KSWZ(row, colB) ((row) * 128 + ((colB) ^ ((((row) >> 1) & 7) << 4)))
__device__ __forceinline__ int crow(int r, int hi) { return (r & 3) + 8 * (r >> 2) + 4 * hi; }
constexpr float THR2 = THR * 1.4426950408889634f;
template <bool FIRST>
__device__ __forceinline__ void sm_max(f32x16& p0, f32x16& p1, f32x16& minit, float& alpha) {
  float pmax = p0[0];
#pragma unroll
  for (int r = 1; r < 16; ++r) pmax = fmaxf(pmax, p0[r]);
#pragma unroll
  for (int r = 0; r < 16; ++r) pmax = fmaxf(pmax, p1[r]);
  { auto rr = __builtin_amdgcn_permlane32_swap(__float_as_uint(pmax), __float_as_uint(pmax), false, false);
    pmax = fmaxf(__uint_as_float(rr[0]), __uint_as_float(rr[1])); }
  alpha = 1.f;
  if (FIRST || !__all(pmax <= THR2)) {
    const float dl = FIRST ? pmax : fmaxf(pmax, 0.f);
    alpha = FIRST ? 1.f : __builtin_amdgcn_exp2f(-dl);
#pragma unroll
    for (int r = 0; r < 16; ++r) { p0[r] -= dl; p1[r] -= dl; minit[r] -= dl; }
  }
}
__device__ __forceinline__ void sm_exp(f32x16& p0, f32x16& p1, float alpha, float& l_reg, bf16x8& pa0, bf16x8& pa1, bf16x8& pa2, bf16x8& pa3) {
#pragma unroll
  for (int r = 0; r < 16; ++r) p0[r] = __builtin_amdgcn_exp2f(p0[r]);
#pragma unroll
  for (int r = 0; r < 16; ++r) p1[r] = __builtin_amdgcn_exp2f(p1[r]);
  { float ps = 0;
#pragma unroll
    for (int r = 0; r < 16; ++r) ps += p0[r];
#pragma unroll
    for (int r = 0; r < 16; ++r) ps += p1[r];
    auto rr = __builtin_amdgcn_permlane32_swap(__float_as_uint(ps), __float_as_uint(ps), false, false);
    l_reg = l_reg * alpha + (__uint_as_float(rr[0]) + __uint_as_float(rr[1])); }
#define PK4(P, BASE, OUT) do { u32x4 w = {cvtpk(P[BASE + 0], P[BASE + 1]), cvtpk(P[BASE + 2], P[BASE + 3]), cvtpk(P[BASE + 4], P[BASE + 5]), cvtpk(P[BASE + 6], P[BASE + 7])}; \
    OUT = *reinterpret_cast<bf16x8*>(&w); } while (0)
  PK4(p0, 0, pa0); PK4(p0, 8, pa1); PK4(p1, 0, pa2); PK4(p1, 8, pa3);
#undef PK4
}
__device__ __forceinline__ int v_st(int k, int c) { const int kk = k; return ((kk >> 3) * 4 + (c >> 5)) * 512 + ((kk & 7) * 32 + (c & 31)) * 2; }
__device__ __forceinline__ int v_rd_base(int lane) { return ((lane & 3) << 3) | (((lane >> 2) & 3) << 6) | (((lane >> 4) & 1) << 5) | (((lane >> 5) & 1) << 8); }
constexpr int v_rd_off(int d0, int ks, int half) { return d0 * 512 + ks * 4096 + half * 2048; }
__device__ __forceinline__ s16x4 tr_read(const LAS unsigned char* p) { return __builtin_amdgcn_ds_read_tr16_b64_v4i16((LAS s16x4*)p); }
#define SBAR() __builtin_amdgcn_sched_barrier(0)
#define PKF(L, H) (bf16x8){L[0], L[1], L[2], L[3], H[0], H[1], H[2], H[3]}
#define ABAR() do { asm volatile("s_waitcnt lgkmcnt(0)" ::: "memory"); __builtin_amdgcn_s_barrier(); asm volatile("" ::: "memory"); } while (0)
__device__ __forceinline__ void qk_tile(f32x16& n0, f32x16& n1, const LAS unsigned char* Ks, const bf16x8* qr, const f32x16& minit, int r32, int hi) {
#pragma unroll
  for (int d0 = 0; d0 < 4; ++d0) { const int cb = (d0 * 16 + hi * 8) * 2;
    const bf16x8 b0 = *(const LAS bf16x8*)(Ks + KSWZ(r32, cb)); const bf16x8 b1 = *(const LAS bf16x8*)(Ks + KSWZ(32 + r32, cb));
    if (d0 == 0) { n0 = __builtin_amdgcn_mfma_f32_32x32x16_bf16(b0, qr[0], minit, 0, 0, 0); n1 = __builtin_amdgcn_mfma_f32_32x32x16_bf16(b1, qr[0], minit, 0, 0, 0); }
    else { n0 = __builtin_amdgcn_mfma_f32_32x32x16_bf16(b0, qr[d0], n0, 0, 0, 0); n1 = __builtin_amdgcn_mfma_f32_32x32x16_bf16(b1, qr[d0], n1, 0, 0, 0); } }
}
__device__ __forceinline__ void pv_tile(f32x16* o, const LAS unsigned char* vb, bf16x8 pa0, bf16x8 pa1, bf16x8 pa2, bf16x8 pa3) {
#pragma unroll
  for (int d0 = 0; d0 < 4; ++d0) {
    const s16x4 l0 = tr_read(vb + v_rd_off(d0, 0, 0)), h0 = tr_read(vb + v_rd_off(d0, 0, 1)), l1 = tr_read(vb + v_rd_off(d0, 1, 0)), h1 = tr_read(vb + v_rd_off(d0, 1, 1));
    const s16x4 l2 = tr_read(vb + v_rd_off(d0, 2, 0)), h2 = tr_read(vb + v_rd_off(d0, 2, 1)), l3 = tr_read(vb + v_rd_off(d0, 3, 0)), h3 = tr_read(vb + v_rd_off(d0, 3, 1));
    o[d0] = __builtin_amdgcn_mfma_f32_32x32x16_bf16(pa0, PKF(l0, h0), o[d0], 0, 0, 0);
    o[d0] = __builtin_amdgcn_mfma_f32_32x32x16_bf16(pa1, PKF(l1, h1), o[d0], 0, 0, 0);
    o[d0] = __builtin_amdgcn_mfma_f32_32x32x16_bf16(pa2, PKF(l2, h2), o[d0], 0, 0, 0);
    o[d0] = __builtin_amdgcn_mfma_f32_32x32x16_bf16(pa3, PKF(l3, h3), o[d0], 0, 0, 0);
  }
}
__device__ __forceinline__ void attn_unit(const bf16_t* __restrict__ Qb, const bf16_t* __restrict__ Kh, const bf16_t* __restrict__ Vh, bf16_t* __restrict__ Ob, int seq, LAS unsigned char* lds) {
  const int tid = tid_now(), wid = tid >> 6, lane = tid & 63, r32 = lane & 31, hi = lane >> 5;
  LAS float* al_l = (LAS float*)(lds + OFF_AUX) + wid * 64; LAS float* li_l = al_l + 32;
  f32x16 o[4] = {}; f32x16 minit = {}; float l_reg = 0.f; bf16x8 qr[4];
  const bf16_t* Qw = Qb + (long)(wid * QBLK + r32) * LD + hi * 8;
#pragma unroll
  for (int d0 = 0; d0 < 4; ++d0) qr[d0] = *reinterpret_cast<const bf16x8*>(Qw + d0 * 16);
  const int sr = tid >> 4, sc = (tid & 15) * 8, ksr = tid >> 3, ksc = (tid & 7) * 8;
  const int vst0 = OFF_VB0 + v_st(sr, sc), vst1 = OFF_VB0 + v_st(32 + sr, sc), kst = OFF_KB0 + KSWZ(ksr, ksc * 2);
  const LAS unsigned char* vrd = lds + OFF_VB0 + v_rd_base(lane);
  const int NT = seq / KVBLK;
  bf16x8 sv0, sv1, sk0;
#define SLOAD(j) do { const int kt_ = ((j) + 2 < NT ? (j) + 2 : NT - 1) * KVBLK; \
    sv0 = *reinterpret_cast<const bf16x8*>(&Vh[(long)((j) * KVBLK + sr) * LD + sc]); sv1 = *reinterpret_cast<const bf16x8*>(&Vh[(long)((j) * KVBLK + 32 + sr) * LD + sc]); \
    sk0 = *reinterpret_cast<const bf16x8*>(&Kh[(long)(kt_ + ksr) * LD + ksc]); } while (0)
#define SWRITE(par) do { *(LAS bf16x8*)(lds + (par) * SHM_V + vst0) = sv0; *(LAS bf16x8*)(lds + (par) * SHM_V + vst1) = sv1; *(LAS bf16x8*)(lds + (par) * SHM_K + kst) = sk0; } while (0)
#define RESC(a) do { if (__any((a) < 1.f)) { if (hi == 0) al_l[r32] = (a); asm volatile("s_waitcnt lgkmcnt(0)" ::: "memory"); \
    _Pragma("unroll") for (int r = 0; r < 16; ++r) { const float a_ = al_l[crow(r, hi)]; o[0][r] *= a_; o[1][r] *= a_; o[2][r] *= a_; o[3][r] *= a_; } } } while (0)
#define SCHED_ITER() do { __builtin_amdgcn_sched_group_barrier(0x100, 6, 0); \
    _Pragma("unroll") for (int i_ = 0; i_ < 16; ++i_) { __builtin_amdgcn_sched_group_barrier(0x008, 1, 0); __builtin_amdgcn_sched_group_barrier(0x100, 2, 0); \
      __builtin_amdgcn_sched_group_barrier(0x002, 7, 0); } \
    _Pragma("unroll") for (int i_ = 0; i_ < 8; ++i_) { __builtin_amdgcn_sched_group_barrier(0x008, 1, 0); __builtin_amdgcn_sched_group_barrier(0x100, 1, 0); __builtin_amdgcn_sched_group_barrier(0x002, 2, 0); } \
    __builtin_amdgcn_sched_group_barrier(0x200, 3, 0); __builtin_amdgcn_sched_group_barrier(0x020, 3, 0); } while (0)
  { const bf16x8 k0 = *reinterpret_cast<const bf16x8*>(&Kh[(long)ksr * LD + ksc]); const bf16x8 k1 = *reinterpret_cast<const bf16x8*>(&Kh[(long)(KVBLK + ksr) * LD + ksc]);
    *(LAS bf16x8*)(lds + kst) = k0; *(LAS bf16x8*)(lds + SHM_K + kst) = k1; }
  SLOAD(0);
  ABAR();
  f32x16 s0, s1; float alpha; bf16x8 xa0, xa1, xa2, xa3, ya0, ya1, ya2, ya3;
  qk_tile(s0, s1, lds + OFF_KB0, qr, minit, r32, hi);
  ABAR();
  sm_max<true>(s0, s1, minit, alpha);
  SBAR();
  sm_exp(s0, s1, alpha, l_reg, xa0, xa1, xa2, xa3);
  qk_tile(s0, s1, lds + OFF_KB0 + SHM_K, qr, minit, r32, hi);
  SWRITE(0); SLOAD(1);
  SBAR(); ABAR();
  alpha = 1.f;
  for (int j = 1; j + 1 < NT; j += 2) {
    RESC(alpha);
    sm_max<false>(s0, s1, minit, alpha);
    SBAR();
    pv_tile(o, vrd, xa0, xa1, xa2, xa3);
    sm_exp(s0, s1, alpha, l_reg, ya0, ya1, ya2, ya3);
    qk_tile(s0, s1, lds + OFF_KB0, qr, minit, r32, hi);
    SWRITE(1); SLOAD(j + 1);
    SCHED_ITER();
    SBAR(); ABAR();
    RESC(alpha);
    sm_max<false>(s0, s1, minit, alpha);
    SBAR();
    pv_tile(o, vrd + SHM_V, ya0, ya1, ya2, ya3);
    sm_exp(s0, s1, alpha, l_reg, xa0, xa1, xa2, xa3);
    qk_tile(s0, s1, lds + OFF_KB0 + SHM_K, qr, minit, r32, hi);
    SWRITE(0); if (j + 2 < NT) SLOAD(j + 2);
    SCHED_ITER();
    SBAR(); ABAR();
  }
  RESC(alpha);
  sm_max<false>(s0, s1, minit, alpha);
  SBAR();
  pv_tile(o, vrd, xa0, xa1, xa2, xa3);
  sm_exp(s0, s1, alpha, l_reg, ya0, ya1, ya2, ya3);
  SWRITE(1);
  SBAR(); ABAR();
  RESC(alpha);
  pv_tile(o, vrd + SHM_V, ya0, ya1, ya2, ya3);
  float rli[16];
  if (hi == 0) li_l[r32] = l_reg; asm volatile("s_waitcnt lgkmcnt(0)" ::: "memory");
#pragma unroll
  for (int r = 0; r < 16; ++r) rli[r] = __builtin_amdgcn_rcpf(li_l[crow(r, hi)]);
  bf16_t* Ow = Ob + (long)(wid * QBLK) * LDO;
#pragma unroll
  for (int r = 0; r < 16; ++r) { const int orow = crow(r, hi);
#pragma unroll
    for (int d0 = 0; d0 < 4; ++d0) Ow[(long)orow * LDO + d0 * 32 + r32] = (bf16_t)(cvtpk(o[d0][r] * rli[r], 0.f) & 0xffffu); }
  __syncthreads();
#undef SLOAD
#undef SWRITE
#undef RESC
#undef SCHED_ITER
}
}

constexpr int SCAN_ROWB = 272, SCAN_WAVE_LDS = 32 * SCAN_ROWB;
__device__ __forceinline__ void scan_seq(const unsigned char* wsb, int rowbase, int L, int g, int dir, char* ldsw, int lane) {
  const int j = lane & 31, hi = lane >> 5, l16 = lane & 15, q4 = lane >> 4;
  const float* LAMp = (const float*)(wsb + OFF_LAM) + ((size_t)(dir * 32 + g) * 64 + lane) * 2;
  const float lr = LAMp[0], li = LAMp[1];
  const bf16_t* BBp = (const bf16_t*)(wsb + OFF_BB) + (size_t)(dir * 32 + g) * 128 * 16;
  const bf16_t* CBp = (const bf16_t*)(wsb + OFF_CB) + (size_t)(dir * 32 + g) * 128 * 16;
  bf16x8 bb[4], cb[4];
#pragma unroll
  for (int nb = 0; nb < 4; ++nb) bb[nb] = *(const bf16x8*)(BBp + (nb * 32 + j) * 16 + 8 * hi);
#pragma unroll
  for (int kk = 0; kk < 4; ++kk) cb[kk] = *(const bf16x8*)(CBp + (kk * 16 + l16) * 32 + 8 * q4);
  const bf16_t* XS = (const bf16_t*)(wsb + OFF_XS) + (size_t)rowbase * 512 + g * 16;
  bf16_t* Y = (bf16_t*)(wsb + (dir ? OFF_YB : OFF_YF)) + (size_t)rowbase * 512 + g * 16;
  float hr = 0.f, him = 0.f;
  const int nch = L / 32;
  auto tok = [&](int c, int t) { const int p = c * 32 + t; return dir ? (L - 1 - p) : p; };
  bf16x8 a_next = *(const bf16x8*)(XS + (size_t)tok(0, j) * 512 + 8 * hi);
  for (int c = 0; c < nch; ++c) {
    const bf16x8 a = a_next;
    if (c + 1 < nch) a_next = *(const bf16x8*)(XS + (size_t)tok(c + 1, j) * 512 + 8 * hi);
    const f32x16 z = {};
    f32x16 d0 = __builtin_amdgcn_mfma_f32_32x32x16_bf16(a, bb[0], z, 0, 0, 0);
    f32x16 d1 = __builtin_amdgcn_mfma_f32_32x32x16_bf16(a, bb[1], z, 0, 0, 0);
    f32x16 d2 = __builtin_amdgcn_mfma_f32_32x32x16_bf16(a, bb[2], z, 0, 0, 0);
    f32x16 d3 = __builtin_amdgcn_mfma_f32_32x32x16_bf16(a, bb[3], z, 0, 0, 0);
#pragma unroll
    for (int a4 = 0; a4 < 4; ++a4) {
      float re[2][4], im[2][4];
#pragma unroll
      for (int i = 0; i < 4; ++i) { const int r = 4 * a4 + i;
        auto s0 = __builtin_amdgcn_permlane32_swap(__float_as_uint(d0[r]), __float_as_uint(d2[r]), false, false);
        auto s1 = __builtin_amdgcn_permlane32_swap(__float_as_uint(d1[r]), __float_as_uint(d3[r]), false, false);
        re[0][i] = __uint_as_float(s0[0]); re[1][i] = __uint_as_float(s0[1]); im[0][i] = __uint_as_float(s1[0]); im[1][i] = __uint_as_float(s1[1]); }
#pragma unroll
      for (int h = 0; h < 2; ++h)
#pragma unroll
        for (int i = 0; i < 4; ++i) { const int t = 8 * a4 + 4 * h + i;
          const float nr = fmaf(lr, hr, fmaf(-li, him, re[h][i])), ni = fmaf(lr, him, fmaf(li, hr, im[h][i]));
          hr = nr; him = ni;
          *(unsigned*)(ldsw + t * SCAN_ROWB + lane * 4) = cvtpk(hr, him); }
    }
    __builtin_amdgcn_wave_barrier();
#pragma unroll
    for (int tb = 0; tb < 2; ++tb) {
      f32x4 acc = {0.f, 0.f, 0.f, 0.f};
#pragma unroll
      for (int kk = 0; kk < 4; ++kk) { const bf16x8 hf = *(const bf16x8*)(ldsw + (tb * 16 + l16) * SCAN_ROWB + (kk * 32 + 8 * q4) * 2);
        acc = __builtin_amdgcn_mfma_f32_16x16x32_bf16(cb[kk], hf, acc, 0, 0, 0); }
      u32x2 w; w.x = cvtpk(acc[0], acc[1]); w.y = cvtpk(acc[2], acc[3]);
      *(u32x2*)(Y + (size_t)tok(c, tb * 16 + l16) * 512 + 4 * q4) = w;
    }
    __builtin_amdgcn_wave_barrier();
  }
}

__device__ __forceinline__ int win_drow(int n) {
  if (n < 1024 || n >= 2048) return n;
  const int c = n & 255, tb = n - c, gi = c >> 6, d = c & 63;
  return tb + (d >> 5) * 128 + gi * 32 + (d & 31);
}
__device__ __forceinline__ void transpose_job(const float* src, int ldn, int K, int k0, int n0, bf16_t* dst, const float* gscale, bool perm, float* tile) {
  const int tid = tid_now();
#pragma unroll
  for (int pss = 0; pss < 2; ++pss) { const int kr = (tid >> 4) + pss * 32, nc = (tid & 15) * 4;
    f32x4 v = *(const f32x4*)(src + (size_t)(k0 + kr) * ldn + n0 + nc);
    if (gscale) v = v * gscale[k0 + kr];
    tile[kr * 65 + nc] = v[0]; tile[kr * 65 + nc + 1] = v[1]; tile[kr * 65 + nc + 2] = v[2]; tile[kr * 65 + nc + 3] = v[3]; }
  __syncthreads();
  { const int nl = tid >> 3, kc = (tid & 7) * 8; f32x4 a, b;
#pragma unroll
    for (int i = 0; i < 4; ++i) { a[i] = tile[(kc + i) * 65 + nl]; b[i] = tile[(kc + 4 + i) * 65 + nl]; }
    const int n = n0 + nl, dr = perm ? win_drow(n) : n;
    *(u32x4*)(dst + (size_t)dr * K + k0 + kc) = pack8(a, b); }
  __syncthreads();
}

__global__ void __launch_bounds__(512, 2) fwd_mega(Params p) {
  extern __shared__ __attribute__((aligned(16))) unsigned char smem[];
  cg::grid_group grid = cg::this_grid();
  const int G = gridDim.x, bx = blockIdx.x;
#define tid tid_now()
#define lane (tid_now() & 63)
#define wid (tid_now() >> 6)
  unsigned char* ws = p.ws;
  bf16_t* gsga = (bf16_t*)p.out;
  const int lo = p.ph_lo, hi_ = p.ph_hi & 0xff, p2mode = (p.ph_hi >> 8) & 3;
#ifndef PHMASK
#define PHMASK 255
#endif
#define IN(k) (((PHMASK >> (k)) & 1) && lo <= (k) && (k) < hi_)
#ifdef DUMP
#undef IN
#define IN(k) (((k) == 8 || ((PHMASK >> (k)) & 1)) && lo <= (k) && (k) < hi_)
#endif
#ifndef DUPMASK
#define DUPMASK 0
#endif
#define NREP(k) (((DUPMASK >> (k)) & 1) ? 2 : 1)
#define SEAM(k) do { if (IN(k) && IN((k) + 1)) grid.sync(); } while (0)

  if (IN(0)) {
    for (int r = bx * 8 + wid; r < MT; r += G * 8) {
      const float* xr = r < MP ? p.x_p + (size_t)r * 1024 : p.x_s + (size_t)(r - MP) * 1024;
      bf16_t* xb = (bf16_t*)(ws + OFF_XB) + (size_t)r * 1024; float s = 0.f;
#pragma unroll
      for (int i = 0; i < 4; ++i) { const f32x4 v = *(const f32x4*)(xr + i * 256 + lane * 4); s += v[0] * v[0] + v[1] * v[1] + v[2] * v[2] + v[3] * v[3];
        u32x2 w; w.x = cvtpk(v[0], v[1]); w.y = cvtpk(v[2], v[3]); *(u32x2*)(xb + i * 256 + lane * 4) = w; }
#pragma unroll
      for (int o = 32; o > 0; o >>= 1) s += __shfl_xor(s, o);
      if (lane == 0) ((float*)(ws + OFF_RSTD))[r] = rsqrtf(s * (1.f / 1024.f) + 1e-6f);
    }
    for (int jb = bx; jb < 1856; jb += G) {
      float* tile = (float*)smem;
      if (jb < 1280) transpose_job(p.w_in, NIN, 1024, (jb / 80) * 64, (jb % 80) * 64, (bf16_t*)(ws + OFF_WIN), p.norm_g, true, tile);
      else if (jb < 1344) { const int q = jb - 1280; transpose_job(p.w_glu, 512, 512, (q / 8) * 64, (q % 8) * 64, (bf16_t*)(ws + OFF_WGLU), nullptr, false, tile); }
      else if (jb < 1600) { const int q = jb - 1344, i = q / 128, r = q % 128;
        transpose_job(p.w_branch + (size_t)i * 512 * 1024, 1024, 512, (r / 16) * 64, (r % 16) * 64, (bf16_t*)(ws + OFF_WBR) + (size_t)i * 1024 * 512, nullptr, false, tile); }
      else { const int q = jb - 1600; transpose_job(p.w_out, 1024, 1024, (q / 16) * 64, (q % 16) * 64, (bf16_t*)(ws + OFF_WOUT), nullptr, false, tile); }
    }
    const int gt = bx * 512 + tid, GT = G * 512;
    for (int i = gt; i < 8192 * 32; i += GT) { const int pos = i >> 5, k = i & 31;
      const float ex = (float)k * 2.0f / 64.0f; const float invf = (float)(1.0 / pow(10000.0, (double)ex));
      const float ang = (float)pos * invf; const double rev = (double)ang * 0.15915494309189535; const float fr2 = (float)(2.0 * (rev - floor(rev)));
      float* rt = (float*)(ws + OFF_ROT) + (size_t)pos * 64; rt[k] = cospif(fr2); rt[32 + k] = sinpif(fr2); }
    for (int i = gt; i < MT; i += GT) ((float*)(ws + OFF_SSQ))[i] = 0.f;
    if (gt < 4096) { const int dir = gt >> 11, g = (gt >> 6) & 31, s = gt & 63;
      const double dt = exp((double)p.log_dt[dir * 32 + g]);
      const double ar = (double)p.a_re[gt], ai = (double)p.a_im[gt];
      const double mag = exp(ar * dt); const double ph = ai * dt * 0.3183098861837907; const float ph2 = (float)(ph - 2.0 * floor(ph * 0.5));
      const double lr = mag * (double)cospif(ph2), li = mag * (double)sinpif(ph2);
      float* lm = (float*)(ws + OFF_LAM) + (size_t)gt * 2; lm[0] = (float)lr; lm[1] = (float)li;
      const double den = ar * ar + ai * ai, cr = ((lr - 1.0) * ar + li * ai) / den, ci = (li * ar - (lr - 1.0) * ai) / den;
      bf16_t* BBp = (bf16_t*)(ws + OFF_BB) + (size_t)(dir * 32 + g) * 128 * 16;
      const int nbr = (s >> 5) * 2, jj = s & 31;
      for (int c = 0; c < 16; ++c) { const double br = (double)p.b_re[(size_t)gt * 16 + c], bi = (double)p.b_im[(size_t)gt * 16 + c];
        BBp[((nbr) * 32 + jj) * 16 + c] = (bf16_t)(cvtpk((float)(cr * br - ci * bi), 0.f) & 0xffffu);
        BBp[((nbr + 1) * 32 + jj) * 16 + c] = (bf16_t)(cvtpk((float)(cr * bi + ci * br), 0.f) & 0xffffu); }
      bf16_t* CBp = (bf16_t*)(ws + OFF_CB) + (size_t)(dir * 32 + g) * 128 * 16;
      for (int c = 0; c < 16; ++c) { const float cre = p.c_re[((size_t)(dir * 32 + g) * 16 + c) * 64 + s], cim = p.c_im[((size_t)(dir * 32 + g) * 16 + c) * 64 + s];
        const int k = 2 * s, kk = k >> 5, kp = k & 31;
        *(unsigned*)(CBp + (kk * 16 + c) * 32 + kp) = cvtpk(cre, -cim); }
    }
    if (gt == 0) { float s1 = 0.f, s2 = 0.f; for (int i = 0; i < 64; ++i) { s1 += p.lq1[i] * p.lk1[i]; s2 += p.lq2[i] * p.lk2[i]; }
      ((float*)(ws + OFF_CTL))[8] = expf(s1) - expf(s2) + 0.2f; for (int i = 0; i < 64; ++i) if (i != 8) ((unsigned*)(ws + OFF_CTL))[i] = 0u; }
  }
  SEAM(0);

  if (IN(1)) for (int rep = 0; rep < NREP(1); ++rep) {
    pg8::Gemm g{(const bf16_t*)(ws + OFF_XB), (const bf16_t*)(ws + OFF_WIN), MT, NIN, 1024}; pg8::StaticOrder S; S.init(MT, NIN, G, bx);
    EpiIn E{ws, gsga, (const float*)(ws + OFF_RSTD), (const float*)(ws + OFF_ROT)};
    pg8::gemm_phase<EpiIn>((LAS unsigned char*)smem, g, S, E);
  }
  SEAM(1);

  if (IN(2)) for (int rep = 0; rep < NREP(2); ++rep) {
    const int xq = bx & 7;
    unsigned* ctr = (unsigned*)(ws + OFF_CTL) + 16 + rep * 8 + xq; volatile unsigned* bc = (volatile unsigned*)(smem + LDS_BYTES - 16);
    const bf16_t* QB = (const bf16_t*)(ws + OFF_QB); const bf16_t* KB = (const bf16_t*)(ws + OFF_KB); const bf16_t* VB = (const bf16_t*)(ws + OFF_VB); bf16_t* AO = (bf16_t*)(ws + OFF_AO);
    for (;;) {
      __syncthreads();
      if (tid == 0) *bc = atomicAdd(ctr, 1u);
      __syncthreads();
      const int it = (int)*bc;
      if (it >= 336) break;
      const bool is_scan = it < 8 || (it >= 264 && it < 272);
      if ((p2mode == 1 && !is_scan) || (p2mode == 2 && is_scan)) continue;
      if (is_scan) {
        const bool lng = it < 8; const int s = (xq * 8 + (lng ? it : it - 264)) * 8 + wid;
        const int b = s >> 6, g = (s >> 1) & 31, dir = s & 1;
        scan_seq(ws, lng ? MP + b * 8192 : b * 2048, lng ? 8192 : 2048, g, dir, (char*)smem + wid * SCAN_WAVE_LDS, lane);
      } else {
        const bool lng = it < 264; const int u = lng ? it - 8 : it - 272;
        const int nqb = lng ? 32 : 8, L = lng ? 8192 : 2048;
        const int qb = u % nqb, vh = u / nqb, b = xq;
        const size_t rb = lng ? (size_t)MP + (size_t)b * 8192 : (size_t)b * 2048;
        att::attn_unit(QB + (rb + qb * 256) * 512 + vh * 64, KB + rb * 512 + vh * 64, VB + rb * 512 + (vh >> 1) * 128, AO + (rb + qb * 256) * 1024 + vh * 128, L, (LAS unsigned char*)smem);
      }
    }
  }
  SEAM(2);

  if (IN(3)) for (int rep = 0; rep < NREP(3); ++rep) {
    const float lam = ((const float*)(ws + OFF_CTL))[8];
    const bf16_t* YF = (const bf16_t*)(ws + OFF_YF); const bf16_t* YB = (const bf16_t*)(ws + OFF_YB); const bf16_t* XS = (const bf16_t*)(ws + OFF_XS);
    const bf16_t* AO = (const bf16_t*)(ws + OFF_AO); const bf16_t* ZA = (const bf16_t*)(ws + OFF_ZA);
    bf16_t* YSG = (bf16_t*)(ws + OFF_YSG); bf16_t* YAN = (bf16_t*)(ws + OFF_YAN);
    const int c0 = lane * 8; const f32x4 dk0 = *(const f32x4*)(p.ssm_d + c0), dk1 = *(const f32x4*)(p.ssm_d + c0 + 4);
    const int h = lane >> 4, e0 = (lane & 15) * 8; const f32x4 sg0 = *(const f32x4*)(p.subln_g + e0) * 0.8f, sg1 = *(const f32x4*)(p.subln_g + e0 + 4) * 0.8f;
    for (int r = bx * 8 + wid; r < MT; r += G * 8) {
      f32x4 f0, f1, b0, b1, x0, x1;
      unpack8(*(const u32x4*)(YF + (size_t)r * 512 + c0), f0, f1); unpack8(*(const u32x4*)(YB + (size_t)r * 512 + c0), b0, b1); unpack8(*(const u32x4*)(XS + (size_t)r * 512 + c0), x0, x1);
      f32x4 v0 = f0 + b0 + dk0 * x0, v1 = f1 + b1 + dk1 * x1;
#pragma unroll
      for (int i = 0; i < 4; ++i) { v0[i] = gelu_tanh(v0[i]); v1[i] = gelu_tanh(v1[i]); }
      f32x4 p0, p1, q0, q1, z0, z1;
      unpack8(*(const u32x4*)(AO + (size_t)r * 1024 + (2 * h) * 128 + e0), p0, p1); unpack8(*(const u32x4*)(AO + (size_t)r * 1024 + (2 * h + 1) * 128 + e0), q0, q1);
      unpack8(*(const u32x4*)(ZA + (size_t)r * 512 + h * 128 + e0), z0, z1);
      *(u32x4*)(YSG + (size_t)r * 512 + c0) = pack8(v0, v1);
      f32x4 o0 = p0 - lam * q0, o1 = p1 - lam * q1;
      float ss = 0.f;
#pragma unroll
      for (int i = 0; i < 4; ++i) ss += o0[i] * o0[i] + o1[i] * o1[i];
      ss += __shfl_xor(ss, 1); ss += __shfl_xor(ss, 2); ss += __shfl_xor(ss, 4); ss += __shfl_xor(ss, 8);
      const float rn = rsqrtf(ss * (1.f / 128.f) + 1e-5f);
      o0 = o0 * rn * sg0 * z0; o1 = o1 * rn * sg1 * z1;
      *(u32x4*)(YAN + (size_t)r * 512 + h * 128 + e0) = pack8(o0, o1);
    }
  }
  SEAM(3);

  if (IN(4)) for (int rep = 0; rep < NREP(4); ++rep) {
    pg8::Gemm g{(const bf16_t*)(ws + OFF_YSG), (const bf16_t*)(ws + OFF_WGLU), MT, 512, 512}; pg8::StaticOrder S; S.init(MT, 512, G, bx);
    EpiGlu E{(const bf16_t*)(ws + OFF_YSG), (const bf16_t*)(ws + OFF_ZS), p.b_glu, (bf16_t*)(ws + OFF_YS2)};
    pg8::gemm_phase<EpiGlu>((LAS unsigned char*)smem, g, S, E);
  }
  SEAM(4);

  if (IN(5)) for (int rep = 0; rep < NREP(5); ++rep) {
    pg8::StaticOrder S; S.init(MT, 1024, G, bx);
    { pg8::Gemm g{(const bf16_t*)(ws + OFF_YS2), (const bf16_t*)(ws + OFF_WBR), MT, 1024, 512};
      EpiBr<0> E{gsga, (bf16_t*)(ws + OFF_PS), nullptr}; pg8::gemm_phase<EpiBr<0>>((LAS unsigned char*)smem, g, S, E); }
    __syncthreads();
    { pg8::Gemm g{(const bf16_t*)(ws + OFF_YAN), (const bf16_t*)(ws + OFF_WBR) + (size_t)1024 * 512, MT, 1024, 512};
      EpiBr<1> E{gsga + (size_t)MT * 1024, (bf16_t*)(ws + OFF_PS), (bf16_t*)(ws + OFF_MG)}; pg8::gemm_phase<EpiBr<1>>((LAS unsigned char*)smem, g, S, E); }
  }
  SEAM(5);

  if (IN(6)) {
    pg8::Gemm g{(const bf16_t*)(ws + OFF_MG), (const bf16_t*)(ws + OFF_WOUT), MT, 1024, 1024}; pg8::StaticOrder S; S.init(MT, 1024, G, bx);
    EpiOut E{p.x_p, p.x_s, p.out, (float*)(ws + OFF_SSQ)};
    pg8::gemm_phase<EpiOut>((LAS unsigned char*)smem, g, S, E);
  }
  SEAM(6);

  if (IN(7)) {
    const float* ssq = (const float*)(ws + OFF_SSQ);
    f32x4 fg[4];
#pragma unroll
    for (int i = 0; i < 4; ++i) fg[i] = *(const f32x4*)(p.final_g + i * 256 + lane * 4);
    for (int r = bx * 8 + wid; r < MT; r += G * 8) {
      const float rn = rsqrtf(ssq[r] * (1.f / 1024.f) + 1e-6f); float* orow = p.out + (size_t)r * 1024;
#pragma unroll
      for (int i = 0; i < 4; ++i) { f32x4 v = *(f32x4*)(orow + i * 256 + lane * 4); *(f32x4*)(orow + i * 256 + lane * 4) = v * rn * fg[i]; }
    }
  }

#ifdef DUMP
  if (IN(8)) {
    for (int r = bx * 8 + wid; r < MT; r += G * 8) {
      float* orow = p.out + (size_t)r * 1024;
      for (int c = lane; c < 512; c += 64) {
        float a = 0.f, b = 0.f; const size_t i5 = (size_t)r * 512 + c, i1 = (size_t)r * 1024 + c;
#define BF(off, idx) bflo((unsigned)((const bf16_t*)(ws + (off)))[idx])
        if (DUMP == 1) { a = BF(OFF_XS, i5) + BF(OFF_ZS, i5) + BF(OFF_VB, i5); b = BF(OFF_QB, i5) + BF(OFF_KB, i5) + BF(OFF_ZA, i5); }
        if (DUMP == 2) { a = BF(OFF_YF, i5) + BF(OFF_YB, i5); b = BF(OFF_AO, i1) + BF(OFF_AO, i1 + 512); }
        if (DUMP == 3) { a = BF(OFF_YSG, i5) + BF(OFF_YAN, i5) + BF(OFF_YS2, i5); b = BF(OFF_MG, i1) + BF(OFF_MG, i1 + 512); }
        if (DUMP == 4) { a = BF(OFF_YF, i5); b = BF(OFF_YB, i5); }
        if (DUMP == 5) { a = BF(OFF_AO, i1); b = BF(OFF_AO, i1 + 512); }
#undef BF
        orow[c] = a; orow[512 + c] = b;
      }
    }
  }
#endif
#undef IN
#undef SEAM
#undef tid
#undef lane
#undef wid
}

#ifndef N_LAUNCH_PER_PHASE
#define N_LAUNCH_PER_PHASE 0
#endif
extern "C" void kernel_launch(void* const* d_in, const int* in_sizes, int n_in, void* d_out, int out_size, void* d_ws, size_t ws_size, hipStream_t stream) {
  static int grid = 0;
  if (grid == 0) {
    if (n_in != 22 || out_size != MT * 1024 || ws_size < WS_END) { fprintf(stderr, "kernel_launch: unexpected shapes n_in %d out %d ws %zu (need %zu)\n", n_in, out_size, ws_size, (size_t)WS_END); grid = -1; return; }
    int dev = 0, cus = 0, per_cu = 0;
    hipGetDevice(&dev); hipDeviceGetAttribute(&cus, hipDeviceAttributeMultiprocessorCount, dev);
    if (hipFuncSetAttribute((const void*)fwd_mega, hipFuncAttributeMaxDynamicSharedMemorySize, LDS_BYTES) != hipSuccess) { fprintf(stderr, "kernel_launch: hipFuncSetAttribute failed\n"); grid = -1; return; }
    if (hipOccupancyMaxActiveBlocksPerMultiprocessor(&per_cu, (const void*)fwd_mega, 512, LDS_BYTES) != hipSuccess || per_cu < 1) { fprintf(stderr, "kernel_launch: occupancy query says %d\n", per_cu); per_cu = 1; }
    (void)hipGetLastError();
    grid = cus * 1;
  }
  if (grid < 0) return;
  Params p{};
  p.x_p = (const float*)d_in[0]; p.x_s = (const float*)d_in[1]; p.norm_g = (const float*)d_in[2]; p.w_in = (const float*)d_in[3];
  p.a_re = (const float*)d_in[4]; p.a_im = (const float*)d_in[5]; p.log_dt = (const float*)d_in[6]; p.b_re = (const float*)d_in[7]; p.b_im = (const float*)d_in[8];
  p.c_re = (const float*)d_in[9]; p.c_im = (const float*)d_in[10]; p.ssm_d = (const float*)d_in[11]; p.w_glu = (const float*)d_in[12]; p.b_glu = (const float*)d_in[13];
  p.lq1 = (const float*)d_in[14]; p.lk1 = (const float*)d_in[15]; p.lq2 = (const float*)d_in[16]; p.lk2 = (const float*)d_in[17]; p.subln_g = (const float*)d_in[18];
  p.w_branch = (const float*)d_in[19]; p.w_out = (const float*)d_in[20]; p.final_g = (const float*)d_in[21];
  p.out = (float*)d_out; p.ws = (unsigned char*)d_ws;
#if N_LAUNCH_PER_PHASE
  #ifdef DUMP
  const int nph = 9;
#else
  const int nph = 8;
#endif
  for (int ph = 0; ph < nph; ++ph) { p.ph_lo = ph; p.ph_hi = ph + 1; hipLaunchKernelGGL(fwd_mega, dim3(grid), dim3(512), LDS_BYTES, stream, p); }
#else
#ifdef PREFIX_HI
#ifndef P2MODE
#define P2MODE 0
#endif
  for (int ph = 0; ph < PREFIX_HI; ++ph) { p.ph_lo = ph; p.ph_hi = (ph + 1) | (ph == 2 ? (P2MODE << 8) : 0); hipLaunchKernelGGL(fwd_mega, dim3(grid), dim3(512), LDS_BYTES, stream, p); }
#endif
  p.ph_lo = 0; p.ph_hi = 8;
  void* args[] = {&p};
  hipError_t e = hipLaunchCooperativeKernel((const void*)fwd_mega, dim3(grid), dim3(512), args, LDS_BYTES, stream);
  if (e != hipSuccess) fprintf(stderr, "cooperative launch failed: %s (grid %d)\n", hipGetErrorString(e), grid);
#endif
}
```

```cpp
#include <hip/hip_runtime.h>
#include <hip/hip_cooperative_groups.h>
#include <cstdio>
#include <cstdint>
namespace cg = cooperative_groups;

#define LAS __attribute__((address_space(3)))
typedef unsigned short bf16_t;
typedef short bf16x8 __attribute__((ext_vector_type(8)));
typedef short s16x4 __attribute__((ext_vector_type(4)));
typedef float f32x4 __attribute__((ext_vector_type(4)));
typedef float f32x16 __attribute__((ext_vector_type(16)));
typedef unsigned u32x4 __attribute__((ext_vector_type(4)));
typedef unsigned u32x2 __attribute__((ext_vector_type(2)));

constexpr int DM = 1024, NIN = 5120, MP = 8 * 2048, MS = 8 * 8192, MT = MP + MS;
constexpr size_t UB = (size_t)MT * 512 * 2;
constexpr size_t OFF_XB = 0;
constexpr size_t OFF_XS = 2 * UB, OFF_ZS = 3 * UB, OFF_QB = 4 * UB, OFF_KB = 5 * UB, OFF_VB = 6 * UB, OFF_ZA = 7 * UB;
constexpr size_t OFF_YF = 8 * UB, OFF_YB = 9 * UB;
constexpr size_t OFF_YSG = OFF_VB, OFF_YCAT = OFF_QB, OFF_AO = OFF_XB, OFF_MG = OFF_YF;
constexpr size_t OFF_WIN = 10 * UB;
constexpr size_t OFF_WGLU = OFF_WIN + (size_t)NIN * DM * 2;
constexpr size_t OFF_WBR = OFF_WGLU + 512 * 512 * 2;
constexpr size_t OFF_WOUT = OFF_WBR + 2 * 1024 * 512 * 2;
constexpr size_t OFF_RSTD = OFF_WOUT + 1024 * 1024 * 2;
constexpr size_t OFF_SSQ = OFF_RSTD + (size_t)MT * 4;
constexpr size_t OFF_ROT = OFF_SSQ + (size_t)MT * 4;
constexpr size_t OFF_LAM = OFF_ROT + 8192 * 64 * 4;
constexpr size_t OFF_BB = OFF_LAM + 2 * 32 * 64 * 2 * 4;
constexpr size_t OFF_CB = OFF_BB + 2 * 32 * 128 * 16 * 2;
constexpr size_t OFF_CTL = OFF_CB + 2 * 32 * 128 * 16 * 2;
constexpr size_t WS_END = OFF_CTL + 256;
constexpr int LDS_BYTES = 131072;

struct Params {
  const float* x_p; const float* x_s; const float* norm_g; const float* w_in;
  const float* a_re; const float* a_im; const float* log_dt; const float* b_re; const float* b_im;
  const float* c_re; const float* c_im; const float* ssm_d; const float* w_glu; const float* b_glu;
  const float* lq1; const float* lk1; const float* lq2; const float* lk2; const float* subln_g;
  const float* w_branch; const float* w_out; const float* final_g;
  float* out; unsigned char* ws; int ph_lo, ph_hi;
};

typedef __bf16 bf16x2_t __attribute__((ext_vector_type(2)));
typedef float f32x2_t __attribute__((ext_vector_type(2)));
__device__ __forceinline__ unsigned cvtpk(float lo, float hi) { f32x2_t v = {lo, hi}; bf16x2_t b = __builtin_convertvector(v, bf16x2_t); return *reinterpret_cast<unsigned*>(&b); }
__device__ __forceinline__ float bflo(unsigned w) { return __uint_as_float(w << 16); }
__device__ __forceinline__ float bfhi(unsigned w) { return __uint_as_float(w & 0xffff0000u); }
__device__ __forceinline__ float sigmoidf_(float x) { return __builtin_amdgcn_rcpf(1.f + __builtin_amdgcn_exp2f(-1.4426950408889634f * x)); }
__device__ __forceinline__ float siluf_(float x) { return x * sigmoidf_(x); }
__device__ __forceinline__ float gelu_tanh(float x) { const float u = x + 0.044715f * x * x * x; return x * sigmoidf_(1.5957691216057308f * u); }
__device__ __forceinline__ u32x4 pack8(f32x4 a, f32x4 b) { u32x4 w; w.x = cvtpk(a[0], a[1]); w.y = cvtpk(a[2], a[3]); w.z = cvtpk(b[0], b[1]); w.w = cvtpk(b[2], b[3]); return w; }
__device__ __forceinline__ void unpack8(u32x4 w, f32x4& a, f32x4& b) { a = (f32x4){bflo(w.x), bfhi(w.x), bflo(w.y), bfhi(w.y)}; b = (f32x4){bflo(w.z), bfhi(w.z), bflo(w.w), bfhi(w.w)}; }
__device__ __forceinline__ int tid_now() { const int w = __builtin_amdgcn_readfirstlane((int)threadIdx.x >> 6); return w * 64 + (int)__builtin_amdgcn_mbcnt_hi(~0u, __builtin_amdgcn_mbcnt_lo(~0u, 0u)); }
__device__ __forceinline__ int row_pos(int r) { return r < MP ? (r & 2047) : (r & 8191); }

namespace pg8 {
constexpr int BM = 256, BK = 64, HALF = 128, HTB = HALF * BK * 2, STAGE_BYTES = 8 * HTB, NXCD = 8, WGM = 8;
__host__ __device__ __forceinline__ int lds_byte(int r, int c) { const int st = (r >> 4) * 2 + (c >> 5), rr = r & 15, cc = c & 31, ob = rr * 64 + cc * 2; return st * 1024 + (ob ^ (((ob >> 9) & 1) << 5)); }
__host__ __device__ __forceinline__ void stage_rc(int b, int& R, int& C) { const int st = b / 1024, sb = b % 1024, swz = sb ^ (((sb >> 9) & 1) << 5); R = (st >> 1) * 16 + swz / 64; C = (st & 1) * 32 + (swz % 64) / 2; }
__host__ __device__ __forceinline__ int perm32(int rho) { const int n = rho >> 4, i = rho & 15; return 8 * (i >> 2) + 4 * n + (i & 3); }
struct Unit { int pm, pn; };
struct Gemm { const bf16_t* A; const bf16_t* Bt; int M, N, K; };
struct StaticOrder {
  int nM, nN, nwg, G, c;
  __device__ void init(int M, int N, int G_, int c_) { nM = M / BM; nN = N / BM; nwg = nM * nN; G = G_; c = c_; }
  __device__ bool next(int i, Unit& u) const {
    const long L = (long)i * G + c; if (L >= nwg) return false;
    int wgid = (int)L; { const int q = nwg / NXCD, r = nwg % NXCD, xcd = wgid % NXCD, off = wgid / NXCD; wgid = (xcd < r ? xcd * (q + 1) : r * (q + 1) + (xcd - r) * q) + off; }
    const int nig = WGM * nN, gid = wgid / nig, fm = gid * WGM, gsz = (nM - fm) < WGM ? (nM - fm) : WGM;
    u.pm = fm + ((wgid % nig) % gsz); u.pn = (wgid % nig) / gsz; return true;
  }
};
template <class Epi>
__device__ __forceinline__ void gemm_phase(LAS unsigned char* lds, const Gemm g, const StaticOrder& S, const Epi& E) {
  const int tid = tid_now(), wid = __builtin_amdgcn_readfirstlane(tid >> 6), lane = tid & 63, wr = wid >> 2, wc = wid & 3, fr = lane & 15, fq = lane >> 4;
  const int K = g.K, nt = K / BK;
  unsigned voffA[2], voffB[2];
#pragma unroll
  for (int i = 0; i < 2; ++i) { int R, C; stage_rc(tid * 16 + i * 8192, R, C); const int Rb = Epi::PERM ? ((R & ~31) + perm32(R & 31)) : R;
    voffA[i] = (unsigned)(R * K + C) * 2u; voffB[i] = (unsigned)(Rb * K + C) * 2u; }
  const size_t kstep = (size_t)(BK * 2), hstep = (size_t)HALF * K * 2, tstep = 2 * hstep;
  const unsigned ldsw = (unsigned)wid * 1024u;
  const int aoff = lds_byte(wr * 64 + fr, fq * 8), boff = lds_byte(wc * 32 + fr, fq * 8);
#define PG8_SA(b, h) (((b) * 2 + (h)) * HTB)
#define PG8_SB(b, h) ((4 + (b) * 2 + (h)) * HTB)
#define PG8_STAGE(bufoff, gbase, voff) do { _Pragma("unroll") for (int _i = 0; _i < 2; ++_i) \
    __builtin_amdgcn_global_load_lds((const unsigned*)((const char*)(gbase) + (voff)[_i]), (LAS unsigned*)(lds + (bufoff) + ldsw + _i * 8192), 16, 0, 0); } while (0)
#define PG8_LDA(dst, b, h) do { _Pragma("unroll") for (int m = 0; m < 4; ++m) _Pragma("unroll") for (int k = 0; k < 2; ++k) dst[m][k] = *(const LAS bf16x8*)(lds + PG8_SA(b, h) + aoff + m * 2048 + k * 1024); } while (0)
#define PG8_LDB(dst, b, h) do { _Pragma("unroll") for (int n = 0; n < 2; ++n) _Pragma("unroll") for (int k = 0; k < 2; ++k) dst[n][k] = *(const LAS bf16x8*)(lds + PG8_SB(b, h) + boff + n * 2048 + k * 1024); } while (0)
#define PG8_MMA(ai, bj, At, Bt) do { __builtin_amdgcn_s_setprio(1); _Pragma("unroll") for (int m = 0; m < 4; ++m) _Pragma("unroll") for (int n = 0; n < 2; ++n) _Pragma("unroll") for (int k = 0; k < 2; ++k) \
    acc[ai][bj][m][n] = __builtin_amdgcn_mfma_f32_16x16x32_bf16(Bt[n][k], At[m][k], acc[ai][bj][m][n], 0, 0, 0); __builtin_amdgcn_s_setprio(0); } while (0)
#define PG8_WAIT_V(n) asm volatile("s_waitcnt vmcnt(" #n ")" ::: "memory")
#define PG8_WAIT_L(n) asm volatile("s_waitcnt lgkmcnt(" #n ")" ::: "memory")
#define PG8_BAR __builtin_amdgcn_s_barrier()
#define PG8_SCHED __builtin_amdgcn_sched_barrier(0)
  Unit cur, nxt; int ui = 0;
  if (!S.next(0, cur)) return;
  f32x4 acc[2][2][4][2];
#pragma unroll
  for (int a = 0; a < 2; ++a)
#pragma unroll
    for (int b = 0; b < 2; ++b)
#pragma unroll
      for (int m = 0; m < 4; ++m)
#pragma unroll
        for (int n = 0; n < 2; ++n) acc[a][b][m][n] = (f32x4){0.f, 0.f, 0.f, 0.f};
  bf16x8 At[4][2], B0[2][2], B1[2][2];
  const char* cA = (const char*)g.A + (size_t)cur.pm * tstep; const char* cB = (const char*)g.Bt + (size_t)cur.pn * tstep;
  PG8_STAGE(PG8_SB(0, 0), cB, voffB); PG8_STAGE(PG8_SA(0, 0), cA, voffA); PG8_STAGE(PG8_SB(0, 1), cB + hstep, voffB); PG8_STAGE(PG8_SA(0, 1), cA + hstep, voffA);
  if (wr == 1) PG8_BAR;
  PG8_WAIT_V(4); PG8_BAR;
  PG8_STAGE(PG8_SB(1, 0), cB + kstep, voffB); PG8_STAGE(PG8_SA(1, 0), cA + kstep, voffA); PG8_STAGE(PG8_SB(1, 1), cB + hstep + kstep, voffB);
  PG8_WAIT_V(6); PG8_BAR;
  for (;;) {
    const bool has_next = S.next(ui + 1, nxt);
    const char* nA = has_next ? (const char*)g.A + (size_t)nxt.pm * tstep : cA; const char* nB = has_next ? (const char*)g.Bt + (size_t)nxt.pn * tstep : cB;
    for (int t = 0; t < nt; t += 2) {
      const bool last = (t == nt - 2);
      if constexpr (Epi::HAS_MID) { if (t == nt / 2) E.mid(acc, cur, wr, wc, fr, fq); }
      const char* a1 = cA + (size_t)(t + 1) * kstep;
      const char* a2 = last ? nA : cA + (size_t)(t + 2) * kstep; const char* b2 = last ? nB : cB + (size_t)(t + 2) * kstep;
      const char* a3 = a2 + kstep; const char* b3 = b2 + kstep;
      PG8_LDB(B0, 0, 0); PG8_SCHED; PG8_LDA(At, 0, 0); PG8_STAGE(PG8_SA(1, 1), a1 + hstep, voffA);
      PG8_WAIT_L(8); PG8_BAR; PG8_WAIT_L(0); PG8_MMA(0, 0, At, B0); PG8_BAR; PG8_SCHED;
      PG8_LDB(B1, 0, 1); PG8_STAGE(PG8_SB(0, 0), b2, voffB);
      PG8_BAR; PG8_WAIT_L(0); PG8_MMA(0, 1, At, B1); PG8_BAR;
      PG8_LDA(At, 0, 1); PG8_STAGE(PG8_SA(0, 0), a2, voffA);
      PG8_BAR; PG8_WAIT_L(0); PG8_MMA(1, 0, At, B0); PG8_BAR; PG8_SCHED;
      PG8_STAGE(PG8_SB(0, 1), b2 + hstep, voffB);
      PG8_WAIT_V(6); PG8_BAR; PG8_MMA(1, 1, At, B1); PG8_BAR;
      PG8_LDB(B0, 1, 0); PG8_SCHED; PG8_LDA(At, 1, 0); PG8_STAGE(PG8_SA(0, 1), a2 + hstep, voffA);
      PG8_WAIT_L(8); PG8_BAR; PG8_WAIT_L(0); PG8_MMA(0, 0, At, B0); PG8_BAR; PG8_SCHED;
      PG8_LDB(B1, 1, 1); PG8_STAGE(PG8_SB(1, 0), b3, voffB);
      PG8_BAR; PG8_WAIT_L(0); PG8_MMA(0, 1, At, B1); PG8_BAR;
      PG8_LDA(At, 1, 1); PG8_STAGE(PG8_SA(1, 0), a3, voffA);
      PG8_BAR; PG8_WAIT_L(0); PG8_MMA(1, 0, At, B0); PG8_BAR; PG8_SCHED;
      PG8_STAGE(PG8_SB(1, 1), b3 + hstep, voffB);
      PG8_WAIT_V(6); PG8_BAR; PG8_MMA(1, 1, At, B1); PG8_BAR;
    }
    E(acc, cur, wr, wc, fr, fq);
    if (!has_next) break;
#pragma unroll
    for (int a = 0; a < 2; ++a)
#pragma unroll
      for (int b = 0; b < 2; ++b)
#pragma unroll
        for (int m = 0; m < 4; ++m)
#pragma unroll
          for (int n = 0; n < 2; ++n) acc[a][b][m][n] = (f32x4){0.f, 0.f, 0.f, 0.f};
    cur = nxt; cA = nA; cB = nB; ++ui;
  }
  PG8_WAIT_V(0);
  if (wr == 0) PG8_BAR;
  PG8_BAR;
#undef PG8_SA
#undef PG8_SB
#undef PG8_STAGE
#undef PG8_LDA
#undef PG8_LDB
#undef PG8_MMA
#undef PG8_WAIT_V
#undef PG8_WAIT_L
#undef PG8_BAR
#undef PG8_SCHED
}
}

struct EpiIn {
  static constexpr bool PERM = true, HAS_MID = false;
  unsigned char* ws; bf16_t* gsga; const float* rstd; const float* rot;
  __device__ __forceinline__ void operator()(const f32x4 (&acc)[2][2][4][2], const pg8::Unit& u, int wr, int wc, int fr, int fq) const {
    const int pn = u.pn, row0 = u.pm * 256 + wr * 64 + fr, col0 = wc * 32 + 8 * fq;
    if (pn >= 4 && pn < 8) {
      bf16_t* base = (bf16_t*)(ws + (pn < 6 ? OFF_QB : OFF_KB));
      const int lc = ((pn & 1) * 4 + wc) * 64 + 8 * fq;
#pragma unroll
      for (int ai = 0; ai < 2; ++ai)
#pragma unroll
        for (int m = 0; m < 4; ++m) {
          const int r = row0 + ai * 128 + m * 16; const float rs = rstd[r];
          const float* rp = rot + (size_t)row_pos(r) * 64 + 8 * fq;
          const f32x4 c0 = *(const f32x4*)(rp), c1 = *(const f32x4*)(rp + 4), s0 = *(const f32x4*)(rp + 32), s1 = *(const f32x4*)(rp + 36);
          const float rq = pn < 6 ? rs * 0.18033688011112042f : rs;
          const f32x4 a0 = acc[ai][0][m][0] * rq, a1 = acc[ai][0][m][1] * rq, b0 = acc[ai][1][m][0] * rq, b1 = acc[ai][1][m][1] * rq;
          const f32x4 o10 = a0 * c0 - b0 * s0, o11 = a1 * c1 - b1 * s1, o20 = b0 * c0 + a0 * s0, o21 = b1 * c1 + a1 * s1;
          bf16_t* rowp = base + (size_t)r * 512 + lc;
          *(u32x4*)(rowp) = pack8(o10, o11); *(u32x4*)(rowp + 32) = pack8(o20, o21);
        }
    } else {
      bf16_t* base; int ldc, colt, act;
      if (pn < 2) { base = (bf16_t*)(ws + OFF_XS); ldc = 512; colt = pn * 256; act = 0; }
      else if (pn < 4) { base = (bf16_t*)(ws + OFF_ZS); ldc = 512; colt = (pn - 2) * 256; act = 1; }
      else if (pn < 10) { base = (bf16_t*)(ws + OFF_VB); ldc = 512; colt = (pn - 8) * 256; act = 0; }
      else if (pn < 12) { base = (bf16_t*)(ws + OFF_ZA); ldc = 512; colt = (pn - 10) * 256; act = 1; }
      else if (pn < 16) { base = gsga; ldc = 1024; colt = (pn - 12) * 256; act = 2; }
      else { base = gsga + (size_t)MT * 1024; ldc = 1024; colt = (pn - 16) * 256; act = 2; }
#pragma unroll
      for (int ai = 0; ai < 2; ++ai)
#pragma unroll
        for (int m = 0; m < 4; ++m) {
          const int r = row0 + ai * 128 + m * 16; const float rs = rstd[r];
          bf16_t* rowp = base + (size_t)r * ldc + colt + col0;
#pragma unroll
          for (int bj = 0; bj < 2; ++bj) {
            f32x4 v0 = acc[ai][bj][m][0] * rs, v1 = acc[ai][bj][m][1] * rs;
            if (act == 1) {
#pragma unroll
              for (int j = 0; j < 4; ++j) { v0[j] = siluf_(v0[j]); v1[j] = siluf_(v1[j]); } }
            else if (act == 2) {
#pragma unroll
              for (int j = 0; j < 4; ++j) { v0[j] = sigmoidf_(v0[j]); v1[j] = sigmoidf_(v1[j]); } }
            *(u32x4*)(rowp + bj * 128) = pack8(v0, v1);
          }
        }
    }
  }
};
struct EpiGlu {
  static constexpr bool PERM = true, HAS_MID = false;
  const bf16_t* ysg; const bf16_t* zs; const float* bias; bf16_t* out;
  __device__ __forceinline__ void operator()(const f32x4 (&acc)[2][2][4][2], const pg8::Unit& u, int wr, int wc, int fr, int fq) const {
    const int row0 = u.pm * 256 + wr * 64 + fr, col0 = u.pn * 256 + wc * 32 + 8 * fq;
#pragma unroll
    for (int ai = 0; ai < 2; ++ai)
#pragma unroll
      for (int m = 0; m < 4; ++m) {
        const size_t ro = (size_t)(row0 + ai * 128 + m * 16) * 512 + col0;
#pragma unroll
        for (int bj = 0; bj < 2; ++bj) {
          const f32x4 bb0 = *(const f32x4*)(bias + col0 + bj * 128), bb1 = *(const f32x4*)(bias + col0 + bj * 128 + 4);
          f32x4 y0, y1, z0, z1; unpack8(*(const u32x4*)(ysg + ro + bj * 128), y0, y1); unpack8(*(const u32x4*)(zs + ro + bj * 128), z0, z1);
          f32x4 v0 = acc[ai][bj][m][0] + bb0, v1 = acc[ai][bj][m][1] + bb1;
#pragma unroll
          for (int j = 0; j < 4; ++j) { v0[j] = y0[j] * sigmoidf_(v0[j]) * z0[j]; v1[j] = y1[j] * sigmoidf_(v1[j]) * z1[j]; }
          *(u32x4*)(out + ro * 2 - col0 + bj * 128) = pack8(v0, v1);
        }
      }
  }
};
struct EpiBrF {
  static constexpr bool PERM = true, HAS_MID = true;
  const bf16_t* gs; const bf16_t* ga; bf16_t* out;
  __device__ __forceinline__ void mid(f32x4 (&acc)[2][2][4][2], const pg8::Unit& u, int wr, int wc, int fr, int fq) const {
    int row0 = u.pm * 256 + wr * 64 + fr, col0 = u.pn * 256 + wc * 32 + 8 * fq;
    asm volatile("" : "+v"(row0), "+v"(col0));
    u32x4 bs[2][2], ba[2][2];
#define MIDLOAD(q, gi) do { const size_t ro_ = (size_t)(row0 + ((gi) >> 2) * 128 + ((gi) & 3) * 16) * 1024 + col0; \
      bs[q][0] = *(const u32x4*)(gs + ro_); bs[q][1] = *(const u32x4*)(gs + ro_ + 128); ba[q][0] = *(const u32x4*)(ga + ro_); ba[q][1] = *(const u32x4*)(ga + ro_ + 128); } while (0)
    MIDLOAD(0, 0);
#pragma unroll
    for (int gi = 0; gi < 8; ++gi) {
      const int q = gi & 1, ai = gi >> 2, m = gi & 3;
      __builtin_amdgcn_sched_barrier(0);
      if (gi + 1 < 8) MIDLOAD(q ^ 1, gi + 1);
      __builtin_amdgcn_sched_barrier(0);
#pragma unroll
      for (int bj = 0; bj < 2; ++bj) { f32x4 s0, s1, a0, a1; unpack8(bs[q][bj], s0, s1); unpack8(ba[q][bj], a0, a1);
#pragma unroll
        for (int j = 0; j < 4; ++j) { acc[ai][bj][m][0][j] *= s0[j] * __builtin_amdgcn_rcpf(a0[j]); acc[ai][bj][m][1][j] *= s1[j] * __builtin_amdgcn_rcpf(a1[j]); } }
    }
    __builtin_amdgcn_sched_barrier(0);
#undef MIDLOAD
  }
  __device__ __forceinline__ void operator()(const f32x4 (&acc)[2][2][4][2], const pg8::Unit& u, int wr, int wc, int fr, int fq) const {
    const int row0 = u.pm * 256 + wr * 64 + fr, col0 = u.pn * 256 + wc * 32 + 8 * fq;
#pragma unroll
    for (int ai = 0; ai < 2; ++ai)
#pragma unroll
      for (int m = 0; m < 4; ++m) {
        const size_t ro = (size_t)(row0 + ai * 128 + m * 16) * 1024 + col0;
#pragma unroll
        for (int bj = 0; bj < 2; ++bj) {
          f32x4 g0, g1; unpack8(*(const u32x4*)(ga + ro + bj * 128), g0, g1);
          *(u32x4*)(out + ro + bj * 128) = pack8(acc[ai][bj][m][0] * g0, acc[ai][bj][m][1] * g1);
        }
      }
  }
};
struct EpiOut {
  static constexpr bool PERM = false, HAS_MID = false;
  const float* x_p; const float* x_s; float* out; float* ssq;
  __device__ __forceinline__ void operator()(const f32x4 (&acc)[2][2][4][2], const pg8::Unit& u, int wr, int wc, int fr, int fq) const {
    const int row0 = u.pm * 256 + wr * 64 + fr, col0 = u.pn * 256 + wc * 32 + 4 * fq;
#pragma unroll
    for (int ai = 0; ai < 2; ++ai)
#pragma unroll
      for (int m = 0; m < 4; ++m) {
        const int r = row0 + ai * 128 + m * 16;
        const float* xr = (r < MP ? x_p + (size_t)r * 1024 : x_s + (size_t)(r - MP) * 1024) + col0;
        float* orow = out + (size_t)r * 1024 + col0; float s = 0.f;
#pragma unroll
        for (int bj = 0; bj < 2; ++bj)
#pragma unroll
          for (int n = 0; n < 2; ++n) { const f32x4 y = acc[ai][bj][m][n] + *(const f32x4*)(xr + bj * 128 + n * 16);
            *(f32x4*)(orow + bj * 128 + n * 16) = y; s += y[0] * y[0] + y[1] * y[1] + y[2] * y[2] + y[3] * y[3]; }
        s += __shfl_xor(s, 16); s += __shfl_xor(s, 32);
        if (fq == 0) atomicAdd(ssq + r, s);
      }
  }
};

namespace att {
constexpr int NW = 8, QBLK = 32, KVBLK = 64, LD = 512, LDO = 1024;
constexpr float SCALE = 0.125f, THR = 8.f;
constexpr int SHM_K = KVBLK * 64 * 2, SHM_V = KVBLK * 128 * 2, OFF_KB0 = 0, OFF_VB0 = 2 * SHM_K, OFF_AUX = 2 * SHM_K + 2 * SHM_V;
#define KSWZ(row, colB) ((row) * 128 + ((colB) ^ ((((row) >> 1) & 7) << 4)))
__device__ __forceinline__ int crow(int r, int hi) { return (r & 3) + 8 * (r >> 2) + 4 * hi; }
constexpr float THR2 = THR * 1.4426950408889634f;
template <bool FIRST>
__device__ __forceinline__ void sm_max(f32x16& p0, f32x16& p1, f32x16& minit, float& alpha) {
  float pmax = p0[0];
#pragma unroll
  for (int r = 1; r < 16; ++r) pmax = fmaxf(pmax, p0[r]);
#pragma unroll
  for (int r = 0; r < 16; ++r) pmax = fmaxf(pmax, p1[r]);
  { auto rr = __builtin_amdgcn_permlane32_swap(__float_as_uint(pmax), __float_as_uint(pmax), false, false);
    pmax = fmaxf(__uint_as_float(rr[0]), __uint_as_float(rr[1])); }
  alpha = 1.f;
  if (FIRST || !__all(pmax <= THR2)) {
    const float dl = FIRST ? pmax : fmaxf(pmax, 0.f);
    alpha = FIRST ? 1.f : __builtin_amdgcn_exp2f(-dl);
#pragma unroll
    for (int r = 0; r < 16; ++r) { p0[r] -= dl; p1[r] -= dl; minit[r] -= dl; }
  }
}
__device__ __forceinline__ void sm_exp(f32x16& p0, f32x16& p1, float alpha, float& l_reg, bf16x8& pa0, bf16x8& pa1, bf16x8& pa2, bf16x8& pa3) {
#pragma unroll
  for (int r = 0; r < 16; ++r) p0[r] = __builtin_amdgcn_exp2f(p0[r]);
#pragma unroll
  for (int r = 0; r < 16; ++r) p1[r] = __builtin_amdgcn_exp2f(p1[r]);
  { float ps = 0;
#pragma unroll
    for (int r = 0; r < 16; ++r) ps += p0[r];
#pragma unroll
    for (int r = 0; r < 16; ++r) ps += p1[r];
    auto rr = __builtin_amdgcn_permlane32_swap(__float_as_uint(ps), __float_as_uint(ps), false, false);
    l_reg = l_reg * alpha + (__uint_as_float(rr[0]) + __uint_as_float(rr[1])); }
#define PK4(P, BASE, OUT) do { u32x4 w = {cvtpk(P[BASE + 0], P[BASE + 1]), cvtpk(P[BASE + 2], P[BASE + 3]), cvtpk(P[BASE + 4], P[BASE + 5]), cvtpk(P[BASE + 6], P[BASE + 7])}; \
    OUT = *reinterpret_cast<bf16x8*>(&w); } while (0)
  PK4(p0, 0, pa0); PK4(p0, 8, pa1); PK4(p1, 0, pa2); PK4(p1, 8, pa3);
#undef PK4
}
__device__ __forceinline__ int v_st(int k, int c) { const int kk = k; return ((kk >> 3) * 4 + (c >> 5)) * 512 + ((kk & 7) * 32 + (c & 31)) * 2; }
__device__ __forceinline__ int v_rd_base(int lane) { return ((lane & 3) << 3) | (((lane >> 2) & 3) << 6) | (((lane >> 4) & 1) << 5) | (((lane >> 5) & 1) << 8); }
constexpr int v_rd_off(int d0, int ks, int half) { return d0 * 512 + ks * 4096 + half * 2048; }
__device__ __forceinline__ s16x4 tr_read(const LAS unsigned char* p) { return __builtin_amdgcn_ds_read_tr16_b64_v4i16((LAS s16x4*)p); }
#define SBAR() __builtin_amdgcn_sched_barrier(0)
#define PKF(L, H) (bf16x8){L[0], L[1], L[2], L[3], H[0], H[1], H[2], H[3]}
#define ABAR() do { asm volatile("s_waitcnt lgkmcnt(0)" ::: "memory"); __builtin_amdgcn_s_barrier(); asm volatile("" ::: "memory"); } while (0)
__device__ __forceinline__ void qk_tile(f32x16& n0, f32x16& n1, const LAS unsigned char* Ks, const bf16x8* qr, const f32x16& minit, int r32, int hi) {
#pragma unroll
  for (int d0 = 0; d0 < 4; ++d0) { const int cb = (d0 * 16 + hi * 8) * 2;
    const bf16x8 b0 = *(const LAS bf16x8*)(Ks + KSWZ(r32, cb)); const bf16x8 b1 = *(const LAS bf16x8*)(Ks + KSWZ(32 + r32, cb));
    if (d0 == 0) { n0 = __builtin_amdgcn_mfma_f32_32x32x16_bf16(b0, qr[0], minit, 0, 0, 0); n1 = __builtin_amdgcn_mfma_f32_32x32x16_bf16(b1, qr[0], minit, 0, 0, 0); }
    else { n0 = __builtin_amdgcn_mfma_f32_32x32x16_bf16(b0, qr[d0], n0, 0, 0, 0); n1 = __builtin_amdgcn_mfma_f32_32x32x16_bf16(b1, qr[d0], n1, 0, 0, 0); } }
}
__device__ __forceinline__ void pv_tile(f32x16* o, const LAS unsigned char* vb, bf16x8 pa0, bf16x8 pa1, bf16x8 pa2, bf16x8 pa3) {
#pragma unroll
  for (int d0 = 0; d0 < 4; ++d0) {
    const s16x4 l0 = tr_read(vb + v_rd_off(d0, 0, 0)), h0 = tr_read(vb + v_rd_off(d0, 0, 1)), l1 = tr_read(vb + v_rd_off(d0, 1, 0)), h1 = tr_read(vb + v_rd_off(d0, 1, 1));
    const s16x4 l2 = tr_read(vb + v_rd_off(d0, 2, 0)), h2 = tr_read(vb + v_rd_off(d0, 2, 1)), l3 = tr_read(vb + v_rd_off(d0, 3, 0)), h3 = tr_read(vb + v_rd_off(d0, 3, 1));
    o[d0] = __builtin_amdgcn_mfma_f32_32x32x16_bf16(pa0, PKF(l0, h0), o[d0], 0, 0, 0);
    o[d0] = __builtin_amdgcn_mfma_f32_32x32x16_bf16(pa1, PKF(l1, h1), o[d0], 0, 0, 0);
    o[d0] = __builtin_amdgcn_mfma_f32_32x32x16_bf16(pa2, PKF(l2, h2), o[d0], 0, 0, 0);
    o[d0] = __builtin_amdgcn_mfma_f32_32x32x16_bf16(pa3, PKF(l3, h3), o[d0], 0, 0, 0);
  }
}
__device__ __forceinline__ void attn_unit(const bf16_t* __restrict__ Qb, const bf16_t* __restrict__ Kh, const bf16_t* __restrict__ Vh, bf16_t* __restrict__ Ob, int seq, LAS unsigned char* lds) {
  const int tid = tid_now(), wid = tid >> 6, lane = tid & 63, r32 = lane & 31, hi = lane >> 5;
  LAS float* al_l = (LAS float*)(lds + OFF_AUX) + wid * 64; LAS float* li_l = al_l + 32;
  f32x16 o[4] = {}; f32x16 minit = {}; float l_reg = 0.f; bf16x8 qr[4];
  const bf16_t* Qw = Qb + (long)(wid * QBLK + r32) * LD + hi * 8;
#pragma unroll
  for (int d0 = 0; d0 < 4; ++d0) qr[d0] = *reinterpret_cast<const bf16x8*>(Qw + d0 * 16);
  const int sr = tid >> 4, sc = (tid & 15) * 8, ksr = tid >> 3, ksc = (tid & 7) * 8;
  const int vst0 = OFF_VB0 + v_st(sr, sc), vst1 = OFF_VB0 + v_st(32 + sr, sc), kst = OFF_KB0 + KSWZ(ksr, ksc * 2);
  const LAS unsigned char* vrd = lds + OFF_VB0 + v_rd_base(lane);
  const int NT = seq / KVBLK;
  bf16x8 sv0, sv1, sk0;
#define SLOAD(j) do { const int kt_ = ((j) + 2 < NT ? (j) + 2 : NT - 1) * KVBLK; \
    sv0 = *reinterpret_cast<const bf16x8*>(&Vh[(long)((j) * KVBLK + sr) * LD + sc]); sv1 = *reinterpret_cast<const bf16x8*>(&Vh[(long)((j) * KVBLK + 32 + sr) * LD + sc]); \
    sk0 = *reinterpret_cast<const bf16x8*>(&Kh[(long)(kt_ + ksr) * LD + ksc]); } while (0)
#define SWRITE(par) do { *(LAS bf16x8*)(lds + (par) * SHM_V + vst0) = sv0; *(LAS bf16x8*)(lds + (par) * SHM_V + vst1) = sv1; *(LAS bf16x8*)(lds + (par) * SHM_K + kst) = sk0; } while (0)
#define RESC(a) do { if (__any((a) < 1.f)) { if (hi == 0) al_l[r32] = (a); asm volatile("s_waitcnt lgkmcnt(0)" ::: "memory"); \
    _Pragma("unroll") for (int r = 0; r < 16; ++r) { const float a_ = al_l[crow(r, hi)]; o[0][r] *= a_; o[1][r] *= a_; o[2][r] *= a_; o[3][r] *= a_; } } } while (0)
#define SCHED_ITER() do { __builtin_amdgcn_sched_group_barrier(0x100, 6, 0); \
    _Pragma("unroll") for (int i_ = 0; i_ < 16; ++i_) { __builtin_amdgcn_sched_group_barrier(0x008, 1, 0); __builtin_amdgcn_sched_group_barrier(0x100, 2, 0); \
      __builtin_amdgcn_sched_group_barrier(0x002, 7, 0); } \
    _Pragma("unroll") for (int i_ = 0; i_ < 8; ++i_) { __builtin_amdgcn_sched_group_barrier(0x008, 1, 0); __builtin_amdgcn_sched_group_barrier(0x100, 1, 0); __builtin_amdgcn_sched_group_barrier(0x002, 2, 0); } \
    __builtin_amdgcn_sched_group_barrier(0x200, 3, 0); __builtin_amdgcn_sched_group_barrier(0x020, 3, 0); } while (0)
  { const bf16x8 k0 = *reinterpret_cast<const bf16x8*>(&Kh[(long)ksr * LD + ksc]); const bf16x8 k1 = *reinterpret_cast<const bf16x8*>(&Kh[(long)(KVBLK + ksr) * LD + ksc]);
    *(LAS bf16x8*)(lds + kst) = k0; *(LAS bf16x8*)(lds + SHM_K + kst) = k1; }
  SLOAD(0);
  ABAR();
  f32x16 s0, s1; float alpha; bf16x8 xa0, xa1, xa2, xa3, ya0, ya1, ya2, ya3;
  qk_tile(s0, s1, lds + OFF_KB0, qr, minit, r32, hi);
  ABAR();
  sm_max<true>(s0, s1, minit, alpha);
  SBAR();
  sm_exp(s0, s1, alpha, l_reg, xa0, xa1, xa2, xa3);
  qk_tile(s0, s1, lds + OFF_KB0 + SHM_K, qr, minit, r32, hi);
  SWRITE(0); SLOAD(1);
  SBAR(); ABAR();
  alpha = 1.f;
  for (int j = 1; j + 1 < NT; j += 2) {
    RESC(alpha);
    sm_max<false>(s0, s1, minit, alpha);
    SBAR();
    pv_tile(o, vrd, xa0, xa1, xa2, xa3);
    sm_exp(s0, s1, alpha, l_reg, ya0, ya1, ya2, ya3);
    qk_tile(s0, s1, lds + OFF_KB0, qr, minit, r32, hi);
    SWRITE(1); SLOAD(j + 1);
    SCHED_ITER();
    SBAR(); ABAR();
    RESC(alpha);
    sm_max<false>(s0, s1, minit, alpha);
    SBAR();
    pv_tile(o, vrd + SHM_V, ya0, ya1, ya2, ya3);
    sm_exp(s0, s1, alpha, l_reg, xa0, xa1, xa2, xa3);
    qk_tile(s0, s1, lds + OFF_KB0 + SHM_K, qr, minit, r32, hi);
    SWRITE(0); if (j + 2 < NT) SLOAD(j + 2);
    SCHED_ITER();
    SBAR(); ABAR();
  }
  RESC(alpha);
  sm_max<false>(s0, s1, minit, alpha);
  SBAR();
  pv_tile(o, vrd, xa0, xa1, xa2, xa3);
  sm_exp(s0, s1, alpha, l_reg, ya0, ya1, ya2, ya3);
  SWRITE(1);
  SBAR(); ABAR();
  RESC(alpha);
  pv_tile(o, vrd + SHM_V, ya0, ya1, ya2, ya3);
  float rli[16];
  if (hi == 0) li_l[r32] = l_reg; asm volatile("s_waitcnt lgkmcnt(0)" ::: "memory");
#pragma unroll
  for (int r = 0; r < 16; ++r) rli[r] = __builtin_amdgcn_rcpf(li_l[crow(r, hi)]);
  bf16_t* Ow = Ob + (long)(wid * QBLK) * LDO;
#pragma unroll
  for (int r = 0; r < 16; ++r) { const int orow = crow(r, hi);
#pragma unroll
    for (int d0 = 0; d0 < 4; ++d0) Ow[(long)orow * LDO + d0 * 32 + r32] = (bf16_t)(cvtpk(o[d0][r] * rli[r], 0.f) & 0xffffu); }
  __syncthreads();
#undef SLOAD
#undef SWRITE
#undef RESC
#undef SCHED_ITER
}
}

constexpr int SCAN_ROWB = 272, SCAN_WAVE_LDS = 32 * SCAN_ROWB;
__device__ __forceinline__ void scan_seq(const unsigned char* wsb, int rowbase, int L, int g, int dir, char* ldsw, int lane) {
  const int j = lane & 31, hi = lane >> 5, l16 = lane & 15, q4 = lane >> 4;
  const float* LAMp = (const float*)(wsb + OFF_LAM) + ((size_t)(dir * 32 + g) * 64 + lane) * 2;
  const float lr = LAMp[0], li = LAMp[1];
  const bf16_t* BBp = (const bf16_t*)(wsb + OFF_BB) + (size_t)(dir * 32 + g) * 128 * 16;
  const bf16_t* CBp = (const bf16_t*)(wsb + OFF_CB) + (size_t)(dir * 32 + g) * 128 * 16;
  bf16x8 bb[4], cb[4];
#pragma unroll
  for (int nb = 0; nb < 4; ++nb) bb[nb] = *(const bf16x8*)(BBp + (nb * 32 + j) * 16 + 8 * hi);
#pragma unroll
  for (int kk = 0; kk < 4; ++kk) cb[kk] = *(const bf16x8*)(CBp + (kk * 16 + l16) * 32 + 8 * q4);
  const bf16_t* XS = (const bf16_t*)(wsb + OFF_XS) + (size_t)rowbase * 512 + g * 16;
  bf16_t* Y = (bf16_t*)(wsb + (dir ? OFF_YB : OFF_YF)) + (size_t)rowbase * 512 + g * 16;
  float hr = 0.f, him = 0.f;
  const int nch = L / 32;
  auto tok = [&](int c, int t) { const int p = c * 32 + t; return dir ? (L - 1 - p) : p; };
  bf16x8 a_next = *(const bf16x8*)(XS + (size_t)tok(0, j) * 512 + 8 * hi);
  for (int c = 0; c < nch; ++c) {
    const bf16x8 a = a_next;
    if (c + 1 < nch) a_next = *(const bf16x8*)(XS + (size_t)tok(c + 1, j) * 512 + 8 * hi);
    const f32x16 z = {};
    f32x16 d0 = __builtin_amdgcn_mfma_f32_32x32x16_bf16(a, bb[0], z, 0, 0, 0);
    f32x16 d1 = __builtin_amdgcn_mfma_f32_32x32x16_bf16(a, bb[1], z, 0, 0, 0);
    f32x16 d2 = __builtin_amdgcn_mfma_f32_32x32x16_bf16(a, bb[2], z, 0, 0, 0);
    f32x16 d3 = __builtin_amdgcn_mfma_f32_32x32x16_bf16(a, bb[3], z, 0, 0, 0);
#pragma unroll
    for (int a4 = 0; a4 < 4; ++a4) {
      float re[2][4], im[2][4];
#pragma unroll
      for (int i = 0; i < 4; ++i) { const int r = 4 * a4 + i;
        auto s0 = __builtin_amdgcn_permlane32_swap(__float_as_uint(d0[r]), __float_as_uint(d2[r]), false, false);
        auto s1 = __builtin_amdgcn_permlane32_swap(__float_as_uint(d1[r]), __float_as_uint(d3[r]), false, false);
        re[0][i] = __uint_as_float(s0[0]); re[1][i] = __uint_as_float(s0[1]); im[0][i] = __uint_as_float(s1[0]); im[1][i] = __uint_as_float(s1[1]); }
#pragma unroll
      for (int h = 0; h < 2; ++h)
#pragma unroll
        for (int i = 0; i < 4; ++i) { const int t = 8 * a4 + 4 * h + i;
          const float nr = fmaf(lr, hr, fmaf(-li, him, re[h][i])), ni = fmaf(lr, him, fmaf(li, hr, im[h][i]));
          hr = nr; him = ni;
          *(unsigned*)(ldsw + t * SCAN_ROWB + lane * 4) = cvtpk(hr, him); }
    }
    __builtin_amdgcn_wave_barrier();
#pragma unroll
    for (int tb = 0; tb < 2; ++tb) {
      f32x4 acc = {0.f, 0.f, 0.f, 0.f};
#pragma unroll
      for (int kk = 0; kk < 4; ++kk) { const bf16x8 hf = *(const bf16x8*)(ldsw + (tb * 16 + l16) * SCAN_ROWB + (kk * 32 + 8 * q4) * 2);
        acc = __builtin_amdgcn_mfma_f32_16x16x32_bf16(cb[kk], hf, acc, 0, 0, 0); }
      u32x2 w; w.x = cvtpk(acc[0], acc[1]); w.y = cvtpk(acc[2], acc[3]);
      *(u32x2*)(Y + (size_t)tok(c, tb * 16 + l16) * 512 + 4 * q4) = w;
    }
    __builtin_amdgcn_wave_barrier();
  }
}

__device__ __forceinline__ int win_drow(int n) {
  if (n < 1024 || n >= 2048) return n;
  const int c = n & 255, tb = n - c, gi = c >> 6, d = c & 63;
  return tb + (d >> 5) * 128 + gi * 32 + (d & 31);
}
__device__ __forceinline__ void transpose_job(const float* src, int ldn, int K, int k0, int n0, bf16_t* dst, const float* gscale, bool perm, float* tile) {
  const int tid = tid_now();
#pragma unroll
  for (int pss = 0; pss < 2; ++pss) { const int kr = (tid >> 4) + pss * 32, nc = (tid & 15) * 4;
    f32x4 v = *(const f32x4*)(src + (size_t)(k0 + kr) * ldn + n0 + nc);
    if (gscale) v = v * gscale[k0 + kr];
    tile[kr * 65 + nc] = v[0]; tile[kr * 65 + nc + 1] = v[1]; tile[kr * 65 + nc + 2] = v[2]; tile[kr * 65 + nc + 3] = v[3]; }
  __syncthreads();
  { const int nl = tid >> 3, kc = (tid & 7) * 8; f32x4 a, b;
#pragma unroll
    for (int i = 0; i < 4; ++i) { a[i] = tile[(kc + i) * 65 + nl]; b[i] = tile[(kc + 4 + i) * 65 + nl]; }
    const int n = n0 + nl, dr = perm ? win_drow(n) : n;
    *(u32x4*)(dst + (size_t)dr * K + k0 + kc) = pack8(a, b); }
  __syncthreads();
}

__global__ void __launch_bounds__(512, 2) fwd_mega(Params p) {
  extern __shared__ __attribute__((aligned(16))) unsigned char smem[];
  cg::grid_group grid = cg::this_grid();
  const int G = gridDim.x, bx = blockIdx.x;
#define tid tid_now()
#define lane (tid_now() & 63)
#define wid (tid_now() >> 6)
  unsigned char* ws = p.ws;
  bf16_t* gsga = (bf16_t*)p.out;
  const int lo = p.ph_lo, hi_ = p.ph_hi & 0xff, p2mode = (p.ph_hi >> 8) & 3;
#ifndef PHMASK
#define PHMASK 255
#endif
#define IN(k) (((PHMASK >> (k)) & 1) && lo <= (k) && (k) < hi_)
#ifdef DUMP
#undef IN
#define IN(k) (((k) == 8 || ((PHMASK >> (k)) & 1)) && lo <= (k) && (k) < hi_)
#endif
#ifndef DUPMASK
#define DUPMASK 0
#endif
#define NREP(k) (((DUPMASK >> (k)) & 1) ? 2 : 1)
#define SEAM(k) do { if (IN(k) && IN((k) + 1)) grid.sync(); } while (0)

  if (IN(0)) {
    for (int r = bx * 8 + wid; r < MT; r += G * 8) {
      const float* xr = r < MP ? p.x_p + (size_t)r * 1024 : p.x_s + (size_t)(r - MP) * 1024;
      bf16_t* xb = (bf16_t*)(ws + OFF_XB) + (size_t)r * 1024; float s = 0.f;
#pragma unroll
      for (int i = 0; i < 4; ++i) { const f32x4 v = *(const f32x4*)(xr + i * 256 + lane * 4); s += v[0] * v[0] + v[1] * v[1] + v[2] * v[2] + v[3] * v[3];
        u32x2 w; w.x = cvtpk(v[0], v[1]); w.y = cvtpk(v[2], v[3]); *(u32x2*)(xb + i * 256 + lane * 4) = w; }
#pragma unroll
      for (int o = 32; o > 0; o >>= 1) s += __shfl_xor(s, o);
      if (lane == 0) ((float*)(ws + OFF_RSTD))[r] = rsqrtf(s * (1.f / 1024.f) + 1e-6f);
    }
    for (int jb = bx; jb < 1856; jb += G) {
      float* tile = (float*)smem;
      if (jb < 1280) transpose_job(p.w_in, NIN, 1024, (jb / 80) * 64, (jb % 80) * 64, (bf16_t*)(ws + OFF_WIN), p.norm_g, true, tile);
      else if (jb < 1344) { const int q = jb - 1280; transpose_job(p.w_glu, 512, 512, (q / 8) * 64, (q % 8) * 64, (bf16_t*)(ws + OFF_WGLU), nullptr, false, tile); }
      else if (jb < 1600) { const int q = jb - 1344, i = q / 128, r = q % 128;
        transpose_job(p.w_branch + (size_t)i * 512 * 1024, 1024, 1024, (r / 16) * 64, (r % 16) * 64, (bf16_t*)(ws + OFF_WBR) + (size_t)i * 512, nullptr, false, tile); }
      else { const int q = jb - 1600; transpose_job(p.w_out, 1024, 1024, (q / 16) * 64, (q % 16) * 64, (bf16_t*)(ws + OFF_WOUT), nullptr, false, tile); }
    }
    const int gt = bx * 512 + tid, GT = G * 512;
    for (int i = gt; i < 8192 * 32; i += GT) { const int pos = i >> 5, k = i & 31;
      const float ex = (float)k * 2.0f / 64.0f; const float invf = (float)(1.0 / pow(10000.0, (double)ex));
      const float ang = (float)pos * invf; const double rev = (double)ang * 0.15915494309189535; const float fr2 = (float)(2.0 * (rev - floor(rev)));
      float* rt = (float*)(ws + OFF_ROT) + (size_t)pos * 64; rt[k] = cospif(fr2); rt[32 + k] = sinpif(fr2); }
    for (int i = gt; i < MT; i += GT) ((float*)(ws + OFF_SSQ))[i] = 0.f;
    if (gt < 4096) { const int dir = gt >> 11, g = (gt >> 6) & 31, s = gt & 63;
      const double dt = exp((double)p.log_dt[dir * 32 + g]);
      const double ar = (double)p.a_re[gt], ai = (double)p.a_im[gt];
      const double mag = exp(ar * dt); const double ph = ai * dt * 0.3183098861837907; const float ph2 = (float)(ph - 2.0 * floor(ph * 0.5));
      const double lr = mag * (double)cospif(ph2), li = mag * (double)sinpif(ph2);
      float* lm = (float*)(ws + OFF_LAM) + (size_t)gt * 2; lm[0] = (float)lr; lm[1] = (float)li;
      const double den = ar * ar + ai * ai, cr = ((lr - 1.0) * ar + li * ai) / den, ci = (li * ar - (lr - 1.0) * ai) / den;
      bf16_t* BBp = (bf16_t*)(ws + OFF_BB) + (size_t)(dir * 32 + g) * 128 * 16;
      const int nbr = (s >> 5) * 2, jj = s & 31;
      for (int c = 0; c < 16; ++c) { const double br = (double)p.b_re[(size_t)gt * 16 + c], bi = (double)p.b_im[(size_t)gt * 16 + c];
        BBp[((nbr) * 32 + jj) * 16 + c] = (bf16_t)(cvtpk((float)(cr * br - ci * bi), 0.f) & 0xffffu);
        BBp[((nbr + 1) * 32 + jj) * 16 + c] = (bf16_t)(cvtpk((float)(cr * bi + ci * br), 0.f) & 0xffffu); }
      bf16_t* CBp = (bf16_t*)(ws + OFF_CB) + (size_t)(dir * 32 + g) * 128 * 16;
      for (int c = 0; c < 16; ++c) { const float cre = p.c_re[((size_t)(dir * 32 + g) * 16 + c) * 64 + s], cim = p.c_im[((size_t)(dir * 32 + g) * 16 + c) * 64 + s];
        const int k = 2 * s, kk = k >> 5, kp = k & 31;
        *(unsigned*)(CBp + (kk * 16 + c) * 32 + kp) = cvtpk(cre, -cim); }
    }
    if (gt == 0) { float s1 = 0.f, s2 = 0.f; for (int i = 0; i < 64; ++i) { s1 += p.lq1[i] * p.lk1[i]; s2 += p.lq2[i] * p.lk2[i]; }
      ((float*)(ws + OFF_CTL))[8] = expf(s1) - expf(s2) + 0.2f; for (int i = 0; i < 64; ++i) if (i != 8) ((unsigned*)(ws + OFF_CTL))[i] = 0u; }
  }
  SEAM(0);

  if (IN(1)) for (int rep = 0; rep < NREP(1); ++rep) {
    pg8::Gemm g{(const bf16_t*)(ws + OFF_XB), (const bf16_t*)(ws + OFF_WIN), MT, NIN, 1024}; pg8::StaticOrder S; S.init(MT, NIN, G, bx);
    EpiIn E{ws, gsga, (const float*)(ws + OFF_RSTD), (const float*)(ws + OFF_ROT)};
    pg8::gemm_phase<EpiIn>((LAS unsigned char*)smem, g, S, E);
  }
  SEAM(1);

  if (IN(2)) for (int rep = 0; rep < NREP(2); ++rep) {
    const int xq = bx & 7;
    unsigned* ctr = (unsigned*)(ws + OFF_CTL) + 16 + rep * 8 + xq; volatile unsigned* bc = (volatile unsigned*)(smem + LDS_BYTES - 16);
    const bf16_t* QB = (const bf16_t*)(ws + OFF_QB); const bf16_t* KB = (const bf16_t*)(ws + OFF_KB); const bf16_t* VB = (const bf16_t*)(ws + OFF_VB); bf16_t* AO = (bf16_t*)(ws + OFF_AO);
    for (;;) {
      __syncthreads();
      if (tid == 0) *bc = atomicAdd(ctr, 1u);
      __syncthreads();
      const int it = (int)*bc;
      if (it >= 336) break;
      const bool is_scan = it < 8 || (it >= 264 && it < 272);
      if ((p2mode == 1 && !is_scan) || (p2mode == 2 && is_scan)) continue;
      if (is_scan) {
        const bool lng = it < 8; const int s = (xq * 8 + (lng ? it : it - 264)) * 8 + wid;
        const int b = s >> 6, g = (s >> 1) & 31, dir = s & 1;
        scan_seq(ws, lng ? MP + b * 8192 : b * 2048, lng ? 8192 : 2048, g, dir, (char*)smem + wid * SCAN_WAVE_LDS, lane);
      } else {
        const bool lng = it < 264; const int u = lng ? it - 8 : it - 272;
        const int nqb = lng ? 32 : 8, L = lng ? 8192 : 2048;
        const int qb = u % nqb, vh = u / nqb, b = xq;
        const size_t rb = lng ? (size_t)MP + (size_t)b * 8192 : (size_t)b * 2048;
        att::attn_unit(QB + (rb + qb * 256) * 512 + vh * 64, KB + rb * 512 + vh * 64, VB + rb * 512 + (vh >> 1) * 128, AO + (rb + qb * 256) * 1024 + vh * 128, L, (LAS unsigned char*)smem);
      }
    }
  }
  SEAM(2);

  if (IN(3)) for (int rep = 0; rep < NREP(3); ++rep) {
    const float lam = ((const float*)(ws + OFF_CTL))[8];
    const bf16_t* YF = (const bf16_t*)(ws + OFF_YF); const bf16_t* YB = (const bf16_t*)(ws + OFF_YB); const bf16_t* XS = (const bf16_t*)(ws + OFF_XS);
    const bf16_t* AO = (const bf16_t*)(ws + OFF_AO); const bf16_t* ZA = (const bf16_t*)(ws + OFF_ZA);
    bf16_t* YSG = (bf16_t*)(ws + OFF_YSG); bf16_t* YCAT = (bf16_t*)(ws + OFF_YCAT);
    const int c0 = lane * 8; const f32x4 dk0 = *(const f32x4*)(p.ssm_d + c0), dk1 = *(const f32x4*)(p.ssm_d + c0 + 4);
    const int h = lane >> 4, e0 = (lane & 15) * 8; const f32x4 sg0 = *(const f32x4*)(p.subln_g + e0) * 0.8f, sg1 = *(const f32x4*)(p.subln_g + e0 + 4) * 0.8f;
    for (int r = bx * 8 + wid; r < MT; r += G * 8) {
      f32x4 f0, f1, b0, b1, x0, x1;
      unpack8(*(const u32x4*)(YF + (size_t)r * 512 + c0), f0, f1); unpack8(*(const u32x4*)(YB + (size_t)r * 512 + c0), b0, b1); unpack8(*(const u32x4*)(XS + (size_t)r * 512 + c0), x0, x1);
      f32x4 v0 = f0 + b0 + dk0 * x0, v1 = f1 + b1 + dk1 * x1;
#pragma unroll
      for (int i = 0; i < 4; ++i) { v0[i] = gelu_tanh(v0[i]); v1[i] = gelu_tanh(v1[i]); }
      f32x4 p0, p1, q0, q1, z0, z1;
      unpack8(*(const u32x4*)(AO + (size_t)r * 1024 + (2 * h) * 128 + e0), p0, p1); unpack8(*(const u32x4*)(AO + (size_t)r * 1024 + (2 * h + 1) * 128 + e0), q0, q1);
      unpack8(*(const u32x4*)(ZA + (size_t)r * 512 + h * 128 + e0), z0, z1);
      *(u32x4*)(YSG + (size_t)r * 512 + c0) = pack8(v0, v1);
      f32x4 o0 = p0 - lam * q0, o1 = p1 - lam * q1;
      float ss = 0.f;
#pragma unroll
      for (int i = 0; i < 4; ++i) ss += o0[i] * o0[i] + o1[i] * o1[i];
      ss += __shfl_xor(ss, 1); ss += __shfl_xor(ss, 2); ss += __shfl_xor(ss, 4); ss += __shfl_xor(ss, 8);
      const float rn = rsqrtf(ss * (1.f / 128.f) + 1e-5f);
      o0 = o0 * rn * sg0 * z0; o1 = o1 * rn * sg1 * z1;
      *(u32x4*)(YCAT + (size_t)r * 1024 + 512 + h * 128 + e0) = pack8(o0, o1);
    }
  }
  SEAM(3);

  if (IN(4)) for (int rep = 0; rep < NREP(4); ++rep) {
    pg8::Gemm g{(const bf16_t*)(ws + OFF_YSG), (const bf16_t*)(ws + OFF_WGLU), MT, 512, 512}; pg8::StaticOrder S; S.init(MT, 512, G, bx);
    EpiGlu E{(const bf16_t*)(ws + OFF_YSG), (const bf16_t*)(ws + OFF_ZS), p.b_glu, (bf16_t*)(ws + OFF_YCAT)};
    pg8::gemm_phase<EpiGlu>((LAS unsigned char*)smem, g, S, E);
  }
  SEAM(4);

  if (IN(5)) for (int rep = 0; rep < NREP(5); ++rep) {
    pg8::StaticOrder S; S.init(MT, 1024, G, bx);
    pg8::Gemm g{(const bf16_t*)(ws + OFF_YCAT), (const bf16_t*)(ws + OFF_WBR), MT, 1024, 1024};
    EpiBrF E{gsga, gsga + (size_t)MT * 1024, (bf16_t*)(ws + OFF_MG)}; pg8::gemm_phase<EpiBrF>((LAS unsigned char*)smem, g, S, E);
  }
  SEAM(5);

  if (IN(6)) {
    pg8::Gemm g{(const bf16_t*)(ws + OFF_MG), (const bf16_t*)(ws + OFF_WOUT), MT, 1024, 1024}; pg8::StaticOrder S; S.init(MT, 1024, G, bx);
    EpiOut E{p.x_p, p.x_s, p.out, (float*)(ws + OFF_SSQ)};
    pg8::gemm_phase<EpiOut>((LAS unsigned char*)smem, g, S, E);
  }
  SEAM(6);

  if (IN(7)) {
    const float* ssq = (const float*)(ws + OFF_SSQ);
    f32x4 fg[4];
#pragma unroll
    for (int i = 0; i < 4; ++i) fg[i] = *(const f32x4*)(p.final_g + i * 256 + lane * 4);
    for (int r = bx * 8 + wid; r < MT; r += G * 8) {
      const float rn = rsqrtf(ssq[r] * (1.f / 1024.f) + 1e-6f); float* orow = p.out + (size_t)r * 1024;
#pragma unroll
      for (int i = 0; i < 4; ++i) { f32x4 v = *(f32x4*)(orow + i * 256 + lane * 4); *(f32x4*)(orow + i * 256 + lane * 4) = v * rn * fg[i]; }
    }
  }

#ifdef DUMP
  if (IN(8)) {
    for (int r = bx * 8 + wid; r < MT; r += G * 8) {
      float* orow = p.out + (size_t)r * 1024;
      for (int c = lane; c < 512; c += 64) {
        float a = 0.f, b = 0.f; const size_t i5 = (size_t)r * 512 + c, i1 = (size_t)r * 1024 + c;
#define BF(off, idx) bflo((unsigned)((const bf16_t*)(ws + (off)))[idx])
        if (DUMP == 1) { a = BF(OFF_XS, i5) + BF(OFF_ZS, i5) + BF(OFF_VB, i5); b = BF(OFF_QB, i5) + BF(OFF_KB, i5) + BF(OFF_ZA, i5); }
        if (DUMP == 2) { a = BF(OFF_YF, i5) + BF(OFF_YB, i5); b = BF(OFF_AO, i1) + BF(OFF_AO, i1 + 512); }
        if (DUMP == 3) { a = BF(OFF_YSG, i5); b = BF(OFF_MG, i1) + BF(OFF_MG, i1 + 512); }
        if (DUMP == 4) { a = BF(OFF_YF, i5); b = BF(OFF_YB, i5); }
        if (DUMP == 5) { a = BF(OFF_AO, i1); b = BF(OFF_AO, i1 + 512); }
#undef BF
        orow[c] = a; orow[512 + c] = b;
      }
    }
  }
#endif
#undef IN
#undef SEAM
#undef tid
#undef lane
#undef wid
}

#ifndef N_LAUNCH_PER_PHASE
#define N_LAUNCH_PER_PHASE 0
#endif
extern "C" void kernel_launch(void* const* d_in, const int* in_sizes, int n_in, void* d_out, int out_size, void* d_ws, size_t ws_size, hipStream_t stream) {
  static int grid = 0;
  if (grid == 0) {
    if (n_in != 22 || out_size != MT * 1024 || ws_size < WS_END) { fprintf(stderr, "kernel_launch: unexpected shapes n_in %d out %d ws %zu (need %zu)\n", n_in, out_size, ws_size, (size_t)WS_END); grid = -1; return; }
    int dev = 0, cus = 0, per_cu = 0;
    hipGetDevice(&dev); hipDeviceGetAttribute(&cus, hipDeviceAttributeMultiprocessorCount, dev);
    if (hipFuncSetAttribute((const void*)fwd_mega, hipFuncAttributeMaxDynamicSharedMemorySize, LDS_BYTES) != hipSuccess) { fprintf(stderr, "kernel_launch: hipFuncSetAttribute failed\n"); grid = -1; return; }
    if (hipOccupancyMaxActiveBlocksPerMultiprocessor(&per_cu, (const void*)fwd_mega, 512, LDS_BYTES) != hipSuccess || per_cu < 1) { fprintf(stderr, "kernel_launch: occupancy query says %d\n", per_cu); per_cu = 1; }
    (void)hipGetLastError();
    grid = cus * 1;
  }
  if (grid < 0) return;
  Params p{};
  p.x_p = (const float*)d_in[0]; p.x_s = (const float*)d_in[1]; p.norm_g = (const float*)d_in[2]; p.w_in = (const float*)d_in[3];
  p.a_re = (const float*)d_in[4]; p.a_im = (const float*)d_in[5]; p.log_dt = (const float*)d_in[6]; p.b_re = (const float*)d_in[7]; p.b_im = (const float*)d_in[8];
  p.c_re = (const float*)d_in[9]; p.c_im = (const float*)d_in[10]; p.ssm_d = (const float*)d_in[11]; p.w_glu = (const float*)d_in[12]; p.b_glu = (const float*)d_in[13];
  p.lq1 = (const float*)d_in[14]; p.lk1 = (const float*)d_in[15]; p.lq2 = (const float*)d_in[16]; p.lk2 = (const float*)d_in[17]; p.subln_g = (const float*)d_in[18];
  p.w_branch = (const float*)d_in[19]; p.w_out = (const float*)d_in[20]; p.final_g = (const float*)d_in[21];
  p.out = (float*)d_out; p.ws = (unsigned char*)d_ws;
#if N_LAUNCH_PER_PHASE
  #ifdef DUMP
  const int nph = 9;
#else
  const int nph = 8;
#endif
  for (int ph = 0; ph < nph; ++ph) { p.ph_lo = ph; p.ph_hi = ph + 1; hipLaunchKernelGGL(fwd_mega, dim3(grid), dim3(512), LDS_BYTES, stream, p); }
#else
#ifdef PREFIX_HI
#ifndef P2MODE
#define P2MODE 0
#endif
  for (int ph = 0; ph < PREFIX_HI; ++ph) { p.ph_lo = ph; p.ph_hi = (ph + 1) | (ph == 2 ? (P2MODE << 8) : 0); hipLaunchKernelGGL(fwd_mega, dim3(grid), dim3(512), LDS_BYTES, stream, p); }
#endif
  p.ph_lo = 0; p.ph_hi = 8;
  void* args[] = {&p};
  hipError_t e = hipLaunchCooperativeKernel((const void*)fwd_mega, dim3(grid), dim3(512), args, LDS_BYTES, stream);
  if (e != hipSuccess) fprintf(stderr, "cooperative launch failed: %s (grid %d)\n", hipGetErrorString(e), grid);
#endif
}
```

```cpp
#include <hip/hip_runtime.h>
#include <hip/hip_cooperative_groups.h>
#include <cstdio>
#include <cstdint>
namespace cg = cooperative_groups;

#define LAS __attribute__((address_space(3)))
typedef unsigned short bf16_t;
typedef short bf16x8 __attribute__((ext_vector_type(8)));
typedef short s16x4 __attribute__((ext_vector_type(4)));
typedef float f32x4 __attribute__((ext_vector_type(4)));
typedef float f32x16 __attribute__((ext_vector_type(16)));
typedef unsigned u32x4 __attribute__((ext_vector_type(4)));
typedef unsigned u32x2 __attribute__((ext_vector_type(2)));

constexpr int DM = 1024, NIN = 5120, MP = 8 * 2048, MS = 8 * 8192, MT = MP + MS;
constexpr size_t UB = (size_t)MT * 512 * 2;
constexpr size_t OFF_XB = 0;
constexpr size_t OFF_XS = 2 * UB, OFF_ZS = 3 * UB, OFF_QB = 4 * UB, OFF_KB = 5 * UB, OFF_VB = 6 * UB, OFF_ZA = 7 * UB;
constexpr size_t OFF_YF = 8 * UB, OFF_YB = 9 * UB;
constexpr size_t OFF_YSG = OFF_VB, OFF_YCAT = OFF_QB, OFF_AO = OFF_XB, OFF_MG = OFF_YF;
constexpr size_t OFF_WIN = 10 * UB;
constexpr size_t OFF_WGLU = OFF_WIN + (size_t)NIN * DM * 2;
constexpr size_t OFF_WBR = OFF_WGLU + 512 * 512 * 2;
constexpr size_t OFF_WOUT = OFF_WBR + 2 * 1024 * 512 * 2;
constexpr size_t OFF_RSTD = OFF_WOUT + 1024 * 1024 * 2;
constexpr size_t OFF_SSQ = OFF_RSTD + (size_t)MT * 4;
constexpr size_t OFF_ROT = OFF_SSQ + (size_t)MT * 4;
constexpr size_t OFF_LAM = OFF_ROT + 8192 * 64 * 4;
constexpr size_t OFF_BB = OFF_LAM + 2 * 32 * 64 * 2 * 4;
constexpr size_t OFF_CB = OFF_BB + 2 * 32 * 128 * 16 * 2;
constexpr size_t OFF_CTL = OFF_CB + 2 * 32 * 128 * 16 * 2;
constexpr size_t WS_END = OFF_CTL + 256;
constexpr int LDS_BYTES = 131072;

struct Params {
  const float* x_p; const float* x_s; const float* norm_g; const float* w_in;
  const float* a_re; const float* a_im; const float* log_dt; const float* b_re; const float* b_im;
  const float* c_re; const float* c_im; const float* ssm_d; const float* w_glu; const float* b_glu;
  const float* lq1; const float* lk1; const float* lq2; const float* lk2; const float* subln_g;
  const float* w_branch; const float* w_out; const float* final_g;
  float* out; unsigned char* ws; int ph_lo, ph_hi;
};

typedef __bf16 bf16x2_t __attribute__((ext_vector_type(2)));
typedef float f32x2_t __attribute__((ext_vector_type(2)));
__device__ __forceinline__ unsigned cvtpk(float lo, float hi) { f32x2_t v = {lo, hi}; bf16x2_t b = __builtin_convertvector(v, bf16x2_t); return *reinterpret_cast<unsigned*>(&b); }
__device__ __forceinline__ float bflo(unsigned w) { return __uint_as_float(w << 16); }
__device__ __forceinline__ float bfhi(unsigned w) { return __uint_as_float(w & 0xffff0000u); }
__device__ __forceinline__ float sigmoidf_(float x) { return __builtin_amdgcn_rcpf(1.f + __builtin_amdgcn_exp2f(-1.4426950408889634f * x)); }
__device__ __forceinline__ float siluf_(float x) { return x * sigmoidf_(x); }
__device__ __forceinline__ float gelu_tanh(float x) { const float u = x + 0.044715f * x * x * x; return x * sigmoidf_(1.5957691216057308f * u); }
__device__ __forceinline__ u32x4 pack8(f32x4 a, f32x4 b) { u32x4 w; w.x = cvtpk(a[0], a[1]); w.y = cvtpk(a[2], a[3]); w.z = cvtpk(b[0], b[1]); w.w = cvtpk(b[2], b[3]); return w; }
__device__ __forceinline__ void unpack8(u32x4 w, f32x4& a, f32x4& b) { a = (f32x4){bflo(w.x), bfhi(w.x), bflo(w.y), bfhi(w.y)}; b = (f32x4){bflo(w.z), bfhi(w.z), bflo(w.w), bfhi(w.w)}; }
__device__ __forceinline__ int tid_now() { const int w = __builtin_amdgcn_readfirstlane((int)threadIdx.x >> 6); return w * 64 + (int)__builtin_amdgcn_mbcnt_hi(~0u, __builtin_amdgcn_mbcnt_lo(~0u, 0u)); }
__device__ __forceinline__ int row_pos(int r) { return r < MP ? (r & 2047) : (r & 8191); }

namespace pg8 {
constexpr int BM = 256, BK = 64, HALF = 128, HTB = HALF * BK * 2, STAGE_BYTES = 8 * HTB, NXCD = 8, WGM = 8;
__host__ __device__ __forceinline__ int lds_byte(int r, int c) { const int st = (r >> 4) * 2 + (c >> 5), rr = r & 15, cc = c & 31, ob = rr * 64 + cc * 2; return st * 1024 + (ob ^ (((ob >> 9) & 1) << 5)); }
__host__ __device__ __forceinline__ void stage_rc(int b, int& R, int& C) { const int st = b / 1024, sb = b % 1024, swz = sb ^ (((sb >> 9) & 1) << 5); R = (st >> 1) * 16 + swz / 64; C = (st & 1) * 32 + (swz % 64) / 2; }
__host__ __device__ __forceinline__ int perm32(int rho) { const int n = rho >> 4, i = rho & 15; return 8 * (i >> 2) + 4 * n + (i & 3); }
struct Unit { int pm, pn; };
struct Gemm { const bf16_t* A; const bf16_t* Bt; int M, N, K; };
struct StaticOrder {
  int nM, nN, nwg, G, c;
  __device__ void init(int M, int N, int G_, int c_) { nM = M / BM; nN = N / BM; nwg = nM * nN; G = G_; c = c_; }
  __device__ bool next(int i, Unit& u) const {
    const long L = (long)i * G + c; if (L >= nwg) return false;
    int wgid = (int)L; { const int q = nwg / NXCD, r = nwg % NXCD, xcd = wgid % NXCD, off = wgid / NXCD; wgid = (xcd < r ? xcd * (q + 1) : r * (q + 1) + (xcd - r) * q) + off; }
    const int nig = WGM * nN, gid = wgid / nig, fm = gid * WGM, gsz = (nM - fm) < WGM ? (nM - fm) : WGM;
    u.pm = fm + ((wgid % nig) % gsz); u.pn = (wgid % nig) / gsz; return true;
  }
};
template <class Epi>
__device__ __forceinline__ void gemm_phase(LAS unsigned char* lds, const Gemm g, const StaticOrder& S, const Epi& E) {
  const int tid = tid_now(), wid = __builtin_amdgcn_readfirstlane(tid >> 6), lane = tid & 63, wr = wid >> 2, wc = wid & 3, fr = lane & 15, fq = lane >> 4;
  const int K = g.K, nt = K / BK;
  unsigned voffA[2], voffB[2];
#pragma unroll
  for (int i = 0; i < 2; ++i) { int R, C; stage_rc(tid * 16 + i * 8192, R, C); const int Rb = Epi::PERM ? ((R & ~31) + perm32(R & 31)) : R;
    voffA[i] = (unsigned)(R * K + C) * 2u; voffB[i] = (unsigned)(Rb * K + C) * 2u; }
  const size_t kstep = (size_t)(BK * 2), hstep = (size_t)HALF * K * 2, tstep = 2 * hstep;
  const unsigned ldsw = (unsigned)wid * 1024u;
  const int aoff = lds_byte(wr * 64 + fr, fq * 8), boff = lds_byte(wc * 32 + fr, fq * 8);
#define PG8_SA(b, h) (((b) * 2 + (h)) * HTB)
#define PG8_SB(b, h) ((4 + (b) * 2 + (h)) * HTB)
#define PG8_STAGE(bufoff, gbase, voff) do { _Pragma("unroll") for (int _i = 0; _i < 2; ++_i) \
    __builtin_amdgcn_global_load_lds((const unsigned*)((const char*)(gbase) + (voff)[_i]), (LAS unsigned*)(lds + (bufoff) + ldsw + _i * 8192), 16, 0, 0); } while (0)
#define PG8_LDA(dst, b, h) do { _Pragma("unroll") for (int m = 0; m < 4; ++m) _Pragma("unroll") for (int k = 0; k < 2; ++k) dst[m][k] = *(const LAS bf16x8*)(lds + PG8_SA(b, h) + aoff + m * 2048 + k * 1024); } while (0)
#define PG8_LDB(dst, b, h) do { _Pragma("unroll") for (int n = 0; n < 2; ++n) _Pragma("unroll") for (int k = 0; k < 2; ++k) dst[n][k] = *(const LAS bf16x8*)(lds + PG8_SB(b, h) + boff + n * 2048 + k * 1024); } while (0)
#define PG8_MMA(ai, bj, At, Bt) do { __builtin_amdgcn_s_setprio(1); _Pragma("unroll") for (int m = 0; m < 4; ++m) _Pragma("unroll") for (int n = 0; n < 2; ++n) _Pragma("unroll") for (int k = 0; k < 2; ++k) \
    acc[ai][bj][m][n] = __builtin_amdgcn_mfma_f32_16x16x32_bf16(Bt[n][k], At[m][k], acc[ai][bj][m][n], 0, 0, 0); __builtin_amdgcn_s_setprio(0); } while (0)
#define PG8_WAIT_V(n) asm volatile("s_waitcnt vmcnt(" #n ")" ::: "memory")
#define PG8_WAIT_L(n) asm volatile("s_waitcnt lgkmcnt(" #n ")" ::: "memory")
#define PG8_BAR __builtin_amdgcn_s_barrier()
#define PG8_SCHED __builtin_amdgcn_sched_barrier(0)
  Unit cur, nxt; int ui = 0;
  if (!S.next(0, cur)) return;
  f32x4 acc[2][2][4][2];
#pragma unroll
  for (int a = 0; a < 2; ++a)
#pragma unroll
    for (int b = 0; b < 2; ++b)
#pragma unroll
      for (int m = 0; m < 4; ++m)
#pragma unroll
        for (int n = 0; n < 2; ++n) acc[a][b][m][n] = (f32x4){0.f, 0.f, 0.f, 0.f};
  bf16x8 At[4][2], B0[2][2], B1[2][2];
  const char* cA = (const char*)g.A + (size_t)cur.pm * tstep; const char* cB = (const char*)g.Bt + (size_t)cur.pn * tstep;
  PG8_STAGE(PG8_SB(0, 0), cB, voffB); PG8_STAGE(PG8_SA(0, 0), cA, voffA); PG8_STAGE(PG8_SB(0, 1), cB + hstep, voffB); PG8_STAGE(PG8_SA(0, 1), cA + hstep, voffA);
  if (wr == 1) PG8_BAR;
  PG8_WAIT_V(4); PG8_BAR;
  PG8_STAGE(PG8_SB(1, 0), cB + kstep, voffB); PG8_STAGE(PG8_SA(1, 0), cA + kstep, voffA); PG8_STAGE(PG8_SB(1, 1), cB + hstep + kstep, voffB);
  PG8_WAIT_V(6); PG8_BAR;
  for (;;) {
    const bool has_next = S.next(ui + 1, nxt);
    const char* nA = has_next ? (const char*)g.A + (size_t)nxt.pm * tstep : cA; const char* nB = has_next ? (const char*)g.Bt + (size_t)nxt.pn * tstep : cB;
    for (int t = 0; t < nt; t += 2) {
      const bool last = (t == nt - 2);
      if constexpr (Epi::HAS_MID) { if (t == nt / 2) E.mid(acc, cur, wr, wc, fr, fq); }
      const char* a1 = cA + (size_t)(t + 1) * kstep;
      const char* a2 = last ? nA : cA + (size_t)(t + 2) * kstep; const char* b2 = last ? nB : cB + (size_t)(t + 2) * kstep;
      const char* a3 = a2 + kstep; const char* b3 = b2 + kstep;
      PG8_LDB(B0, 0, 0); PG8_SCHED; PG8_LDA(At, 0, 0); PG8_STAGE(PG8_SA(1, 1), a1 + hstep, voffA);
      PG8_WAIT_L(8); PG8_BAR; PG8_WAIT_L(0); PG8_MMA(0, 0, At, B0); PG8_BAR; PG8_SCHED;
      PG8_LDB(B1, 0, 1); PG8_STAGE(PG8_SB(0, 0), b2, voffB);
      PG8_BAR; PG8_WAIT_L(0); PG8_MMA(0, 1, At, B1); PG8_BAR;
      PG8_LDA(At, 0, 1); PG8_STAGE(PG8_SA(0, 0), a2, voffA);
      PG8_BAR; PG8_WAIT_L(0); PG8_MMA(1, 0, At, B0); PG8_BAR; PG8_SCHED;
      PG8_STAGE(PG8_SB(0, 1), b2 + hstep, voffB);
      PG8_WAIT_V(6); PG8_BAR; PG8_MMA(1, 1, At, B1); PG8_BAR;
      PG8_LDB(B0, 1, 0); PG8_SCHED; PG8_LDA(At, 1, 0); PG8_STAGE(PG8_SA(0, 1), a2 + hstep, voffA);
      PG8_WAIT_L(8); PG8_BAR; PG8_WAIT_L(0); PG8_MMA(0, 0, At, B0); PG8_BAR; PG8_SCHED;
      PG8_LDB(B1, 1, 1); PG8_STAGE(PG8_SB(1, 0), b3, voffB);
      PG8_BAR; PG8_WAIT_L(0); PG8_MMA(0, 1, At, B1); PG8_BAR;
      PG8_LDA(At, 1, 1); PG8_STAGE(PG8_SA(1, 0), a3, voffA);
      PG8_BAR; PG8_WAIT_L(0); PG8_MMA(1, 0, At, B0); PG8_BAR; PG8_SCHED;
      PG8_STAGE(PG8_SB(1, 1), b3 + hstep, voffB);
      PG8_WAIT_V(6); PG8_BAR; PG8_MMA(1, 1, At, B1); PG8_BAR;
    }
    E(acc, cur, wr, wc, fr, fq);
    if (!has_next) break;
#pragma unroll
    for (int a = 0; a < 2; ++a)
#pragma unroll
      for (int b = 0; b < 2; ++b)
#pragma unroll
        for (int m = 0; m < 4; ++m)
#pragma unroll
          for (int n = 0; n < 2; ++n) acc[a][b][m][n] = (f32x4){0.f, 0.f, 0.f, 0.f};
    cur = nxt; cA = nA; cB = nB; ++ui;
  }
  PG8_WAIT_V(0);
  if (wr == 0) PG8_BAR;
  PG8_BAR;
#undef PG8_SA
#undef PG8_SB
#undef PG8_STAGE
#undef PG8_LDA
#undef PG8_LDB
#undef PG8_MMA
#undef PG8_WAIT_V
#undef PG8_WAIT_L
#undef PG8_BAR
#undef PG8_SCHED
}
}

struct EpiIn {
  static constexpr bool PERM = true, HAS_MID = false;
  unsigned char* ws; bf16_t* gsga; const float* rstd; const float* rot;
  __device__ __forceinline__ void operator()(const f32x4 (&acc)[2][2][4][2], const pg8::Unit& u, int wr, int wc, int fr, int fq) const {
    const int pn = u.pn, row0 = u.pm * 256 + wr * 64 + fr, col0 = wc * 32 + 8 * fq;
    if (pn >= 4 && pn < 8) {
      bf16_t* base = (bf16_t*)(ws + (pn < 6 ? OFF_QB : OFF_KB));
      const int lc = ((pn & 1) * 4 + wc) * 64 + 8 * fq;
#pragma unroll
      for (int ai = 0; ai < 2; ++ai)
#pragma unroll
        for (int m = 0; m < 4; ++m) {
          const int r = row0 + ai * 128 + m * 16; const float rs = rstd[r];
          const float* rp = rot + (size_t)row_pos(r) * 64 + 8 * fq;
          const f32x4 c0 = *(const f32x4*)(rp), c1 = *(const f32x4*)(rp + 4), s0 = *(const f32x4*)(rp + 32), s1 = *(const f32x4*)(rp + 36);
          const float rq = pn < 6 ? rs * 0.18033688011112042f : rs;
          const f32x4 a0 = acc[ai][0][m][0] * rq, a1 = acc[ai][0][m][1] * rq, b0 = acc[ai][1][m][0] * rq, b1 = acc[ai][1][m][1] * rq;
          const f32x4 o10 = a0 * c0 - b0 * s0, o11 = a1 * c1 - b1 * s1, o20 = b0 * c0 + a0 * s0, o21 = b1 * c1 + a1 * s1;
          bf16_t* rowp = base + (size_t)r * 512 + lc;
          *(u32x4*)(rowp) = pack8(o10, o11); *(u32x4*)(rowp + 32) = pack8(o20, o21);
        }
    } else {
      bf16_t* base; int ldc, colt, act;
      if (pn < 2) { base = (bf16_t*)(ws + OFF_XS); ldc = 512; colt = pn * 256; act = 0; }
      else if (pn < 4) { base = (bf16_t*)(ws + OFF_ZS); ldc = 512; colt = (pn - 2) * 256; act = 1; }
      else if (pn < 10) { base = (bf16_t*)(ws + OFF_VB); ldc = 512; colt = (pn - 8) * 256; act = 0; }
      else if (pn < 12) { base = (bf16_t*)(ws + OFF_ZA); ldc = 512; colt = (pn - 10) * 256; act = 1; }
      else if (pn < 16) { base = gsga; ldc = 1024; colt = (pn - 12) * 256; act = 2; }
      else { base = gsga + (size_t)MT * 1024; ldc = 1024; colt = (pn - 16) * 256; act = 2; }
#pragma unroll
      for (int ai = 0; ai < 2; ++ai)
#pragma unroll
        for (int m = 0; m < 4; ++m) {
          const int r = row0 + ai * 128 + m * 16; const float rs = rstd[r];
          bf16_t* rowp = base + (size_t)r * ldc + colt + col0;
#pragma unroll
          for (int bj = 0; bj < 2; ++bj) {
            f32x4 v0 = acc[ai][bj][m][0] * rs, v1 = acc[ai][bj][m][1] * rs;
            if (act == 1) {
#pragma unroll
              for (int j = 0; j < 4; ++j) { v0[j] = siluf_(v0[j]); v1[j] = siluf_(v1[j]); } }
            else if (act == 2) {
#pragma unroll
              for (int j = 0; j < 4; ++j) { v0[j] = sigmoidf_(v0[j]); v1[j] = sigmoidf_(v1[j]); } }
            *(u32x4*)(rowp + bj * 128) = pack8(v0, v1);
          }
        }
    }
  }
};
struct EpiGlu {
  static constexpr bool PERM = true, HAS_MID = false;
  const bf16_t* ysg; const bf16_t* zs; const float* bias; bf16_t* out;
  __device__ __forceinline__ void operator()(const f32x4 (&acc)[2][2][4][2], const pg8::Unit& u, int wr, int wc, int fr, int fq) const {
    const int row0 = u.pm * 256 + wr * 64 + fr, col0 = u.pn * 256 + wc * 32 + 8 * fq;
#pragma unroll
    for (int ai = 0; ai < 2; ++ai)
#pragma unroll
      for (int m = 0; m < 4; ++m) {
        const size_t ro = (size_t)(row0 + ai * 128 + m * 16) * 512 + col0;
#pragma unroll
        for (int bj = 0; bj < 2; ++bj) {
          const f32x4 bb0 = *(const f32x4*)(bias + col0 + bj * 128), bb1 = *(const f32x4*)(bias + col0 + bj * 128 + 4);
          f32x4 y0, y1, z0, z1; unpack8(*(const u32x4*)(ysg + ro + bj * 128), y0, y1); unpack8(*(const u32x4*)(zs + ro + bj * 128), z0, z1);
          f32x4 v0 = acc[ai][bj][m][0] + bb0, v1 = acc[ai][bj][m][1] + bb1;
#pragma unroll
          for (int j = 0; j < 4; ++j) { v0[j] = y0[j] * sigmoidf_(v0[j]) * z0[j]; v1[j] = y1[j] * sigmoidf_(v1[j]) * z1[j]; }
          *(u32x4*)(out + ro * 2 - col0 + bj * 128) = pack8(v0, v1);
        }
      }
  }
};
struct EpiBrF {
  static constexpr bool PERM = true, HAS_MID = true;
  const bf16_t* gs; const bf16_t* ga; bf16_t* out;
  __device__ __forceinline__ void mid(f32x4 (&acc)[2][2][4][2], const pg8::Unit& u, int wr, int wc, int fr, int fq) const {
    int row0 = u.pm * 256 + wr * 64 + fr, col0 = u.pn * 256 + wc * 32 + 8 * fq;
    asm volatile("" : "+v"(row0), "+v"(col0));
    u32x4 bs[2][2], ba[2][2];
#define MIDLOAD(q, gi) do { const size_t ro_ = (size_t)(row0 + ((gi) >> 2) * 128 + ((gi) & 3) * 16) * 1024 + col0; \
      bs[q][0] = *(const u32x4*)(gs + ro_); bs[q][1] = *(const u32x4*)(gs + ro_ + 128); ba[q][0] = *(const u32x4*)(ga + ro_); ba[q][1] = *(const u32x4*)(ga + ro_ + 128); } while (0)
    MIDLOAD(0, 0);
#pragma unroll
    for (int gi = 0; gi < 8; ++gi) {
      const int q = gi & 1, ai = gi >> 2, m = gi & 3;
      __builtin_amdgcn_sched_barrier(0);
      if (gi + 1 < 8) MIDLOAD(q ^ 1, gi + 1);
      __builtin_amdgcn_sched_barrier(0);
#pragma unroll
      for (int bj = 0; bj < 2; ++bj) { f32x4 s0, s1, a0, a1; unpack8(bs[q][bj], s0, s1); unpack8(ba[q][bj], a0, a1);
#pragma unroll
        for (int j = 0; j < 4; ++j) { acc[ai][bj][m][0][j] *= s0[j] * __builtin_amdgcn_rcpf(a0[j]); acc[ai][bj][m][1][j] *= s1[j] * __builtin_amdgcn_rcpf(a1[j]); } }
    }
    __builtin_amdgcn_sched_barrier(0);
#undef MIDLOAD
  }
  __device__ __forceinline__ void operator()(const f32x4 (&acc)[2][2][4][2], const pg8::Unit& u, int wr, int wc, int fr, int fq) const {
    const int row0 = u.pm * 256 + wr * 64 + fr, col0 = u.pn * 256 + wc * 32 + 8 * fq;
#pragma unroll
    for (int ai = 0; ai < 2; ++ai)
#pragma unroll
      for (int m = 0; m < 4; ++m) {
        const size_t ro = (size_t)(row0 + ai * 128 + m * 16) * 1024 + col0;
#pragma unroll
        for (int bj = 0; bj < 2; ++bj) {
          f32x4 g0, g1; unpack8(*(const u32x4*)(ga + ro + bj * 128), g0, g1);
          *(u32x4*)(out + ro + bj * 128) = pack8(acc[ai][bj][m][0] * g0, acc[ai][bj][m][1] * g1);
        }
      }
  }
};
struct EpiOut {
  static constexpr bool PERM = true, HAS_MID = false;
  bf16_t* yb;
  __device__ __forceinline__ void operator()(const f32x4 (&acc)[2][2][4][2], const pg8::Unit& u, int wr, int wc, int fr, int fq) const {
    const int row0 = u.pm * 256 + wr * 64 + fr, col0 = u.pn * 256 + wc * 32 + 8 * fq;
#pragma unroll
    for (int ai = 0; ai < 2; ++ai)
#pragma unroll
      for (int m = 0; m < 4; ++m) {
        bf16_t* orow = yb + (size_t)(row0 + ai * 128 + m * 16) * 1024 + col0;
#pragma unroll
        for (int bj = 0; bj < 2; ++bj) *(u32x4*)(orow + bj * 128) = pack8(acc[ai][bj][m][0], acc[ai][bj][m][1]);
      }
  }
};

namespace att {
constexpr int NW = 8, QBLK = 32, KVBLK = 64, LD = 512, LDO = 1024;
constexpr float SCALE = 0.125f, THR = 8.f;
constexpr int SHM_K = KVBLK * 64 * 2, SHM_V = KVBLK * 128 * 2, OFF_KB0 = 0, OFF_VB0 = 2 * SHM_K, OFF_AUX = 2 * SHM_K + 2 * SHM_V;
#define KSWZ(row, colB) ((row) * 128 + ((colB) ^ ((((row) >> 1) & 7) << 4)))
__device__ __forceinline__ int crow(int r, int hi) { return (r & 3) + 8 * (r >> 2) + 4 * hi; }
constexpr float THR2 = THR * 1.4426950408889634f;
template <bool FIRST>
__device__ __forceinline__ void sm_max(f32x16& p0, f32x16& p1, f32x16& minit, float& alpha) {
  float pmax = p0[0];
#pragma unroll
  for (int r = 1; r < 16; ++r) pmax = fmaxf(pmax, p0[r]);
#pragma unroll
  for (int r = 0; r < 16; ++r) pmax = fmaxf(pmax, p1[r]);
  { auto rr = __builtin_amdgcn_permlane32_swap(__float_as_uint(pmax), __float_as_uint(pmax), false, false);
    pmax = fmaxf(__uint_as_float(rr[0]), __uint_as_float(rr[1])); }
  alpha = 1.f;
  if (FIRST || !__all(pmax <= THR2)) {
    const float dl = FIRST ? pmax : fmaxf(pmax, 0.f);
    alpha = FIRST ? 1.f : __builtin_amdgcn_exp2f(-dl);
#pragma unroll
    for (int r = 0; r < 16; ++r) { p0[r] -= dl; p1[r] -= dl; minit[r] -= dl; }
  }
}
__device__ __forceinline__ void sm_exp(f32x16& p0, f32x16& p1, float alpha, float& l_reg, bf16x8& pa0, bf16x8& pa1, bf16x8& pa2, bf16x8& pa3) {
#pragma unroll
  for (int r = 0; r < 16; ++r) p0[r] = __builtin_amdgcn_exp2f(p0[r]);
#pragma unroll
  for (int r = 0; r < 16; ++r) p1[r] = __builtin_amdgcn_exp2f(p1[r]);
  { float ps = 0;
#pragma unroll
    for (int r = 0; r < 16; ++r) ps += p0[r];
#pragma unroll
    for (int r = 0; r < 16; ++r) ps += p1[r];
    auto rr = __builtin_amdgcn_permlane32_swap(__float_as_uint(ps), __float_as_uint(ps), false, false);
    l_reg = l_reg * alpha + (__uint_as_float(rr[0]) + __uint_as_float(rr[1])); }
#define PK4(P, BASE, OUT) do { u32x4 w = {cvtpk(P[BASE + 0], P[BASE + 1]), cvtpk(P[BASE + 2], P[BASE + 3]), cvtpk(P[BASE + 4], P[BASE + 5]), cvtpk(P[BASE + 6], P[BASE + 7])}; \
    OUT = *reinterpret_cast<bf16x8*>(&w); } while (0)
  PK4(p0, 0, pa0); PK4(p0, 8, pa1); PK4(p1, 0, pa2); PK4(p1, 8, pa3);
#undef PK4
}
__device__ __forceinline__ int v_st(int k, int c) { const int kk = k; return ((kk >> 3) * 4 + (c >> 5)) * 512 + ((kk & 7) * 32 + (c & 31)) * 2; }
__device__ __forceinline__ int v_rd_base(int lane) { return ((lane & 3) << 3) | (((lane >> 2) & 3) << 6) | (((lane >> 4) & 1) << 5) | (((lane >> 5) & 1) << 8); }
constexpr int v_rd_off(int d0, int ks, int half) { return d0 * 512 + ks * 4096 + half * 2048; }
__device__ __forceinline__ s16x4 tr_read(const LAS unsigned char* p) { return __builtin_amdgcn_ds_read_tr16_b64_v4i16((LAS s16x4*)p); }
#define SBAR() __builtin_amdgcn_sched_barrier(0)
#define PKF(L, H) (bf16x8){L[0], L[1], L[2], L[3], H[0], H[1], H[2], H[3]}
#define ABAR() do { asm volatile("s_waitcnt lgkmcnt(0)" ::: "memory"); __builtin_amdgcn_s_barrier(); asm volatile("" ::: "memory"); } while (0)
__device__ __forceinline__ void qk_tile(f32x16& n0, f32x16& n1, const LAS unsigned char* Ks, const bf16x8* qr, const f32x16& minit, int r32, int hi) {
#pragma unroll
  for (int d0 = 0; d0 < 4; ++d0) { const int cb = (d0 * 16 + hi * 8) * 2;
    const bf16x8 b0 = *(const LAS bf16x8*)(Ks + KSWZ(r32, cb)); const bf16x8 b1 = *(const LAS bf16x8*)(Ks + KSWZ(32 + r32, cb));
    if (d0 == 0) { n0 = __builtin_amdgcn_mfma_f32_32x32x16_bf16(b0, qr[0], minit, 0, 0, 0); n1 = __builtin_amdgcn_mfma_f32_32x32x16_bf16(b1, qr[0], minit, 0, 0, 0); }
    else { n0 = __builtin_amdgcn_mfma_f32_32x32x16_bf16(b0, qr[d0], n0, 0, 0, 0); n1 = __builtin_amdgcn_mfma_f32_32x32x16_bf16(b1, qr[d0], n1, 0, 0, 0); } }
}
__device__ __forceinline__ void pv_tile(f32x16* o, const LAS unsigned char* vb, bf16x8 pa0, bf16x8 pa1, bf16x8 pa2, bf16x8 pa3) {
#define PV_KS(ks, pa) do { _Pragma("unroll") for (int d0 = 0; d0 < 4; ++d0) { \
    const s16x4 l_ = tr_read(vb + v_rd_off(d0, ks, 0)), h_ = tr_read(vb + v_rd_off(d0, ks, 1)); \
    o[d0] = __builtin_amdgcn_mfma_f32_32x32x16_bf16(pa, PKF(l_, h_), o[d0], 0, 0, 0); } } while (0)
  PV_KS(0, pa0); PV_KS(1, pa1); PV_KS(2, pa2); PV_KS(3, pa3);
#undef PV_KS
}
__device__ __forceinline__ void attn_unit(const bf16_t* __restrict__ Qb, const bf16_t* __restrict__ Kh, const bf16_t* __restrict__ Vh, bf16_t* __restrict__ Ob, int seq, LAS unsigned char* lds) {
  const int tid = tid_now(), wid = tid >> 6, lane = tid & 63, r32 = lane & 31, hi = lane >> 5;
  LAS float* al_l = (LAS float*)(lds + OFF_AUX) + wid * 64; LAS float* li_l = al_l + 32;
  f32x16 o[4] = {}; f32x16 minit = {}; float l_reg = 0.f; bf16x8 qr[4];
  const bf16_t* Qw = Qb + (long)(wid * QBLK + r32) * LD + hi * 8;
#pragma unroll
  for (int d0 = 0; d0 < 4; ++d0) qr[d0] = *reinterpret_cast<const bf16x8*>(Qw + d0 * 16);
  const int sr = tid >> 4, sc = (tid & 15) * 8, ksr = tid >> 3, ksc = (tid & 7) * 8;
  const int vst0 = OFF_VB0 + v_st(sr, sc), vst1 = OFF_VB0 + v_st(32 + sr, sc), kst = OFF_KB0 + KSWZ(ksr, ksc * 2);
  const LAS unsigned char* vrd = lds + OFF_VB0 + v_rd_base(lane);
  const int NT = seq / KVBLK;
  bf16x8 sv0, sv1, sk0;
#define SLOAD(j) do { const int kt_ = ((j) + 2 < NT ? (j) + 2 : NT - 1) * KVBLK; \
    sv0 = *reinterpret_cast<const bf16x8*>(&Vh[(long)((j) * KVBLK + sr) * LD + sc]); sv1 = *reinterpret_cast<const bf16x8*>(&Vh[(long)((j) * KVBLK + 32 + sr) * LD + sc]); \
    sk0 = *reinterpret_cast<const bf16x8*>(&Kh[(long)(kt_ + ksr) * LD + ksc]); } while (0)
#define SWRITE(par) do { *(LAS bf16x8*)(lds + (par) * SHM_V + vst0) = sv0; *(LAS bf16x8*)(lds + (par) * SHM_V + vst1) = sv1; *(LAS bf16x8*)(lds + (par) * SHM_K + kst) = sk0; } while (0)
#define RESC(a) do { if (__any((a) < 1.f)) { if (hi == 0) al_l[r32] = (a); asm volatile("s_waitcnt lgkmcnt(0)" ::: "memory"); \
    _Pragma("unroll") for (int r = 0; r < 16; ++r) { const float a_ = al_l[crow(r, hi)]; o[0][r] *= a_; o[1][r] *= a_; o[2][r] *= a_; o[3][r] *= a_; } } } while (0)
#define SCHED_ITER() do { __builtin_amdgcn_sched_group_barrier(0x100, 6, 0); \
    _Pragma("unroll") for (int i_ = 0; i_ < 16; ++i_) { __builtin_amdgcn_sched_group_barrier(0x008, 1, 0); __builtin_amdgcn_sched_group_barrier(0x100, 2, 0); \
      __builtin_amdgcn_sched_group_barrier(0x002, 7, 0); } \
    _Pragma("unroll") for (int i_ = 0; i_ < 8; ++i_) { __builtin_amdgcn_sched_group_barrier(0x008, 1, 0); __builtin_amdgcn_sched_group_barrier(0x100, 1, 0); __builtin_amdgcn_sched_group_barrier(0x002, 2, 0); } \
    __builtin_amdgcn_sched_group_barrier(0x200, 3, 0); __builtin_amdgcn_sched_group_barrier(0x020, 3, 0); } while (0)
  { const bf16x8 k0 = *reinterpret_cast<const bf16x8*>(&Kh[(long)ksr * LD + ksc]); const bf16x8 k1 = *reinterpret_cast<const bf16x8*>(&Kh[(long)(KVBLK + ksr) * LD + ksc]);
    *(LAS bf16x8*)(lds + kst) = k0; *(LAS bf16x8*)(lds + SHM_K + kst) = k1; }
  SLOAD(0);
  ABAR();
  f32x16 s0, s1; float alpha; bf16x8 xa0, xa1, xa2, xa3, ya0, ya1, ya2, ya3;
  qk_tile(s0, s1, lds + OFF_KB0, qr, minit, r32, hi);
  ABAR();
  sm_max<true>(s0, s1, minit, alpha);
  SBAR();
  sm_exp(s0, s1, alpha, l_reg, xa0, xa1, xa2, xa3);
  qk_tile(s0, s1, lds + OFF_KB0 + SHM_K, qr, minit, r32, hi);
  SWRITE(0); SLOAD(1);
  SBAR(); ABAR();
  alpha = 1.f;
  for (int j = 1; j + 1 < NT; j += 2) {
    RESC(alpha);
    sm_max<false>(s0, s1, minit, alpha);
    SBAR();
    pv_tile(o, vrd, xa0, xa1, xa2, xa3);
    sm_exp(s0, s1, alpha, l_reg, ya0, ya1, ya2, ya3);
    qk_tile(s0, s1, lds + OFF_KB0, qr, minit, r32, hi);
    SWRITE(1); SLOAD(j + 1);
    SCHED_ITER();
    SBAR(); ABAR();
    RESC(alpha);
    sm_max<false>(s0, s1, minit, alpha);
    SBAR();
    pv_tile(o, vrd + SHM_V, ya0, ya1, ya2, ya3);
    sm_exp(s0, s1, alpha, l_reg, xa0, xa1, xa2, xa3);
    qk_tile(s0, s1, lds + OFF_KB0 + SHM_K, qr, minit, r32, hi);
    SWRITE(0); if (j + 2 < NT) SLOAD(j + 2);
    SCHED_ITER();
    SBAR(); ABAR();
  }
  RESC(alpha);
  sm_max<false>(s0, s1, minit, alpha);
  SBAR();
  pv_tile(o, vrd, xa0, xa1, xa2, xa3);
  sm_exp(s0, s1, alpha, l_reg, ya0, ya1, ya2, ya3);
  SWRITE(1);
  SBAR(); ABAR();
  RESC(alpha);
  pv_tile(o, vrd + SHM_V, ya0, ya1, ya2, ya3);
  float rli[16];
  if (hi == 0) li_l[r32] = l_reg; asm volatile("s_waitcnt lgkmcnt(0)" ::: "memory");
#pragma unroll
  for (int r = 0; r < 16; ++r) rli[r] = __builtin_amdgcn_rcpf(li_l[crow(r, hi)]);
  bf16_t* Ow = Ob + (long)(wid * QBLK) * LDO;
#pragma unroll
  for (int r = 0; r < 16; ++r) { const int orow = crow(r, hi);
#pragma unroll
    for (int d0 = 0; d0 < 4; ++d0) Ow[(long)orow * LDO + d0 * 32 + r32] = (bf16_t)(cvtpk(o[d0][r] * rli[r], 0.f) & 0xffffu); }
  __syncthreads();
#undef SLOAD
#undef SWRITE
#undef RESC
#undef SCHED_ITER
}
}

constexpr int SCAN_ROWB = 272, SCAN_WAVE_LDS = 32 * SCAN_ROWB;
__device__ __forceinline__ void scan_seq(const unsigned char* wsb, int rowbase, int L, int g, int dir, char* ldsw, int lane) {
  const int j = lane & 31, hi = lane >> 5, l16 = lane & 15, q4 = lane >> 4;
  const float* LAMp = (const float*)(wsb + OFF_LAM) + ((size_t)(dir * 32 + g) * 64 + lane) * 2;
  const float lr = LAMp[0], li = LAMp[1];
  const bf16_t* BBp = (const bf16_t*)(wsb + OFF_BB) + (size_t)(dir * 32 + g) * 128 * 16;
  const bf16_t* CBp = (const bf16_t*)(wsb + OFF_CB) + (size_t)(dir * 32 + g) * 128 * 16;
  bf16x8 bb[4], cb[4];
#pragma unroll
  for (int nb = 0; nb < 4; ++nb) bb[nb] = *(const bf16x8*)(BBp + (nb * 32 + j) * 16 + 8 * hi);
#pragma unroll
  for (int kk = 0; kk < 4; ++kk) cb[kk] = *(const bf16x8*)(CBp + (kk * 16 + l16) * 32 + 8 * q4);
  const bf16_t* XS = (const bf16_t*)(wsb + OFF_XS) + (size_t)rowbase * 512 + g * 16;
  bf16_t* Y = (bf16_t*)(wsb + (dir ? OFF_YB : OFF_YF)) + (size_t)rowbase * 512 + g * 16;
  float hr = 0.f, him = 0.f;
  const int nch = L / 32;
  auto tok = [&](int c, int t) { const int p = c * 32 + t; return dir ? (L - 1 - p) : p; };
  bf16x8 a_next = *(const bf16x8*)(XS + (size_t)tok(0, j) * 512 + 8 * hi);
  for (int c = 0; c < nch; ++c) {
    const bf16x8 a = a_next;
    if (c + 1 < nch) a_next = *(const bf16x8*)(XS + (size_t)tok(c + 1, j) * 512 + 8 * hi);
    const f32x16 z = {};
    f32x16 d0 = __builtin_amdgcn_mfma_f32_32x32x16_bf16(a, bb[0], z, 0, 0, 0);
    f32x16 d1 = __builtin_amdgcn_mfma_f32_32x32x16_bf16(a, bb[1], z, 0, 0, 0);
    f32x16 d2 = __builtin_amdgcn_mfma_f32_32x32x16_bf16(a, bb[2], z, 0, 0, 0);
    f32x16 d3 = __builtin_amdgcn_mfma_f32_32x32x16_bf16(a, bb[3], z, 0, 0, 0);
#pragma unroll
    for (int a4 = 0; a4 < 4; ++a4) {
      float re[2][4], im[2][4];
#pragma unroll
      for (int i = 0; i < 4; ++i) { const int r = 4 * a4 + i;
        auto s0 = __builtin_amdgcn_permlane32_swap(__float_as_uint(d0[r]), __float_as_uint(d2[r]), false, false);
        auto s1 = __builtin_amdgcn_permlane32_swap(__float_as_uint(d1[r]), __float_as_uint(d3[r]), false, false);
        re[0][i] = __uint_as_float(s0[0]); re[1][i] = __uint_as_float(s0[1]); im[0][i] = __uint_as_float(s1[0]); im[1][i] = __uint_as_float(s1[1]); }
#pragma unroll
      for (int h = 0; h < 2; ++h)
#pragma unroll
        for (int i = 0; i < 4; ++i) { const int t = 8 * a4 + 4 * h + i;
          const float nr = fmaf(lr, hr, fmaf(-li, him, re[h][i])), ni = fmaf(lr, him, fmaf(li, hr, im[h][i]));
          hr = nr; him = ni;
          *(unsigned*)(ldsw + t * SCAN_ROWB + lane * 4) = cvtpk(hr, him); }
    }
    __builtin_amdgcn_wave_barrier();
#pragma unroll
    for (int tb = 0; tb < 2; ++tb) {
      f32x4 acc = {0.f, 0.f, 0.f, 0.f};
#pragma unroll
      for (int kk = 0; kk < 4; ++kk) { const bf16x8 hf = *(const bf16x8*)(ldsw + (tb * 16 + l16) * SCAN_ROWB + (kk * 32 + 8 * q4) * 2);
        acc = __builtin_amdgcn_mfma_f32_16x16x32_bf16(cb[kk], hf, acc, 0, 0, 0); }
      u32x2 w; w.x = cvtpk(acc[0], acc[1]); w.y = cvtpk(acc[2], acc[3]);
      *(u32x2*)(Y + (size_t)tok(c, tb * 16 + l16) * 512 + 4 * q4) = w;
    }
    __builtin_amdgcn_wave_barrier();
  }
}

__device__ __forceinline__ int win_drow(int n) {
  if (n < 1024 || n >= 2048) return n;
  const int c = n & 255, tb = n - c, gi = c >> 6, d = c & 63;
  return tb + (d >> 5) * 128 + gi * 32 + (d & 31);
}
__device__ __forceinline__ void transpose_job(const float* src, int ldn, int K, int k0, int n0, bf16_t* dst, const float* gscale, bool perm, float* tile) {
  const int tid = tid_now();
#pragma unroll
  for (int pss = 0; pss < 2; ++pss) { const int kr = (tid >> 4) + pss * 32, nc = (tid & 15) * 4;
    f32x4 v = *(const f32x4*)(src + (size_t)(k0 + kr) * ldn + n0 + nc);
    if (gscale) v = v * gscale[k0 + kr];
    tile[kr * 65 + nc] = v[0]; tile[kr * 65 + nc + 1] = v[1]; tile[kr * 65 + nc + 2] = v[2]; tile[kr * 65 + nc + 3] = v[3]; }
  __syncthreads();
  { const int nl = tid >> 3, kc = (tid & 7) * 8; f32x4 a, b;
#pragma unroll
    for (int i = 0; i < 4; ++i) { a[i] = tile[(kc + i) * 65 + nl]; b[i] = tile[(kc + 4 + i) * 65 + nl]; }
    const int n = n0 + nl, dr = perm ? win_drow(n) : n;
    *(u32x4*)(dst + (size_t)dr * K + k0 + kc) = pack8(a, b); }
  __syncthreads();
}

__global__ void __launch_bounds__(512, 2) fwd_mega(Params p) {
  extern __shared__ __attribute__((aligned(16))) unsigned char smem[];
  cg::grid_group grid = cg::this_grid();
  const int G = gridDim.x, bx = blockIdx.x;
#define tid tid_now()
#define lane (tid_now() & 63)
#define wid (tid_now() >> 6)
  unsigned char* ws = p.ws;
  bf16_t* gsga = (bf16_t*)p.out;
  const int lo = p.ph_lo, hi_ = p.ph_hi & 0xff, p2mode = (p.ph_hi >> 8) & 3;
#ifndef PHMASK
#define PHMASK 255
#endif
#define IN(k) (((PHMASK >> (k)) & 1) && lo <= (k) && (k) < hi_)
#ifdef DUMP
#undef IN
#define IN(k) (((k) == 8 || ((PHMASK >> (k)) & 1)) && lo <= (k) && (k) < hi_)
#endif
#ifndef DUPMASK
#define DUPMASK 0
#endif
#define NREP(k) (((DUPMASK >> (k)) & 1) ? 2 : 1)
#define SEAM(k) do { if (IN(k) && IN((k) + 1)) grid.sync(); } while (0)

  if (IN(0)) {
    for (int r = bx * 8 + wid; r < MT; r += G * 8) {
      const float* xr = r < MP ? p.x_p + (size_t)r * 1024 : p.x_s + (size_t)(r - MP) * 1024;
      bf16_t* xb = (bf16_t*)(ws + OFF_XB) + (size_t)r * 1024; float s = 0.f;
#pragma unroll
      for (int i = 0; i < 4; ++i) { const f32x4 v = *(const f32x4*)(xr + i * 256 + lane * 4); s += v[0] * v[0] + v[1] * v[1] + v[2] * v[2] + v[3] * v[3];
        u32x2 w; w.x = cvtpk(v[0], v[1]); w.y = cvtpk(v[2], v[3]); *(u32x2*)(xb + i * 256 + lane * 4) = w; }
#pragma unroll
      for (int o = 32; o > 0; o >>= 1) s += __shfl_xor(s, o);
      if (lane == 0) ((float*)(ws + OFF_RSTD))[r] = rsqrtf(s * (1.f / 1024.f) + 1e-6f);
    }
    for (int jb = bx; jb < 1856; jb += G) {
      float* tile = (float*)smem;
      if (jb < 1280) transpose_job(p.w_in, NIN, 1024, (jb / 80) * 64, (jb % 80) * 64, (bf16_t*)(ws + OFF_WIN), p.norm_g, true, tile);
      else if (jb < 1344) { const int q = jb - 1280; transpose_job(p.w_glu, 512, 512, (q / 8) * 64, (q % 8) * 64, (bf16_t*)(ws + OFF_WGLU), nullptr, false, tile); }
      else if (jb < 1600) { const int q = jb - 1344, i = q / 128, r = q % 128;
        transpose_job(p.w_branch + (size_t)i * 512 * 1024, 1024, 1024, (r / 16) * 64, (r % 16) * 64, (bf16_t*)(ws + OFF_WBR) + (size_t)i * 512, nullptr, false, tile); }
      else { const int q = jb - 1600; transpose_job(p.w_out, 1024, 1024, (q / 16) * 64, (q % 16) * 64, (bf16_t*)(ws + OFF_WOUT), nullptr, false, tile); }
    }
    const int gt = bx * 512 + tid, GT = G * 512;
    for (int i = gt; i < 8192 * 32; i += GT) { const int pos = i >> 5, k = i & 31;
      const float ex = (float)k * 2.0f / 64.0f; const float invf = (float)(1.0 / pow(10000.0, (double)ex));
      const float ang = (float)pos * invf; const double rev = (double)ang * 0.15915494309189535; const float fr2 = (float)(2.0 * (rev - floor(rev)));
      float* rt = (float*)(ws + OFF_ROT) + (size_t)pos * 64; rt[k] = cospif(fr2); rt[32 + k] = sinpif(fr2); }
    for (int i = gt; i < MT; i += GT) ((float*)(ws + OFF_SSQ))[i] = 0.f;
    if (gt < 4096) { const int dir = gt >> 11, g = (gt >> 6) & 31, s = gt & 63;
      const double dt = exp((double)p.log_dt[dir * 32 + g]);
      const double ar = (double)p.a_re[gt], ai = (double)p.a_im[gt];
      const double mag = exp(ar * dt); const double ph = ai * dt * 0.3183098861837907; const float ph2 = (float)(ph - 2.0 * floor(ph * 0.5));
      const double lr = mag * (double)cospif(ph2), li = mag * (double)sinpif(ph2);
      float* lm = (float*)(ws + OFF_LAM) + (size_t)gt * 2; lm[0] = (float)lr; lm[1] = (float)li;
      const double den = ar * ar + ai * ai, cr = ((lr - 1.0) * ar + li * ai) / den, ci = (li * ar - (lr - 1.0) * ai) / den;
      bf16_t* BBp = (bf16_t*)(ws + OFF_BB) + (size_t)(dir * 32 + g) * 128 * 16;
      const int nbr = (s >> 5) * 2, jj = s & 31;
      for (int c = 0; c < 16; ++c) { const double br = (double)p.b_re[(size_t)gt * 16 + c], bi = (double)p.b_im[(size_t)gt * 16 + c];
        BBp[((nbr) * 32 + jj) * 16 + c] = (bf16_t)(cvtpk((float)(cr * br - ci * bi), 0.f) & 0xffffu);
        BBp[((nbr + 1) * 32 + jj) * 16 + c] = (bf16_t)(cvtpk((float)(cr * bi + ci * br), 0.f) & 0xffffu); }
      bf16_t* CBp = (bf16_t*)(ws + OFF_CB) + (size_t)(dir * 32 + g) * 128 * 16;
      for (int c = 0; c < 16; ++c) { const float cre = p.c_re[((size_t)(dir * 32 + g) * 16 + c) * 64 + s], cim = p.c_im[((size_t)(dir * 32 + g) * 16 + c) * 64 + s];
        const int k = 2 * s, kk = k >> 5, kp = k & 31;
        *(unsigned*)(CBp + (kk * 16 + c) * 32 + kp) = cvtpk(cre, -cim); }
    }
    if (gt == 0) { float s1 = 0.f, s2 = 0.f; for (int i = 0; i < 64; ++i) { s1 += p.lq1[i] * p.lk1[i]; s2 += p.lq2[i] * p.lk2[i]; }
      ((float*)(ws + OFF_CTL))[8] = expf(s1) - expf(s2) + 0.2f; for (int i = 0; i < 64; ++i) if (i != 8) ((unsigned*)(ws + OFF_CTL))[i] = 0u; }
  }
  SEAM(0);

  if (IN(1)) for (int rep = 0; rep < NREP(1); ++rep) {
    pg8::Gemm g{(const bf16_t*)(ws + OFF_XB), (const bf16_t*)(ws + OFF_WIN), MT, NIN, 1024}; pg8::StaticOrder S; S.init(MT, NIN, G, bx);
    EpiIn E{ws, gsga, (const float*)(ws + OFF_RSTD), (const float*)(ws + OFF_ROT)};
    pg8::gemm_phase<EpiIn>((LAS unsigned char*)smem, g, S, E);
  }
  SEAM(1);

  if (IN(2)) for (int rep = 0; rep < NREP(2); ++rep) {
    const int xq = bx & 7;
    unsigned* ctr = (unsigned*)(ws + OFF_CTL) + 16 + rep * 8 + xq; volatile unsigned* bc = (volatile unsigned*)(smem + LDS_BYTES - 16);
    const bf16_t* QB = (const bf16_t*)(ws + OFF_QB); const bf16_t* KB = (const bf16_t*)(ws + OFF_KB); const bf16_t* VB = (const bf16_t*)(ws + OFF_VB); bf16_t* AO = (bf16_t*)(ws + OFF_AO);
    for (;;) {
      __syncthreads();
      if (tid == 0) *bc = atomicAdd(ctr, 1u);
      __syncthreads();
      const int it = (int)*bc;
      if (it >= 336) break;
      const bool is_scan = it < 8 || (it >= 264 && it < 272);
      if ((p2mode == 1 && !is_scan) || (p2mode == 2 && is_scan)) continue;
      if (is_scan) {
        const bool lng = it < 8; const int s = (xq * 8 + (lng ? it : it - 264)) * 8 + wid;
        const int b = s >> 6, g = (s >> 1) & 31, dir = s & 1;
        scan_seq(ws, lng ? MP + b * 8192 : b * 2048, lng ? 8192 : 2048, g, dir, (char*)smem + wid * SCAN_WAVE_LDS, lane);
      } else {
        const bool lng = it < 264; const int u = lng ? it - 8 : it - 272;
        const int nqb = lng ? 32 : 8, L = lng ? 8192 : 2048;
        const int qb = u % nqb, vh = u / nqb, b = xq;
        const size_t rb = lng ? (size_t)MP + (size_t)b * 8192 : (size_t)b * 2048;
        att::attn_unit(QB + (rb + qb * 256) * 512 + vh * 64, KB + rb * 512 + vh * 64, VB + rb * 512 + (vh >> 1) * 128, AO + (rb + qb * 256) * 1024 + vh * 128, L, (LAS unsigned char*)smem);
      }
    }
  }
  SEAM(2);

  if (IN(3)) for (int rep = 0; rep < NREP(3); ++rep) {
    const float lam = ((const float*)(ws + OFF_CTL))[8];
    const bf16_t* YF = (const bf16_t*)(ws + OFF_YF); const bf16_t* YB = (const bf16_t*)(ws + OFF_YB); const bf16_t* XS = (const bf16_t*)(ws + OFF_XS);
    const bf16_t* AO = (const bf16_t*)(ws + OFF_AO); const bf16_t* ZA = (const bf16_t*)(ws + OFF_ZA);
    bf16_t* YSG = (bf16_t*)(ws + OFF_YSG); bf16_t* YCAT = (bf16_t*)(ws + OFF_YCAT);
    const int c0 = lane * 8; const f32x4 dk0 = *(const f32x4*)(p.ssm_d + c0), dk1 = *(const f32x4*)(p.ssm_d + c0 + 4);
    const int h = lane >> 4, e0 = (lane & 15) * 8; const f32x4 sg0 = *(const f32x4*)(p.subln_g + e0) * 0.8f, sg1 = *(const f32x4*)(p.subln_g + e0 + 4) * 0.8f;
    for (int r = bx * 8 + wid; r < MT; r += G * 8) {
      f32x4 f0, f1, b0, b1, x0, x1;
      unpack8(*(const u32x4*)(YF + (size_t)r * 512 + c0), f0, f1); unpack8(*(const u32x4*)(YB + (size_t)r * 512 + c0), b0, b1); unpack8(*(const u32x4*)(XS + (size_t)r * 512 + c0), x0, x1);
      f32x4 v0 = f0 + b0 + dk0 * x0, v1 = f1 + b1 + dk1 * x1;
#pragma unroll
      for (int i = 0; i < 4; ++i) { v0[i] = gelu_tanh(v0[i]); v1[i] = gelu_tanh(v1[i]); }
      f32x4 p0, p1, q0, q1, z0, z1;
      unpack8(*(const u32x4*)(AO + (size_t)r * 1024 + (2 * h) * 128 + e0), p0, p1); unpack8(*(const u32x4*)(AO + (size_t)r * 1024 + (2 * h + 1) * 128 + e0), q0, q1);
      unpack8(*(const u32x4*)(ZA + (size_t)r * 512 + h * 128 + e0), z0, z1);
      *(u32x4*)(YSG + (size_t)r * 512 + c0) = pack8(v0, v1);
      f32x4 o0 = p0 - lam * q0, o1 = p1 - lam * q1;
      float ss = 0.f;
#pragma unroll
      for (int i = 0; i < 4; ++i) ss += o0[i] * o0[i] + o1[i] * o1[i];
      ss += __shfl_xor(ss, 1); ss += __shfl_xor(ss, 2); ss += __shfl_xor(ss, 4); ss += __shfl_xor(ss, 8);
      const float rn = rsqrtf(ss * (1.f / 128.f) + 1e-5f);
      o0 = o0 * rn * sg0 * z0; o1 = o1 * rn * sg1 * z1;
      *(u32x4*)(YCAT + (size_t)r * 1024 + 512 + h * 128 + e0) = pack8(o0, o1);
    }
  }
  SEAM(3);

  if (IN(4)) for (int rep = 0; rep < NREP(4); ++rep) {
    pg8::Gemm g{(const bf16_t*)(ws + OFF_YSG), (const bf16_t*)(ws + OFF_WGLU), MT, 512, 512}; pg8::StaticOrder S; S.init(MT, 512, G, bx);
    EpiGlu E{(const bf16_t*)(ws + OFF_YSG), (const bf16_t*)(ws + OFF_ZS), p.b_glu, (bf16_t*)(ws + OFF_YCAT)};
    pg8::gemm_phase<EpiGlu>((LAS unsigned char*)smem, g, S, E);
  }
  SEAM(4);

  if (IN(5)) for (int rep = 0; rep < NREP(5); ++rep) {
    pg8::StaticOrder S; S.init(MT, 1024, G, bx);
    pg8::Gemm g{(const bf16_t*)(ws + OFF_YCAT), (const bf16_t*)(ws + OFF_WBR), MT, 1024, 1024};
    EpiBrF E{gsga, gsga + (size_t)MT * 1024, (bf16_t*)(ws + OFF_MG)}; pg8::gemm_phase<EpiBrF>((LAS unsigned char*)smem, g, S, E);
  }
  SEAM(5);

  if (IN(6)) {
    pg8::Gemm g{(const bf16_t*)(ws + OFF_MG), (const bf16_t*)(ws + OFF_WOUT), MT, 1024, 1024}; pg8::StaticOrder S; S.init(MT, 1024, G, bx);
    EpiOut E{(bf16_t*)(ws + OFF_XB)};
    pg8::gemm_phase<EpiOut>((LAS unsigned char*)smem, g, S, E);
  }
  SEAM(6);

  if (IN(7)) {
    f32x4 fg[4];
#pragma unroll
    for (int i = 0; i < 4; ++i) fg[i] = *(const f32x4*)(p.final_g + (i >> 1) * 512 + lane * 8 + (i & 1) * 4);
    const bf16_t* yb = (const bf16_t*)(ws + OFF_XB);
    for (int r = bx * 8 + wid; r < MT; r += G * 8) {
      const float* xr = r < MP ? p.x_p + (size_t)r * 1024 : p.x_s + (size_t)(r - MP) * 1024;
      float* orow = p.out + (size_t)r * 1024; const bf16_t* yr = yb + (size_t)r * 1024;
      f32x4 y[4]; float s = 0.f;
#pragma unroll
      for (int i = 0; i < 2; ++i) { f32x4 v0, v1; unpack8(*(const u32x4*)(yr + i * 512 + lane * 8), v0, v1);
        y[2 * i] = v0 + *(const f32x4*)(xr + i * 512 + lane * 8); y[2 * i + 1] = v1 + *(const f32x4*)(xr + i * 512 + lane * 8 + 4); }
#pragma unroll
      for (int i = 0; i < 4; ++i) s += y[i][0] * y[i][0] + y[i][1] * y[i][1] + y[i][2] * y[i][2] + y[i][3] * y[i][3];
#pragma unroll
      for (int o = 32; o > 0; o >>= 1) s += __shfl_xor(s, o);
      const float rn = rsqrtf(s * (1.f / 1024.f) + 1e-6f);
#pragma unroll
      for (int i = 0; i < 2; ++i) { *(f32x4*)(orow + i * 512 + lane * 8) = y[2 * i] * rn * fg[2 * i]; *(f32x4*)(orow + i * 512 + lane * 8 + 4) = y[2 * i + 1] * rn * fg[2 * i + 1]; }
    }
  }

#ifdef DUMP
  if (IN(8)) {
    for (int r = bx * 8 + wid; r < MT; r += G * 8) {
      float* orow = p.out + (size_t)r * 1024;
      for (int c = lane; c < 512; c += 64) {
        float a = 0.f, b = 0.f; const size_t i5 = (size_t)r * 512 + c, i1 = (size_t)r * 1024 + c;
#define BF(off, idx) bflo((unsigned)((const bf16_t*)(ws + (off)))[idx])
        if (DUMP == 1) { a = BF(OFF_XS, i5) + BF(OFF_ZS, i5) + BF(OFF_VB, i5); b = BF(OFF_QB, i5) + BF(OFF_KB, i5) + BF(OFF_ZA, i5); }
        if (DUMP == 2) { a = BF(OFF_YF, i5) + BF(OFF_YB, i5); b = BF(OFF_AO, i1) + BF(OFF_AO, i1 + 512); }
        if (DUMP == 3) { a = BF(OFF_YSG, i5); b = BF(OFF_MG, i1) + BF(OFF_MG, i1 + 512); }
        if (DUMP == 4) { a = BF(OFF_YF, i5); b = BF(OFF_YB, i5); }
        if (DUMP == 5) { a = BF(OFF_AO, i1); b = BF(OFF_AO, i1 + 512); }
#undef BF
        orow[c] = a; orow[512 + c] = b;
      }
    }
  }
#endif
#undef IN
#undef SEAM
#undef tid
#undef lane
#undef wid
}

#ifndef N_LAUNCH_PER_PHASE
#define N_LAUNCH_PER_PHASE 0
#endif
extern "C" void kernel_launch(void* const* d_in, const int* in_sizes, int n_in, void* d_out, int out_size, void* d_ws, size_t ws_size, hipStream_t stream) {
  static int grid = 0;
  if (grid == 0) {
    if (n_in != 22 || out_size != MT * 1024 || ws_size < WS_END) { fprintf(stderr, "kernel_launch: unexpected shapes n_in %d out %d ws %zu (need %zu)\n", n_in, out_size, ws_size, (size_t)WS_END); grid = -1; return; }
    int dev = 0, cus = 0, per_cu = 0;
    hipGetDevice(&dev); hipDeviceGetAttribute(&cus, hipDeviceAttributeMultiprocessorCount, dev);
    if (hipFuncSetAttribute((const void*)fwd_mega, hipFuncAttributeMaxDynamicSharedMemorySize, LDS_BYTES) != hipSuccess) { fprintf(stderr, "kernel_launch: hipFuncSetAttribute failed\n"); grid = -1; return; }
    if (hipOccupancyMaxActiveBlocksPerMultiprocessor(&per_cu, (const void*)fwd_mega, 512, LDS_BYTES) != hipSuccess || per_cu < 1) { fprintf(stderr, "kernel_launch: occupancy query says %d\n", per_cu); per_cu = 1; }
    (void)hipGetLastError();
    grid = cus * 1;
  }
  if (grid < 0) return;
  Params p{};
  p.x_p = (const float*)d_in[0]; p.x_s = (const float*)d_in[1]; p.norm_g = (const float*)d_in[2]; p.w_in = (const float*)d_in[3];
  p.a_re = (const float*)d_in[4]; p.a_im = (const float*)d_in[5]; p.log_dt = (const float*)d_in[6]; p.b_re = (const float*)d_in[7]; p.b_im = (const float*)d_in[8];
  p.c_re = (const float*)d_in[9]; p.c_im = (const float*)d_in[10]; p.ssm_d = (const float*)d_in[11]; p.w_glu = (const float*)d_in[12]; p.b_glu = (const float*)d_in[13];
  p.lq1 = (const float*)d_in[14]; p.lk1 = (const float*)d_in[15]; p.lq2 = (const float*)d_in[16]; p.lk2 = (const float*)d_in[17]; p.subln_g = (const float*)d_in[18];
  p.w_branch = (const float*)d_in[19]; p.w_out = (const float*)d_in[20]; p.final_g = (const float*)d_in[21];
  p.out = (float*)d_out; p.ws = (unsigned char*)d_ws;
#if N_LAUNCH_PER_PHASE
  #ifdef DUMP
  const int nph = 9;
#else
  const int nph = 8;
#endif
  for (int ph = 0; ph < nph; ++ph) { p.ph_lo = ph; p.ph_hi = ph + 1; hipLaunchKernelGGL(fwd_mega, dim3(grid), dim3(512), LDS_BYTES, stream, p); }
#else
#ifdef PREFIX_HI
#ifndef P2MODE
#define P2MODE 0
#endif
  for (int ph = 0; ph < PREFIX_HI; ++ph) { p.ph_lo = ph; p.ph_hi = (ph + 1) | (ph == 2 ? (P2MODE << 8) : 0); hipLaunchKernelGGL(fwd_mega, dim3(grid), dim3(512), LDS_BYTES, stream, p); }
#endif
  p.ph_lo = 0; p.ph_hi = 8;
  void* args[] = {&p};
  hipError_t e = hipLaunchCooperativeKernel((const void*)fwd_mega, dim3(grid), dim3(512), args, LDS_BYTES, stream);
  if (e != hipSuccess) fprintf(stderr, "cooperative launch failed: %s (grid %d)\n", hipGetErrorString(e), grid);
#endif
}
```

```cpp
#include <hip/hip_runtime.h>
#include <hip/hip_cooperative_groups.h>
#include <cstdio>
#include <cstdint>
namespace cg = cooperative_groups;

#define LAS __attribute__((address_space(3)))
typedef unsigned short bf16_t;
typedef short bf16x8 __attribute__((ext_vector_type(8)));
typedef short s16x4 __attribute__((ext_vector_type(4)));
typedef float f32x4 __attribute__((ext_vector_type(4)));
typedef float f32x16 __attribute__((ext_vector_type(16)));
typedef unsigned u32x4 __attribute__((ext_vector_type(4)));
typedef unsigned u32x2 __attribute__((ext_vector_type(2)));

constexpr int DM = 1024, NIN = 5120, MP = 8 * 2048, MS = 8 * 8192, MT = MP + MS;
constexpr size_t UB = (size_t)MT * 512 * 2;
constexpr size_t OFF_XB = 0;
constexpr size_t OFF_XS = 2 * UB, OFF_ZS = 3 * UB, OFF_QB = 4 * UB, OFF_KB = 5 * UB, OFF_VB = 6 * UB, OFF_ZA = 7 * UB;
constexpr size_t OFF_YF = 8 * UB, OFF_YB = 9 * UB;
constexpr size_t OFF_YSG = OFF_VB, OFF_YCAT = OFF_QB, OFF_AO = OFF_XB, OFF_MG = OFF_YF;
constexpr size_t OFF_WIN = 10 * UB;
constexpr size_t OFF_WGLU = OFF_WIN + (size_t)NIN * DM * 2;
constexpr size_t OFF_WBR = OFF_WGLU + 512 * 512 * 2;
constexpr size_t OFF_WOUT = OFF_WBR + 2 * 1024 * 512 * 2;
constexpr size_t OFF_RSTD = OFF_WOUT + 1024 * 1024 * 2;
constexpr size_t OFF_SSQ = OFF_RSTD + (size_t)MT * 4;
constexpr size_t OFF_ROT = OFF_SSQ + (size_t)MT * 4;
constexpr size_t OFF_LAM = OFF_ROT + 8192 * 64 * 4;
constexpr size_t OFF_BB = OFF_LAM + 2 * 32 * 64 * 2 * 4;
constexpr size_t OFF_CB = OFF_BB + 2 * 32 * 128 * 16 * 2;
constexpr size_t OFF_CTL = OFF_CB + 2 * 32 * 128 * 16 * 2;
constexpr size_t WS_END = OFF_CTL + 256;
constexpr int LDS_BYTES = 131072;

struct Params {
  const float* x_p; const float* x_s; const float* norm_g; const float* w_in;
  const float* a_re; const float* a_im; const float* log_dt; const float* b_re; const float* b_im;
  const float* c_re; const float* c_im; const float* ssm_d; const float* w_glu; const float* b_glu;
  const float* lq1; const float* lk1; const float* lq2; const float* lk2; const float* subln_g;
  const float* w_branch; const float* w_out; const float* final_g;
  float* out; unsigned char* ws; int ph_lo, ph_hi;
};

typedef __bf16 bf16x2_t __attribute__((ext_vector_type(2)));
typedef float f32x2_t __attribute__((ext_vector_type(2)));
__device__ __forceinline__ unsigned cvtpk(float lo, float hi) { f32x2_t v = {lo, hi}; bf16x2_t b = __builtin_convertvector(v, bf16x2_t); return *reinterpret_cast<unsigned*>(&b); }
__device__ __forceinline__ float bflo(unsigned w) { return __uint_as_float(w << 16); }
__device__ __forceinline__ float bfhi(unsigned w) { return __uint_as_float(w & 0xffff0000u); }
__device__ __forceinline__ float sigmoidf_(float x) { return __builtin_amdgcn_rcpf(1.f + __builtin_amdgcn_exp2f(-1.4426950408889634f * x)); }
__device__ __forceinline__ float siluf_(float x) { return x * sigmoidf_(x); }
__device__ __forceinline__ float gelu_tanh(float x) { const float u = x + 0.044715f * x * x * x; return x * sigmoidf_(1.5957691216057308f * u); }
__device__ __forceinline__ u32x4 pack8(f32x4 a, f32x4 b) { u32x4 w; w.x = cvtpk(a[0], a[1]); w.y = cvtpk(a[2], a[3]); w.z = cvtpk(b[0], b[1]); w.w = cvtpk(b[2], b[3]); return w; }
__device__ __forceinline__ void unpack8(u32x4 w, f32x4& a, f32x4& b) { a = (f32x4){bflo(w.x), bfhi(w.x), bflo(w.y), bfhi(w.y)}; b = (f32x4){bflo(w.z), bfhi(w.z), bflo(w.w), bfhi(w.w)}; }
__device__ __forceinline__ int tid_now() { const int w = __builtin_amdgcn_readfirstlane((int)threadIdx.x >> 6); return w * 64 + (int)__builtin_amdgcn_mbcnt_hi(~0u, __builtin_amdgcn_mbcnt_lo(~0u, 0u)); }
__device__ __forceinline__ int row_pos(int r) { return r < MP ? (r & 2047) : (r & 8191); }

namespace pg8 {
constexpr int BM = 256, BK = 64, HALF = 128, HTB = HALF * BK * 2, STAGE_BYTES = 8 * HTB, NXCD = 8, WGM = 8;
__host__ __device__ __forceinline__ int lds_byte(int r, int c) { const int st = (r >> 4) * 2 + (c >> 5), rr = r & 15, cc = c & 31, ob = rr * 64 + cc * 2; return st * 1024 + (ob ^ (((ob >> 9) & 1) << 5)); }
__host__ __device__ __forceinline__ void stage_rc(int b, int& R, int& C) { const int st = b / 1024, sb = b % 1024, swz = sb ^ (((sb >> 9) & 1) << 5); R = (st >> 1) * 16 + swz / 64; C = (st & 1) * 32 + (swz % 64) / 2; }
__host__ __device__ __forceinline__ int perm32(int rho) { const int n = rho >> 4, i = rho & 15; return 8 * (i >> 2) + 4 * n + (i & 3); }
struct Unit { int pm, pn; };
struct Gemm { const bf16_t* A; const bf16_t* Bt; int M, N, K; };
struct StaticOrder {
  int nM, nN, nwg, G, c;
  __device__ void init(int M, int N, int G_, int c_) { nM = M / BM; nN = N / BM; nwg = nM * nN; G = G_; c = c_; }
  __device__ bool next(int i, Unit& u) const {
    const long L = (long)i * G + c; if (L >= nwg) return false;
    int wgid = (int)L; { const int q = nwg / NXCD, r = nwg % NXCD, xcd = wgid % NXCD, off = wgid / NXCD; wgid = (xcd < r ? xcd * (q + 1) : r * (q + 1) + (xcd - r) * q) + off; }
    const int nig = WGM * nN, gid = wgid / nig, fm = gid * WGM, gsz = (nM - fm) < WGM ? (nM - fm) : WGM;
    u.pm = fm + ((wgid % nig) % gsz); u.pn = (wgid % nig) / gsz; return true;
  }
};
template <class Epi>
__device__ __forceinline__ void gemm_phase(LAS unsigned char* lds, const Gemm g, const StaticOrder& S, const Epi& E) {
  const int tid = tid_now(), wid = __builtin_amdgcn_readfirstlane(tid >> 6), lane = tid & 63, wr = wid >> 2, wc = wid & 3, fr = lane & 15, fq = lane >> 4;
  const int K = g.K, nt = K / BK;
  unsigned voffA[2], voffB[2];
#pragma unroll
  for (int i = 0; i < 2; ++i) { int R, C; stage_rc(tid * 16 + i * 8192, R, C); const int Rb = Epi::PERM ? ((R & ~31) + perm32(R & 31)) : R;
    voffA[i] = (unsigned)(R * K + C) * 2u; voffB[i] = (unsigned)(Rb * K + C) * 2u; }
  const size_t kstep = (size_t)(BK * 2), hstep = (size_t)HALF * K * 2, tstep = 2 * hstep;
  const unsigned ldsw = (unsigned)wid * 1024u;
  const int aoff = lds_byte(wr * 64 + fr, fq * 8), boff = lds_byte(wc * 32 + fr, fq * 8);
#define PG8_SA(b, h) (((b) * 2 + (h)) * HTB)
#define PG8_SB(b, h) ((4 + (b) * 2 + (h)) * HTB)
#define PG8_STAGE(bufoff, gbase, voff) do { _Pragma("unroll") for (int _i = 0; _i < 2; ++_i) \
    __builtin_amdgcn_global_load_lds((const unsigned*)((const char*)(gbase) + (voff)[_i]), (LAS unsigned*)(lds + (bufoff) + ldsw + _i * 8192), 16, 0, 0); } while (0)
#define PG8_LDA(dst, b, h) do { _Pragma("unroll") for (int m = 0; m < 4; ++m) _Pragma("unroll") for (int k = 0; k < 2; ++k) dst[m][k] = *(const LAS bf16x8*)(lds + PG8_SA(b, h) + aoff + m * 2048 + k * 1024); } while (0)
#define PG8_LDB(dst, b, h) do { _Pragma("unroll") for (int n = 0; n < 2; ++n) _Pragma("unroll") for (int k = 0; k < 2; ++k) dst[n][k] = *(const LAS bf16x8*)(lds + PG8_SB(b, h) + boff + n * 2048 + k * 1024); } while (0)
#define PG8_MMA(ai, bj, At, Bt) do { __builtin_amdgcn_s_setprio(1); _Pragma("unroll") for (int m = 0; m < 4; ++m) _Pragma("unroll") for (int n = 0; n < 2; ++n) _Pragma("unroll") for (int k = 0; k < 2; ++k) \
    acc[ai][bj][m][n] = __builtin_amdgcn_mfma_f32_16x16x32_bf16(Bt[n][k], At[m][k], acc[ai][bj][m][n], 0, 0, 0); __builtin_amdgcn_s_setprio(0); } while (0)
#define PG8_WAIT_V(n) asm volatile("s_waitcnt vmcnt(" #n ")" ::: "memory")
#define PG8_WAIT_L(n) asm volatile("s_waitcnt lgkmcnt(" #n ")" ::: "memory")
#define PG8_BAR __builtin_amdgcn_s_barrier()
#define PG8_SCHED __builtin_amdgcn_sched_barrier(0)
  Unit cur, nxt; int ui = 0;
  if (!S.next(0, cur)) return;
  f32x4 acc[2][2][4][2];
#pragma unroll
  for (int a = 0; a < 2; ++a)
#pragma unroll
    for (int b = 0; b < 2; ++b)
#pragma unroll
      for (int m = 0; m < 4; ++m)
#pragma unroll
        for (int n = 0; n < 2; ++n) acc[a][b][m][n] = (f32x4){0.f, 0.f, 0.f, 0.f};
  bf16x8 At[4][2], B0[2][2], B1[2][2];
  const char* cA = (const char*)g.A + (size_t)cur.pm * tstep; const char* cB = (const char*)g.Bt + (size_t)cur.pn * tstep;
  PG8_STAGE(PG8_SB(0, 0), cB, voffB); PG8_STAGE(PG8_SA(0, 0), cA, voffA); PG8_STAGE(PG8_SB(0, 1), cB + hstep, voffB); PG8_STAGE(PG8_SA(0, 1), cA + hstep, voffA);
  if (wr == 1) PG8_BAR;
  PG8_WAIT_V(4); PG8_BAR;
  PG8_STAGE(PG8_SB(1, 0), cB + kstep, voffB); PG8_STAGE(PG8_SA(1, 0), cA + kstep, voffA); PG8_STAGE(PG8_SB(1, 1), cB + hstep + kstep, voffB);
  PG8_WAIT_V(6); PG8_BAR;
  for (;;) {
    const bool has_next = S.next(ui + 1, nxt);
    const char* nA = has_next ? (const char*)g.A + (size_t)nxt.pm * tstep : cA; const char* nB = has_next ? (const char*)g.Bt + (size_t)nxt.pn * tstep : cB;
    for (int t = 0; t < nt; t += 2) {
      const bool last = (t == nt - 2);
      if constexpr (Epi::HAS_MID) { if (t == nt / 2) E.mid(acc, cur, wr, wc, fr, fq); }
      const char* a1 = cA + (size_t)(t + 1) * kstep;
      const char* a2 = last ? nA : cA + (size_t)(t + 2) * kstep; const char* b2 = last ? nB : cB + (size_t)(t + 2) * kstep;
      const char* a3 = a2 + kstep; const char* b3 = b2 + kstep;
      PG8_LDB(B0, 0, 0); PG8_SCHED; PG8_LDA(At, 0, 0); PG8_STAGE(PG8_SA(1, 1), a1 + hstep, voffA);
      PG8_WAIT_L(8); PG8_BAR; PG8_WAIT_L(0); PG8_MMA(0, 0, At, B0); PG8_BAR; PG8_SCHED;
      PG8_LDB(B1, 0, 1); PG8_STAGE(PG8_SB(0, 0), b2, voffB);
      PG8_BAR; PG8_WAIT_L(0); PG8_MMA(0, 1, At, B1); PG8_BAR;
      PG8_LDA(At, 0, 1); PG8_STAGE(PG8_SA(0, 0), a2, voffA);
      PG8_BAR; PG8_WAIT_L(0); PG8_MMA(1, 0, At, B0); PG8_BAR; PG8_SCHED;
      PG8_STAGE(PG8_SB(0, 1), b2 + hstep, voffB);
      PG8_WAIT_V(6); PG8_BAR; PG8_MMA(1, 1, At, B1); PG8_BAR;
      PG8_LDB(B0, 1, 0); PG8_SCHED; PG8_LDA(At, 1, 0); PG8_STAGE(PG8_SA(0, 1), a2 + hstep, voffA);
      PG8_WAIT_L(8); PG8_BAR; PG8_WAIT_L(0); PG8_MMA(0, 0, At, B0); PG8_BAR; PG8_SCHED;
      PG8_LDB(B1, 1, 1); PG8_STAGE(PG8_SB(1, 0), b3, voffB);
      PG8_BAR; PG8_WAIT_L(0); PG8_MMA(0, 1, At, B1); PG8_BAR;
      PG8_LDA(At, 1, 1); PG8_STAGE(PG8_SA(1, 0), a3, voffA);
      PG8_BAR; PG8_WAIT_L(0); PG8_MMA(1, 0, At, B0); PG8_BAR; PG8_SCHED;
      PG8_STAGE(PG8_SB(1, 1), b3 + hstep, voffB);
      PG8_WAIT_V(6); PG8_BAR; PG8_MMA(1, 1, At, B1); PG8_BAR;
    }
    E(acc, cur, wr, wc, fr, fq);
    if (!has_next) break;
#pragma unroll
    for (int a = 0; a < 2; ++a)
#pragma unroll
      for (int b = 0; b < 2; ++b)
#pragma unroll
        for (int m = 0; m < 4; ++m)
#pragma unroll
          for (int n = 0; n < 2; ++n) acc[a][b][m][n] = (f32x4){0.f, 0.f, 0.f, 0.f};
    cur = nxt; cA = nA; cB = nB; ++ui;
  }
  PG8_WAIT_V(0);
  if (wr == 0) PG8_BAR;
  PG8_BAR;
#undef PG8_SA
#undef PG8_SB
#undef PG8_STAGE
#undef PG8_LDA
#undef PG8_LDB
#undef PG8_MMA
#undef PG8_WAIT_V
#undef PG8_WAIT_L
#undef PG8_BAR
#undef PG8_SCHED
}
}

struct EpiIn {
  static constexpr bool PERM = true, HAS_MID = false;
  unsigned char* ws; bf16_t* gsga; const float* rstd; const float* rot;
  __device__ __forceinline__ void operator()(const f32x4 (&acc)[2][2][4][2], const pg8::Unit& u, int wr, int wc, int fr, int fq) const {
    const int pn = u.pn, row0 = u.pm * 256 + wr * 64 + fr, col0 = wc * 32 + 8 * fq;
    if (pn >= 4 && pn < 8) {
      bf16_t* base = (bf16_t*)(ws + (pn < 6 ? OFF_QB : OFF_KB));
      const int lc = ((pn & 1) * 4 + wc) * 64 + 8 * fq;
#pragma unroll
      for (int ai = 0; ai < 2; ++ai)
#pragma unroll
        for (int m = 0; m < 4; ++m) {
          const int r = row0 + ai * 128 + m * 16; const float rs = rstd[r];
          const float* rp = rot + (size_t)row_pos(r) * 64 + 8 * fq;
          const f32x4 c0 = *(const f32x4*)(rp), c1 = *(const f32x4*)(rp + 4), s0 = *(const f32x4*)(rp + 32), s1 = *(const f32x4*)(rp + 36);
          const float rq = pn < 6 ? rs * 0.18033688011112042f : rs;
          const f32x4 a0 = acc[ai][0][m][0] * rq, a1 = acc[ai][0][m][1] * rq, b0 = acc[ai][1][m][0] * rq, b1 = acc[ai][1][m][1] * rq;
          const f32x4 o10 = a0 * c0 - b0 * s0, o11 = a1 * c1 - b1 * s1, o20 = b0 * c0 + a0 * s0, o21 = b1 * c1 + a1 * s1;
          bf16_t* rowp = base + (size_t)r * 512 + lc;
          *(u32x4*)(rowp) = pack8(o10, o11); *(u32x4*)(rowp + 32) = pack8(o20, o21);
        }
    } else {
      bf16_t* base; int ldc, colt, act;
      if (pn < 2) { base = (bf16_t*)(ws + OFF_XS); ldc = 512; colt = pn * 256; act = 0; }
      else if (pn < 4) { base = (bf16_t*)(ws + OFF_ZS); ldc = 512; colt = (pn - 2) * 256; act = 1; }
      else if (pn < 10) { base = (bf16_t*)(ws + OFF_VB); ldc = 512; colt = (pn - 8) * 256; act = 0; }
      else if (pn < 12) { base = (bf16_t*)(ws + OFF_ZA); ldc = 512; colt = (pn - 10) * 256; act = 0; }
      else if (pn < 16) { base = gsga; ldc = 1024; colt = (pn - 12) * 256; act = 2; }
      else { base = gsga + (size_t)MT * 1024; ldc = 1024; colt = (pn - 16) * 256; act = 2; }
#pragma unroll
      for (int ai = 0; ai < 2; ++ai)
#pragma unroll
        for (int m = 0; m < 4; ++m) {
          const int r = row0 + ai * 128 + m * 16; const float rs = rstd[r];
          bf16_t* rowp = base + (size_t)r * ldc + colt + col0;
#pragma unroll
          for (int bj = 0; bj < 2; ++bj) {
            f32x4 v0 = acc[ai][bj][m][0] * rs, v1 = acc[ai][bj][m][1] * rs;
            if (act == 1) {
#pragma unroll
              for (int j = 0; j < 4; ++j) { v0[j] = siluf_(v0[j]); v1[j] = siluf_(v1[j]); } }
            else if (act == 2) {
#pragma unroll
              for (int j = 0; j < 4; ++j) { v0[j] = sigmoidf_(v0[j]); v1[j] = sigmoidf_(v1[j]); } }
            *(u32x4*)(rowp + bj * 128) = pack8(v0, v1);
          }
        }
    }
  }
};
struct EpiGlu {
  static constexpr bool PERM = true, HAS_MID = false;
  const bf16_t* ysg; const bf16_t* zs; const float* bias; bf16_t* out;
  __device__ __forceinline__ void operator()(const f32x4 (&acc)[2][2][4][2], const pg8::Unit& u, int wr, int wc, int fr, int fq) const {
    const int row0 = u.pm * 256 + wr * 64 + fr, col0 = u.pn * 256 + wc * 32 + 8 * fq;
#pragma unroll
    for (int ai = 0; ai < 2; ++ai)
#pragma unroll
      for (int m = 0; m < 4; ++m) {
        const size_t ro = (size_t)(row0 + ai * 128 + m * 16) * 512 + col0;
#pragma unroll
        for (int bj = 0; bj < 2; ++bj) {
          const f32x4 bb0 = *(const f32x4*)(bias + col0 + bj * 128), bb1 = *(const f32x4*)(bias + col0 + bj * 128 + 4);
          f32x4 y0, y1, z0, z1; unpack8(*(const u32x4*)(ysg + ro + bj * 128), y0, y1); unpack8(*(const u32x4*)(zs + ro + bj * 128), z0, z1);
          f32x4 v0 = acc[ai][bj][m][0] + bb0, v1 = acc[ai][bj][m][1] + bb1;
#pragma unroll
          for (int j = 0; j < 4; ++j) { v0[j] = y0[j] * sigmoidf_(v0[j]) * z0[j]; v1[j] = y1[j] * sigmoidf_(v1[j]) * z1[j]; }
          *(u32x4*)(out + ro * 2 - col0 + bj * 128) = pack8(v0, v1);
        }
      }
  }
};
struct EpiBrF {
  static constexpr bool PERM = true, HAS_MID = true;
  const bf16_t* gs; const bf16_t* ga; bf16_t* out;
  __device__ __forceinline__ void mid(f32x4 (&acc)[2][2][4][2], const pg8::Unit& u, int wr, int wc, int fr, int fq) const {
    int row0 = u.pm * 256 + wr * 64 + fr, col0 = u.pn * 256 + wc * 32 + 8 * fq;
    asm volatile("" : "+v"(row0), "+v"(col0));
    u32x4 bs[2][2], ba[2][2];
#define MIDLOAD(q, gi) do { const size_t ro_ = (size_t)(row0 + ((gi) >> 2) * 128 + ((gi) & 3) * 16) * 1024 + col0; \
      bs[q][0] = *(const u32x4*)(gs + ro_); bs[q][1] = *(const u32x4*)(gs + ro_ + 128); ba[q][0] = *(const u32x4*)(ga + ro_); ba[q][1] = *(const u32x4*)(ga + ro_ + 128); } while (0)
    MIDLOAD(0, 0);
#pragma unroll
    for (int gi = 0; gi < 8; ++gi) {
      const int q = gi & 1, ai = gi >> 2, m = gi & 3;
      __builtin_amdgcn_sched_barrier(0);
      if (gi + 1 < 8) MIDLOAD(q ^ 1, gi + 1);
      __builtin_amdgcn_sched_barrier(0);
#pragma unroll
      for (int bj = 0; bj < 2; ++bj) { f32x4 s0, s1, a0, a1; unpack8(bs[q][bj], s0, s1); unpack8(ba[q][bj], a0, a1);
#pragma unroll
        for (int j = 0; j < 4; ++j) { acc[ai][bj][m][0][j] *= s0[j] * __builtin_amdgcn_rcpf(a0[j]); acc[ai][bj][m][1][j] *= s1[j] * __builtin_amdgcn_rcpf(a1[j]); } }
    }
    __builtin_amdgcn_sched_barrier(0);
#undef MIDLOAD
  }
  __device__ __forceinline__ void operator()(const f32x4 (&acc)[2][2][4][2], const pg8::Unit& u, int wr, int wc, int fr, int fq) const {
    const int row0 = u.pm * 256 + wr * 64 + fr, col0 = u.pn * 256 + wc * 32 + 8 * fq;
#pragma unroll
    for (int ai = 0; ai < 2; ++ai)
#pragma unroll
      for (int m = 0; m < 4; ++m) {
        const size_t ro = (size_t)(row0 + ai * 128 + m * 16) * 1024 + col0;
#pragma unroll
        for (int bj = 0; bj < 2; ++bj) {
          f32x4 g0, g1; unpack8(*(const u32x4*)(ga + ro + bj * 128), g0, g1);
          *(u32x4*)(out + ro + bj * 128) = pack8(acc[ai][bj][m][0] * g0, acc[ai][bj][m][1] * g1);
        }
      }
  }
};
struct EpiOut {
  static constexpr bool PERM = true, HAS_MID = false;
  bf16_t* yb;
  __device__ __forceinline__ void operator()(const f32x4 (&acc)[2][2][4][2], const pg8::Unit& u, int wr, int wc, int fr, int fq) const {
    const int row0 = u.pm * 256 + wr * 64 + fr, col0 = u.pn * 256 + wc * 32 + 8 * fq;
#pragma unroll
    for (int ai = 0; ai < 2; ++ai)
#pragma unroll
      for (int m = 0; m < 4; ++m) {
        bf16_t* orow = yb + (size_t)(row0 + ai * 128 + m * 16) * 1024 + col0;
#pragma unroll
        for (int bj = 0; bj < 2; ++bj) *(u32x4*)(orow + bj * 128) = pack8(acc[ai][bj][m][0], acc[ai][bj][m][1]);
      }
  }
};

namespace att {
constexpr int NW = 8, QBLK = 32, KVBLK = 64, LD = 512, LDO = 1024;
constexpr float SCALE = 0.125f, THR = 8.f;
constexpr int SHM_K = KVBLK * 64 * 2, SHM_V = KVBLK * 128 * 2, OFF_KB0 = 0, OFF_VB0 = 2 * SHM_K, OFF_AUX = 2 * SHM_K + 2 * SHM_V;
#define KSWZ(row, colB) ((row) * 128 + ((colB) ^ ((((row) >> 1) & 7) << 4)))
__device__ __forceinline__ int crow(int r, int hi) { return (r & 3) + 8 * (r >> 2) + 4 * hi; }
constexpr float THR2 = THR * 1.4426950408889634f;
template <bool FIRST>
__device__ __forceinline__ void sm_max(f32x16& p0, f32x16& p1, f32x16& minit, float& alpha) {
  float pmax = p0[0];
#pragma unroll
  for (int r = 1; r < 16; ++r) pmax = fmaxf(pmax, p0[r]);
#pragma unroll
  for (int r = 0; r < 16; ++r) pmax = fmaxf(pmax, p1[r]);
  { auto rr = __builtin_amdgcn_permlane32_swap(__float_as_uint(pmax), __float_as_uint(pmax), false, false);
    pmax = fmaxf(__uint_as_float(rr[0]), __uint_as_float(rr[1])); }
  alpha = 1.f;
  if (FIRST || !__all(pmax <= THR2)) {
    const float dl = FIRST ? pmax : fmaxf(pmax, 0.f);
    alpha = FIRST ? 1.f : __builtin_amdgcn_exp2f(-dl);
#pragma unroll
    for (int r = 0; r < 16; ++r) { p0[r] -= dl; p1[r] -= dl; minit[r] -= dl; }
  }
}
__device__ __forceinline__ void sm_exp(f32x16& p0, f32x16& p1, float alpha, float& l_reg, bf16x8& pa0, bf16x8& pa1, bf16x8& pa2, bf16x8& pa3) {
#pragma unroll
  for (int r = 0; r < 16; ++r) p0[r] = __builtin_amdgcn_exp2f(p0[r]);
#pragma unroll
  for (int r = 0; r < 16; ++r) p1[r] = __builtin_amdgcn_exp2f(p1[r]);
  { float ps = 0;
#pragma unroll
    for (int r = 0; r < 16; ++r) ps += p0[r];
#pragma unroll
    for (int r = 0; r < 16; ++r) ps += p1[r];
    auto rr = __builtin_amdgcn_permlane32_swap(__float_as_uint(ps), __float_as_uint(ps), false, false);
    l_reg = l_reg * alpha + (__uint_as_float(rr[0]) + __uint_as_float(rr[1])); }
#define PK4(P, BASE, OUT) do { u32x4 w = {cvtpk(P[BASE + 0], P[BASE + 1]), cvtpk(P[BASE + 2], P[BASE + 3]), cvtpk(P[BASE + 4], P[BASE + 5]), cvtpk(P[BASE + 6], P[BASE + 7])}; \
    OUT = *reinterpret_cast<bf16x8*>(&w); } while (0)
  PK4(p0, 0, pa0); PK4(p0, 8, pa1); PK4(p1, 0, pa2); PK4(p1, 8, pa3);
#undef PK4
}
__device__ __forceinline__ int v_st(int k, int c) { const int kk = k; return ((kk >> 3) * 4 + (c >> 5)) * 512 + ((kk & 7) * 32 + (c & 31)) * 2; }
__device__ __forceinline__ int v_rd_base(int lane) { return ((lane & 3) << 3) | (((lane >> 2) & 3) << 6) | (((lane >> 4) & 1) << 5) | (((lane >> 5) & 1) << 8); }
constexpr int v_rd_off(int d0, int ks, int half) { return d0 * 512 + ks * 4096 + half * 2048; }
__device__ __forceinline__ s16x4 tr_read(const LAS unsigned char* p) { return __builtin_amdgcn_ds_read_tr16_b64_v4i16((LAS s16x4*)p); }
#define SBAR() __builtin_amdgcn_sched_barrier(0)
#define PKF(L, H) (bf16x8){L[0], L[1], L[2], L[3], H[0], H[1], H[2], H[3]}
#define ABAR() do { asm volatile("s_waitcnt lgkmcnt(0)" ::: "memory"); __builtin_amdgcn_s_barrier(); asm volatile("" ::: "memory"); } while (0)
__device__ __forceinline__ void qk_tile(f32x16& n0, f32x16& n1, const LAS unsigned char* Ks, const bf16x8* qr, const f32x16& minit, int r32, int hi) {
#pragma unroll
  for (int d0 = 0; d0 < 4; ++d0) { const int cb = (d0 * 16 + hi * 8) * 2;
    const bf16x8 b0 = *(const LAS bf16x8*)(Ks + KSWZ(r32, cb)); const bf16x8 b1 = *(const LAS bf16x8*)(Ks + KSWZ(32 + r32, cb));
    if (d0 == 0) { n0 = __builtin_amdgcn_mfma_f32_32x32x16_bf16(b0, qr[0], minit, 0, 0, 0); n1 = __builtin_amdgcn_mfma_f32_32x32x16_bf16(b1, qr[0], minit, 0, 0, 0); }
    else { n0 = __builtin_amdgcn_mfma_f32_32x32x16_bf16(b0, qr[d0], n0, 0, 0, 0); n1 = __builtin_amdgcn_mfma_f32_32x32x16_bf16(b1, qr[d0], n1, 0, 0, 0); } }
}
__device__ __forceinline__ void pv_tile(f32x16* o, const LAS unsigned char* vb, bf16x8 pa0, bf16x8 pa1, bf16x8 pa2, bf16x8 pa3) {
#define PV_KS(ks, pa) do { _Pragma("unroll") for (int d0 = 0; d0 < 4; ++d0) { \
    const s16x4 l_ = tr_read(vb + v_rd_off(d0, ks, 0)), h_ = tr_read(vb + v_rd_off(d0, ks, 1)); \
    o[d0] = __builtin_amdgcn_mfma_f32_32x32x16_bf16(pa, PKF(l_, h_), o[d0], 0, 0, 0); } } while (0)
  PV_KS(0, pa0); PV_KS(1, pa1); PV_KS(2, pa2); PV_KS(3, pa3);
#undef PV_KS
}
__device__ __forceinline__ void attn_unit(const bf16_t* __restrict__ Qb, const bf16_t* __restrict__ Kh, const bf16_t* __restrict__ Vh, bf16_t* __restrict__ Ob, int seq, LAS unsigned char* lds) {
  const int tid = tid_now(), wid = tid >> 6, lane = tid & 63, r32 = lane & 31, hi = lane >> 5;
  LAS float* al_l = (LAS float*)(lds + OFF_AUX) + wid * 64; LAS float* li_l = al_l + 32;
  f32x16 o[4] = {}; f32x16 minit = {}; float l_reg = 0.f; bf16x8 qr[4];
  const bf16_t* Qw = Qb + (long)(wid * QBLK + r32) * LD + hi * 8;
#pragma unroll
  for (int d0 = 0; d0 < 4; ++d0) qr[d0] = *reinterpret_cast<const bf16x8*>(Qw + d0 * 16);
  const int sr = tid >> 4, sc = (tid & 15) * 8, ksr = tid >> 3, ksc = (tid & 7) * 8;
  const int vst0 = OFF_VB0 + v_st(sr, sc), vst1 = OFF_VB0 + v_st(32 + sr, sc), kst = OFF_KB0 + KSWZ(ksr, ksc * 2);
  const LAS unsigned char* vrd = lds + OFF_VB0 + v_rd_base(lane);
  const int NT = seq / KVBLK;
  bf16x8 sv0, sv1, sk0;
  const bf16_t* vp = Vh + (long)sr * LD + sc; const bf16_t* kp = Kh + (long)(2 * KVBLK + ksr) * LD + ksc;
#define SLOAD(j) do { sv0 = *reinterpret_cast<const bf16x8*>(vp); sv1 = *reinterpret_cast<const bf16x8*>(vp + 32 * LD); sk0 = *reinterpret_cast<const bf16x8*>(kp); \
    vp += KVBLK * LD; kp += KVBLK * LD; } while (0)
#define SWRITE(par) do { *(LAS bf16x8*)(lds + (par) * SHM_V + vst0) = sv0; *(LAS bf16x8*)(lds + (par) * SHM_V + vst1) = sv1; *(LAS bf16x8*)(lds + (par) * SHM_K + kst) = sk0; } while (0)
#define RESC(a) do { if (__any((a) < 1.f)) { if (hi == 0) al_l[r32] = (a); asm volatile("s_waitcnt lgkmcnt(0)" ::: "memory"); \
    _Pragma("unroll") for (int r = 0; r < 16; ++r) { const float a_ = al_l[crow(r, hi)]; o[0][r] *= a_; o[1][r] *= a_; o[2][r] *= a_; o[3][r] *= a_; } } } while (0)
#define SCHED_ITER() do { __builtin_amdgcn_sched_group_barrier(0x100, 6, 0); \
    _Pragma("unroll") for (int i_ = 0; i_ < 16; ++i_) { __builtin_amdgcn_sched_group_barrier(0x008, 1, 0); __builtin_amdgcn_sched_group_barrier(0x100, 2, 0); \
      __builtin_amdgcn_sched_group_barrier(0x002, 7, 0); } \
    _Pragma("unroll") for (int i_ = 0; i_ < 8; ++i_) { __builtin_amdgcn_sched_group_barrier(0x008, 1, 0); __builtin_amdgcn_sched_group_barrier(0x100, 1, 0); __builtin_amdgcn_sched_group_barrier(0x002, 2, 0); } \
    __builtin_amdgcn_sched_group_barrier(0x200, 3, 0); __builtin_amdgcn_sched_group_barrier(0x020, 3, 0); } while (0)
  { const bf16x8 k0 = *reinterpret_cast<const bf16x8*>(&Kh[(long)ksr * LD + ksc]); const bf16x8 k1 = *reinterpret_cast<const bf16x8*>(&Kh[(long)(KVBLK + ksr) * LD + ksc]);
    *(LAS bf16x8*)(lds + kst) = k0; *(LAS bf16x8*)(lds + SHM_K + kst) = k1; }
  SLOAD(0);
  ABAR();
  f32x16 s0, s1; float alpha; bf16x8 xa0, xa1, xa2, xa3, ya0, ya1, ya2, ya3;
  qk_tile(s0, s1, lds + OFF_KB0, qr, minit, r32, hi);
  ABAR();
  sm_max<true>(s0, s1, minit, alpha);
  SBAR();
  sm_exp(s0, s1, alpha, l_reg, xa0, xa1, xa2, xa3);
  qk_tile(s0, s1, lds + OFF_KB0 + SHM_K, qr, minit, r32, hi);
  SWRITE(0); SLOAD(1);
  SBAR(); ABAR();
  alpha = 1.f;
  for (int j = 1; j + 1 < NT; j += 2) {
    RESC(alpha);
    sm_max<false>(s0, s1, minit, alpha);
    SBAR();
    pv_tile(o, vrd, xa0, xa1, xa2, xa3);
    sm_exp(s0, s1, alpha, l_reg, ya0, ya1, ya2, ya3);
    qk_tile(s0, s1, lds + OFF_KB0, qr, minit, r32, hi);
    SWRITE(1); SLOAD(j + 1);
    SCHED_ITER();
    SBAR(); ABAR();
    RESC(alpha);
    sm_max<false>(s0, s1, minit, alpha);
    SBAR();
    pv_tile(o, vrd + SHM_V, ya0, ya1, ya2, ya3);
    sm_exp(s0, s1, alpha, l_reg, xa0, xa1, xa2, xa3);
    qk_tile(s0, s1, lds + OFF_KB0 + SHM_K, qr, minit, r32, hi);
    SWRITE(0); if (j + 2 < NT) SLOAD(j + 2);
    SCHED_ITER();
    SBAR(); ABAR();
  }
  RESC(alpha);
  sm_max<false>(s0, s1, minit, alpha);
  SBAR();
  pv_tile(o, vrd, xa0, xa1, xa2, xa3);
  sm_exp(s0, s1, alpha, l_reg, ya0, ya1, ya2, ya3);
  SWRITE(1);
  SBAR(); ABAR();
  RESC(alpha);
  pv_tile(o, vrd + SHM_V, ya0, ya1, ya2, ya3);
  float rli[16];
  if (hi == 0) li_l[r32] = l_reg; asm volatile("s_waitcnt lgkmcnt(0)" ::: "memory");
#pragma unroll
  for (int r = 0; r < 16; ++r) rli[r] = __builtin_amdgcn_rcpf(li_l[crow(r, hi)]);
  bf16_t* Ow = Ob + (long)(wid * QBLK) * LDO;
#pragma unroll
  for (int r = 0; r < 16; ++r) { const int orow = crow(r, hi);
#pragma unroll
    for (int d0 = 0; d0 < 4; ++d0) Ow[(long)orow * LDO + d0 * 32 + r32] = (bf16_t)(cvtpk(o[d0][r] * rli[r], 0.f) & 0xffffu); }
  __syncthreads();
#undef SLOAD
#undef SWRITE
#undef RESC
#undef SCHED_ITER
}
}

constexpr int SCAN_ROWB = 272, SCAN_WAVE_LDS = 32 * SCAN_ROWB;
__device__ __forceinline__ void scan_seq(const unsigned char* wsb, int rowbase, int L, int g, int dir, char* ldsw, int lane) {
  const int j = lane & 31, hi = lane >> 5, l16 = lane & 15, q4 = lane >> 4;
  const float* LAMp = (const float*)(wsb + OFF_LAM) + ((size_t)(dir * 32 + g) * 64 + lane) * 2;
  const float lr = LAMp[0], li = LAMp[1];
  const bf16_t* BBp = (const bf16_t*)(wsb + OFF_BB) + (size_t)(dir * 32 + g) * 128 * 16;
  const bf16_t* CBp = (const bf16_t*)(wsb + OFF_CB) + (size_t)(dir * 32 + g) * 128 * 16;
  bf16x8 bb[4], cb[4];
#pragma unroll
  for (int nb = 0; nb < 4; ++nb) bb[nb] = *(const bf16x8*)(BBp + (nb * 32 + j) * 16 + 8 * hi);
#pragma unroll
  for (int kk = 0; kk < 4; ++kk) cb[kk] = *(const bf16x8*)(CBp + (kk * 16 + l16) * 32 + 8 * q4);
  const bf16_t* XS = (const bf16_t*)(wsb + OFF_XS) + (size_t)rowbase * 512 + g * 16;
  bf16_t* Y = (bf16_t*)(wsb + (dir ? OFF_YB : OFF_YF)) + (size_t)rowbase * 512 + g * 16;
  float hr = 0.f, him = 0.f;
  const int nch = L / 32;
  auto tok = [&](int c, int t) { const int p = c * 32 + t; return dir ? (L - 1 - p) : p; };
  bf16x8 a_next = *(const bf16x8*)(XS + (size_t)tok(0, j) * 512 + 8 * hi);
  for (int c = 0; c < nch; ++c) {
    const bf16x8 a = a_next;
    if (c + 1 < nch) a_next = *(const bf16x8*)(XS + (size_t)tok(c + 1, j) * 512 + 8 * hi);
    const f32x16 z = {};
    f32x16 d0 = __builtin_amdgcn_mfma_f32_32x32x16_bf16(a, bb[0], z, 0, 0, 0);
    f32x16 d1 = __builtin_amdgcn_mfma_f32_32x32x16_bf16(a, bb[1], z, 0, 0, 0);
    f32x16 d2 = __builtin_amdgcn_mfma_f32_32x32x16_bf16(a, bb[2], z, 0, 0, 0);
    f32x16 d3 = __builtin_amdgcn_mfma_f32_32x32x16_bf16(a, bb[3], z, 0, 0, 0);
#pragma unroll
    for (int a4 = 0; a4 < 4; ++a4) {
      float re[2][4], im[2][4];
#pragma unroll
      for (int i = 0; i < 4; ++i) { const int r = 4 * a4 + i;
        auto s0 = __builtin_amdgcn_permlane32_swap(__float_as_uint(d0[r]), __float_as_uint(d2[r]), false, false);
        auto s1 = __builtin_amdgcn_permlane32_swap(__float_as_uint(d1[r]), __float_as_uint(d3[r]), false, false);
        re[0][i] = __uint_as_float(s0[0]); re[1][i] = __uint_as_float(s0[1]); im[0][i] = __uint_as_float(s1[0]); im[1][i] = __uint_as_float(s1[1]); }
#pragma unroll
      for (int h = 0; h < 2; ++h)
#pragma unroll
        for (int i = 0; i < 4; ++i) { const int t = 8 * a4 + 4 * h + i;
          const float nr = fmaf(lr, hr, fmaf(-li, him, re[h][i])), ni = fmaf(lr, him, fmaf(li, hr, im[h][i]));
          hr = nr; him = ni;
          *(unsigned*)(ldsw + t * SCAN_ROWB + lane * 4) = cvtpk(hr, him); }
    }
    __builtin_amdgcn_wave_barrier();
#pragma unroll
    for (int tb = 0; tb < 2; ++tb) {
      f32x4 acc = {0.f, 0.f, 0.f, 0.f};
#pragma unroll
      for (int kk = 0; kk < 4; ++kk) { const bf16x8 hf = *(const bf16x8*)(ldsw + (tb * 16 + l16) * SCAN_ROWB + (kk * 32 + 8 * q4) * 2);
        acc = __builtin_amdgcn_mfma_f32_16x16x32_bf16(cb[kk], hf, acc, 0, 0, 0); }
      u32x2 w; w.x = cvtpk(acc[0], acc[1]); w.y = cvtpk(acc[2], acc[3]);
      *(u32x2*)(Y + (size_t)tok(c, tb * 16 + l16) * 512 + 4 * q4) = w;
    }
    __builtin_amdgcn_wave_barrier();
  }
}

__device__ __forceinline__ int win_drow(int n) {
  if (n < 1024 || n >= 2048) return n;
  const int c = n & 255, tb = n - c, gi = c >> 6, d = c & 63;
  return tb + (d >> 5) * 128 + gi * 32 + (d & 31);
}
__device__ __forceinline__ void transpose_job(const float* src, int ldn, int K, int k0, int n0, bf16_t* dst, const float* gscale, bool perm, float* tile) {
  const int tid = tid_now();
#pragma unroll
  for (int pss = 0; pss < 2; ++pss) { const int kr = (tid >> 4) + pss * 32, nc = (tid & 15) * 4;
    f32x4 v = *(const f32x4*)(src + (size_t)(k0 + kr) * ldn + n0 + nc);
    if (gscale) v = v * gscale[k0 + kr];
    tile[kr * 65 + nc] = v[0]; tile[kr * 65 + nc + 1] = v[1]; tile[kr * 65 + nc + 2] = v[2]; tile[kr * 65 + nc + 3] = v[3]; }
  __syncthreads();
  { const int nl = tid >> 3, kc = (tid & 7) * 8; f32x4 a, b;
#pragma unroll
    for (int i = 0; i < 4; ++i) { a[i] = tile[(kc + i) * 65 + nl]; b[i] = tile[(kc + 4 + i) * 65 + nl]; }
    const int n = n0 + nl, dr = perm ? win_drow(n) : n;
    *(u32x4*)(dst + (size_t)dr * K + k0 + kc) = pack8(a, b); }
  __syncthreads();
}

__global__ void __launch_bounds__(512, 2) fwd_mega(Params p) {
  extern __shared__ __attribute__((aligned(16))) unsigned char smem[];
  cg::grid_group grid = cg::this_grid();
  const int G = gridDim.x, bx = blockIdx.x;
#define tid tid_now()
#define lane (tid_now() & 63)
#define wid (tid_now() >> 6)
  unsigned char* ws = p.ws;
  bf16_t* gsga = (bf16_t*)p.out;
  const int lo = p.ph_lo, hi_ = p.ph_hi & 0xff, p2mode = (p.ph_hi >> 8) & 3;
#ifndef PHMASK
#define PHMASK 255
#endif
#define IN(k) (((PHMASK >> (k)) & 1) && lo <= (k) && (k) < hi_)
#ifdef DUMP
#undef IN
#define IN(k) (((k) == 8 || ((PHMASK >> (k)) & 1)) && lo <= (k) && (k) < hi_)
#endif
#ifndef DUPMASK
#define DUPMASK 0
#endif
#define NREP(k) (((DUPMASK >> (k)) & 1) ? 2 : 1)
#define SEAM(k) do { if (IN(k) && IN((k) + 1)) grid.sync(); } while (0)

  if (IN(0)) {
    for (int r = bx * 8 + wid; r < MT; r += G * 8) {
      const float* xr = r < MP ? p.x_p + (size_t)r * 1024 : p.x_s + (size_t)(r - MP) * 1024;
      bf16_t* xb = (bf16_t*)(ws + OFF_XB) + (size_t)r * 1024; float s = 0.f;
#pragma unroll
      for (int i = 0; i < 4; ++i) { const f32x4 v = *(const f32x4*)(xr + i * 256 + lane * 4); s += v[0] * v[0] + v[1] * v[1] + v[2] * v[2] + v[3] * v[3];
        u32x2 w; w.x = cvtpk(v[0], v[1]); w.y = cvtpk(v[2], v[3]); *(u32x2*)(xb + i * 256 + lane * 4) = w; }
#pragma unroll
      for (int o = 32; o > 0; o >>= 1) s += __shfl_xor(s, o);
      if (lane == 0) ((float*)(ws + OFF_RSTD))[r] = rsqrtf(s * (1.f / 1024.f) + 1e-6f);
    }
    for (int jb = bx; jb < 1856; jb += G) {
      float* tile = (float*)smem;
      if (jb < 1280) transpose_job(p.w_in, NIN, 1024, (jb / 80) * 64, (jb % 80) * 64, (bf16_t*)(ws + OFF_WIN), p.norm_g, true, tile);
      else if (jb < 1344) { const int q = jb - 1280; transpose_job(p.w_glu, 512, 512, (q / 8) * 64, (q % 8) * 64, (bf16_t*)(ws + OFF_WGLU), nullptr, false, tile); }
      else if (jb < 1600) { const int q = jb - 1344, i = q / 128, r = q % 128;
        transpose_job(p.w_branch + (size_t)i * 512 * 1024, 1024, 1024, (r / 16) * 64, (r % 16) * 64, (bf16_t*)(ws + OFF_WBR) + (size_t)i * 512, nullptr, false, tile); }
      else { const int q = jb - 1600; transpose_job(p.w_out, 1024, 1024, (q / 16) * 64, (q % 16) * 64, (bf16_t*)(ws + OFF_WOUT), nullptr, false, tile); }
    }
    const int gt = bx * 512 + tid, GT = G * 512;
    for (int i = gt; i < 8192 * 32; i += GT) { const int pos = i >> 5, k = i & 31;
      const float ex = (float)k * 2.0f / 64.0f; const float invf = (float)(1.0 / pow(10000.0, (double)ex));
      const float ang = (float)pos * invf; const double rev = (double)ang * 0.15915494309189535; const float fr2 = (float)(2.0 * (rev - floor(rev)));
      float* rt = (float*)(ws + OFF_ROT) + (size_t)pos * 64; rt[k] = cospif(fr2); rt[32 + k] = sinpif(fr2); }
    for (int i = gt; i < MT; i += GT) ((float*)(ws + OFF_SSQ))[i] = 0.f;
    if (gt < 4096) { const int dir = gt >> 11, g = (gt >> 6) & 31, s = gt & 63;
      const double dt = exp((double)p.log_dt[dir * 32 + g]);
      const double ar = (double)p.a_re[gt], ai = (double)p.a_im[gt];
      const double mag = exp(ar * dt); const double ph = ai * dt * 0.3183098861837907; const float ph2 = (float)(ph - 2.0 * floor(ph * 0.5));
      const double lr = mag * (double)cospif(ph2), li = mag * (double)sinpif(ph2);
      float* lm = (float*)(ws + OFF_LAM) + (size_t)gt * 2; lm[0] = (float)lr; lm[1] = (float)li;
      const double den = ar * ar + ai * ai, cr = ((lr - 1.0) * ar + li * ai) / den, ci = (li * ar - (lr - 1.0) * ai) / den;
      bf16_t* BBp = (bf16_t*)(ws + OFF_BB) + (size_t)(dir * 32 + g) * 128 * 16;
      const int nbr = (s >> 5) * 2, jj = s & 31;
      for (int c = 0; c < 16; ++c) { const double br = (double)p.b_re[(size_t)gt * 16 + c], bi = (double)p.b_im[(size_t)gt * 16 + c];
        BBp[((nbr) * 32 + jj) * 16 + c] = (bf16_t)(cvtpk((float)(cr * br - ci * bi), 0.f) & 0xffffu);
        BBp[((nbr + 1) * 32 + jj) * 16 + c] = (bf16_t)(cvtpk((float)(cr * bi + ci * br), 0.f) & 0xffffu); }
      bf16_t* CBp = (bf16_t*)(ws + OFF_CB) + (size_t)(dir * 32 + g) * 128 * 16;
      for (int c = 0; c < 16; ++c) { const float cre = p.c_re[((size_t)(dir * 32 + g) * 16 + c) * 64 + s], cim = p.c_im[((size_t)(dir * 32 + g) * 16 + c) * 64 + s];
        const int k = 2 * s, kk = k >> 5, kp = k & 31;
        *(unsigned*)(CBp + (kk * 16 + c) * 32 + kp) = cvtpk(cre, -cim); }
    }
    if (gt == 0) { float s1 = 0.f, s2 = 0.f; for (int i = 0; i < 64; ++i) { s1 += p.lq1[i] * p.lk1[i]; s2 += p.lq2[i] * p.lk2[i]; }
      ((float*)(ws + OFF_CTL))[8] = expf(s1) - expf(s2) + 0.2f; for (int i = 0; i < 64; ++i) if (i != 8) ((unsigned*)(ws + OFF_CTL))[i] = 0u; }
  }
  SEAM(0);

  if (IN(1)) for (int rep = 0; rep < NREP(1); ++rep) {
    pg8::Gemm g{(const bf16_t*)(ws + OFF_XB), (const bf16_t*)(ws + OFF_WIN), MT, NIN, 1024}; pg8::StaticOrder S; S.init(MT, NIN, G, bx);
    EpiIn E{ws, gsga, (const float*)(ws + OFF_RSTD), (const float*)(ws + OFF_ROT)};
    pg8::gemm_phase<EpiIn>((LAS unsigned char*)smem, g, S, E);
  }
  SEAM(1);

  if (IN(2)) for (int rep = 0; rep < NREP(2); ++rep) {
    const int xq = bx & 7;
    unsigned* ctr = (unsigned*)(ws + OFF_CTL) + 16 + rep * 8 + xq; volatile unsigned* bc = (volatile unsigned*)(smem + LDS_BYTES - 16);
    const bf16_t* QB = (const bf16_t*)(ws + OFF_QB); const bf16_t* KB = (const bf16_t*)(ws + OFF_KB); const bf16_t* VB = (const bf16_t*)(ws + OFF_VB); bf16_t* AO = (bf16_t*)(ws + OFF_AO);
    for (;;) {
      __syncthreads();
      if (tid == 0) *bc = atomicAdd(ctr, 1u);
      __syncthreads();
      const int it = (int)*bc;
      if (it >= 336) break;
      const bool is_scan = it < 8 || (it >= 264 && it < 272);
      if ((p2mode == 1 && !is_scan) || (p2mode == 2 && is_scan)) continue;
      if (is_scan) {
        const bool lng = it < 8; const int s = (xq * 8 + (lng ? it : it - 264)) * 8 + wid;
        const int b = s >> 6, g = (s >> 1) & 31, dir = s & 1;
        scan_seq(ws, lng ? MP + b * 8192 : b * 2048, lng ? 8192 : 2048, g, dir, (char*)smem + wid * SCAN_WAVE_LDS, lane);
      } else {
        const bool lng = it < 264; const int u = lng ? it - 8 : it - 272;
        const int nqb = lng ? 32 : 8, L = lng ? 8192 : 2048;
        const int qb = u % nqb, vh = u / nqb, b = xq;
        const size_t rb = lng ? (size_t)MP + (size_t)b * 8192 : (size_t)b * 2048;
        att::attn_unit(QB + (rb + qb * 256) * 512 + vh * 64, KB + rb * 512 + vh * 64, VB + rb * 512 + (vh >> 1) * 128, AO + (rb + qb * 256) * 1024 + vh * 128, L, (LAS unsigned char*)smem);
      }
    }
  }
  SEAM(2);

  if (IN(3)) for (int rep = 0; rep < NREP(3); ++rep) {
    const float lam = ((const float*)(ws + OFF_CTL))[8];
    const bf16_t* YF = (const bf16_t*)(ws + OFF_YF); const bf16_t* YB = (const bf16_t*)(ws + OFF_YB); const bf16_t* XS = (const bf16_t*)(ws + OFF_XS);
    const bf16_t* AO = (const bf16_t*)(ws + OFF_AO); const bf16_t* ZA = (const bf16_t*)(ws + OFF_ZA);
    bf16_t* YSG = (bf16_t*)(ws + OFF_YSG); bf16_t* YCAT = (bf16_t*)(ws + OFF_YCAT);
    const int c0 = lane * 8; const f32x4 dk0 = *(const f32x4*)(p.ssm_d + c0), dk1 = *(const f32x4*)(p.ssm_d + c0 + 4);
    const int h = lane >> 4, e0 = (lane & 15) * 8; const f32x4 sg0 = *(const f32x4*)(p.subln_g + e0) * 0.8f, sg1 = *(const f32x4*)(p.subln_g + e0 + 4) * 0.8f;
    for (int r = bx * 8 + wid; r < MT; r += G * 8) {
      f32x4 f0, f1, b0, b1, x0, x1;
      unpack8(*(const u32x4*)(YF + (size_t)r * 512 + c0), f0, f1); unpack8(*(const u32x4*)(YB + (size_t)r * 512 + c0), b0, b1); unpack8(*(const u32x4*)(XS + (size_t)r * 512 + c0), x0, x1);
      f32x4 v0 = f0 + b0 + dk0 * x0, v1 = f1 + b1 + dk1 * x1;
#pragma unroll
      for (int i = 0; i < 4; ++i) { v0[i] = gelu_tanh(v0[i]); v1[i] = gelu_tanh(v1[i]); }
      f32x4 p0, p1, q0, q1, z0, z1;
      unpack8(*(const u32x4*)(AO + (size_t)r * 1024 + (2 * h) * 128 + e0), p0, p1); unpack8(*(const u32x4*)(AO + (size_t)r * 1024 + (2 * h + 1) * 128 + e0), q0, q1);
      unpack8(*(const u32x4*)(ZA + (size_t)r * 512 + h * 128 + e0), z0, z1);
#pragma unroll
      for (int i = 0; i < 4; ++i) { z0[i] = siluf_(z0[i]); z1[i] = siluf_(z1[i]); }
      *(u32x4*)(YSG + (size_t)r * 512 + c0) = pack8(v0, v1);
      f32x4 o0 = p0 - lam * q0, o1 = p1 - lam * q1;
      float ss = 0.f;
#pragma unroll
      for (int i = 0; i < 4; ++i) ss += o0[i] * o0[i] + o1[i] * o1[i];
      ss += __shfl_xor(ss, 1); ss += __shfl_xor(ss, 2); ss += __shfl_xor(ss, 4); ss += __shfl_xor(ss, 8);
      const float rn = rsqrtf(ss * (1.f / 128.f) + 1e-5f);
      o0 = o0 * rn * sg0 * z0; o1 = o1 * rn * sg1 * z1;
      *(u32x4*)(YCAT + (size_t)r * 1024 + 512 + h * 128 + e0) = pack8(o0, o1);
    }
  }
  SEAM(3);

  if (IN(4)) for (int rep = 0; rep < NREP(4); ++rep) {
    pg8::Gemm g{(const bf16_t*)(ws + OFF_YSG), (const bf16_t*)(ws + OFF_WGLU), MT, 512, 512}; pg8::StaticOrder S; S.init(MT, 512, G, bx);
    EpiGlu E{(const bf16_t*)(ws + OFF_YSG), (const bf16_t*)(ws + OFF_ZS), p.b_glu, (bf16_t*)(ws + OFF_YCAT)};
    pg8::gemm_phase<EpiGlu>((LAS unsigned char*)smem, g, S, E);
  }
  SEAM(4);

  if (IN(5)) for (int rep = 0; rep < NREP(5); ++rep) {
    pg8::StaticOrder S; S.init(MT, 1024, G, bx);
    pg8::Gemm g{(const bf16_t*)(ws + OFF_YCAT), (const bf16_t*)(ws + OFF_WBR), MT, 1024, 1024};
    EpiBrF E{gsga, gsga + (size_t)MT * 1024, (bf16_t*)(ws + OFF_MG)}; pg8::gemm_phase<EpiBrF>((LAS unsigned char*)smem, g, S, E);
  }
  SEAM(5);

  if (IN(6)) {
    pg8::Gemm g{(const bf16_t*)(ws + OFF_MG), (const bf16_t*)(ws + OFF_WOUT), MT, 1024, 1024}; pg8::StaticOrder S; S.init(MT, 1024, G, bx);
    EpiOut E{(bf16_t*)(ws + OFF_XB)};
    pg8::gemm_phase<EpiOut>((LAS unsigned char*)smem, g, S, E);
  }
  SEAM(6);

  if (IN(7)) {
    f32x4 fg[4];
#pragma unroll
    for (int i = 0; i < 4; ++i) fg[i] = *(const f32x4*)(p.final_g + (i >> 1) * 512 + lane * 8 + (i & 1) * 4);
    const bf16_t* yb = (const bf16_t*)(ws + OFF_XB);
    for (int r = bx * 8 + wid; r < MT; r += G * 8) {
      const float* xr = r < MP ? p.x_p + (size_t)r * 1024 : p.x_s + (size_t)(r - MP) * 1024;
      float* orow = p.out + (size_t)r * 1024; const bf16_t* yr = yb + (size_t)r * 1024;
      f32x4 y[4]; float s = 0.f;
#pragma unroll
      for (int i = 0; i < 2; ++i) { f32x4 v0, v1; unpack8(*(const u32x4*)(yr + i * 512 + lane * 8), v0, v1);
        y[2 * i] = v0 + *(const f32x4*)(xr + i * 512 + lane * 8); y[2 * i + 1] = v1 + *(const f32x4*)(xr + i * 512 + lane * 8 + 4); }
#pragma unroll
      for (int i = 0; i < 4; ++i) s += y[i][0] * y[i][0] + y[i][1] * y[i][1] + y[i][2] * y[i][2] + y[i][3] * y[i][3];
#pragma unroll
      for (int o = 32; o > 0; o >>= 1) s += __shfl_xor(s, o);
      const float rn = rsqrtf(s * (1.f / 1024.f) + 1e-6f);
#pragma unroll
      for (int i = 0; i < 2; ++i) { *(f32x4*)(orow + i * 512 + lane * 8) = y[2 * i] * rn * fg[2 * i]; *(f32x4*)(orow + i * 512 + lane * 8 + 4) = y[2 * i + 1] * rn * fg[2 * i + 1]; }
    }
  }

#ifdef DUMP
  if (IN(8)) {
    for (int r = bx * 8 + wid; r < MT; r += G * 8) {
      float* orow = p.out + (size_t)r * 1024;
      for (int c = lane; c < 512; c += 64) {
        float a = 0.f, b = 0.f; const size_t i5 = (size_t)r * 512 + c, i1 = (size_t)r * 1024 + c;
#define BF(off, idx) bflo((unsigned)((const bf16_t*)(ws + (off)))[idx])
        if (DUMP == 1) { a = BF(OFF_XS, i5) + BF(OFF_ZS, i5) + BF(OFF_VB, i5); b = BF(OFF_QB, i5) + BF(OFF_KB, i5) + BF(OFF_ZA, i5); }
        if (DUMP == 2) { a = BF(OFF_YF, i5) + BF(OFF_YB, i5); b = BF(OFF_AO, i1) + BF(OFF_AO, i1 + 512); }
        if (DUMP == 3) { a = BF(OFF_YSG, i5); b = BF(OFF_MG, i1) + BF(OFF_MG, i1 + 512); }
        if (DUMP == 4) { a = BF(OFF_YF, i5); b = BF(OFF_YB, i5); }
        if (DUMP == 5) { a = BF(OFF_AO, i1); b = BF(OFF_AO, i1 + 512); }
#undef BF
        orow[c] = a; orow[512 + c] = b;
      }
    }
  }
#endif
#undef IN
#undef SEAM
#undef tid
#undef lane
#undef wid
}

#ifndef N_LAUNCH_PER_PHASE
#define N_LAUNCH_PER_PHASE 0
#endif
extern "C" void kernel_launch(void* const* d_in, const int* in_sizes, int n_in, void* d_out, int out_size, void* d_ws, size_t ws_size, hipStream_t stream) {
  static int grid = 0;
  if (grid == 0) {
    if (n_in != 22 || out_size != MT * 1024 || ws_size < WS_END) { fprintf(stderr, "kernel_launch: unexpected shapes n_in %d out %d ws %zu (need %zu)\n", n_in, out_size, ws_size, (size_t)WS_END); grid = -1; return; }
    int dev = 0, cus = 0, per_cu = 0;
    hipGetDevice(&dev); hipDeviceGetAttribute(&cus, hipDeviceAttributeMultiprocessorCount, dev);
    if (hipFuncSetAttribute((const void*)fwd_mega, hipFuncAttributeMaxDynamicSharedMemorySize, LDS_BYTES) != hipSuccess) { fprintf(stderr, "kernel_launch: hipFuncSetAttribute failed\n"); grid = -1; return; }
    if (hipOccupancyMaxActiveBlocksPerMultiprocessor(&per_cu, (const void*)fwd_mega, 512, LDS_BYTES) != hipSuccess || per_cu < 1) { fprintf(stderr, "kernel_launch: occupancy query says %d\n", per_cu); per_cu = 1; }
    (void)hipGetLastError();
    grid = cus * 1;
  }
  if (grid < 0) return;
  Params p{};
  p.x_p = (const float*)d_in[0]; p.x_s = (const float*)d_in[1]; p.norm_g = (const float*)d_in[2]; p.w_in = (const float*)d_in[3];
  p.a_re = (const float*)d_in[4]; p.a_im = (const float*)d_in[5]; p.log_dt = (const float*)d_in[6]; p.b_re = (const float*)d_in[7]; p.b_im = (const float*)d_in[8];
  p.c_re = (const float*)d_in[9]; p.c_im = (const float*)d_in[10]; p.ssm_d = (const float*)d_in[11]; p.w_glu = (const float*)d_in[12]; p.b_glu = (const float*)d_in[13];
  p.lq1 = (const float*)d_in[14]; p.lk1 = (const float*)d_in[15]; p.lq2 = (const float*)d_in[16]; p.lk2 = (const float*)d_in[17]; p.subln_g = (const float*)d_in[18];
  p.w_branch = (const float*)d_in[19]; p.w_out = (const float*)d_in[20]; p.final_g = (const float*)d_in[21];
  p.out = (float*)d_out; p.ws = (unsigned char*)d_ws;
#if N_LAUNCH_PER_PHASE
  #ifdef DUMP
  const int nph = 9;
#else
  const int nph = 8;
#endif
  for (int ph = 0; ph < nph; ++ph) { p.ph_lo = ph; p.ph_hi = ph + 1; hipLaunchKernelGGL(fwd_mega, dim3(grid), dim3(512), LDS_BYTES, stream, p); }
#else
#ifdef PREFIX_HI
#ifndef P2MODE
#define P2MODE 0
#endif
  for (int ph = 0; ph < PREFIX_HI; ++ph) { p.ph_lo = ph; p.ph_hi = (ph + 1) | (ph == 2 ? (P2MODE << 8) : 0); hipLaunchKernelGGL(fwd_mega, dim3(grid), dim3(512), LDS_BYTES, stream, p); }
#endif
  p.ph_lo = 0; p.ph_hi = 8;
  void* args[] = {&p};
  hipError_t e = hipLaunchCooperativeKernel((const void*)fwd_mega, dim3(grid), dim3(512), args, LDS_BYTES, stream);
  if (e != hipSuccess) fprintf(stderr, "cooperative launch failed: %s (grid %d)\n", hipGetErrorString(e), grid);
#endif
}
```
